# Optimizing an MI355X kernel written in HIP

```python
import jax
import jax.numpy as jnp
from jax import lax
import numpy as np

D_MODEL = 1024
BATCH = 32
SEQ = 2048
DEPTH = 1

GRID_W = 64
CTX_LEN = 256
EPS = 1e-6
N_MOD = 6

ATTN_HEADS = 8
ATTN_KV_HEADS = 2
ATTN_HEAD_DIM = 64
ATTN_WIDTH = ATTN_HEADS * ATTN_HEAD_DIM
KV_WIDTH = ATTN_KV_HEADS * ATTN_HEAD_DIM
Q_BLOCK = 128
ROPE_THETA = 10000.0

MLSTM_HEADS = 4
MLSTM_HEAD_DIM = 128
MLSTM_WIDTH = MLSTM_HEADS * MLSTM_HEAD_DIM
MLSTM_CHUNK = 64
CONV_W = 3

N_EXPERTS = 256
TOP_K = 8
N_GROUPS = 8
TOPK_GROUPS = 4
EXPERT_FF = 256
SHARED_FF = 256
ROUTED_SCALE = 2.5
MOE_BLOCK = 128

IN_SPLITS = (ATTN_WIDTH, KV_WIDTH, KV_WIDTH, MLSTM_WIDTH, MLSTM_WIDTH, MLSTM_WIDTH, MLSTM_WIDTH,
             2 * MLSTM_HEADS, 2 * MLSTM_HEADS, D_MODEL, D_MODEL)
IN_WIDTH = sum(IN_SPLITS)

kernel_name = "hybrid_gqa_mlstm_moe_dit_layer"


def rms_norm(x, g):
    xf = x.astype(jnp.float32)
    y = xf * lax.rsqrt(jnp.mean(xf * xf, axis=-1, keepdims=True) + EPS)
    return (y * g.astype(jnp.float32)).astype(x.dtype)


def modulate(h, shift, scale):
    return h * (1.0 + scale) + shift


def split_in(p):
    idx = np.cumsum(IN_SPLITS)[:-1].tolist()
    return jnp.split(p, idx, axis=-1)


def axial_rope_tables(n):
    rows = n // GRID_W
    row = jnp.repeat(jnp.arange(rows, dtype=jnp.int32), GRID_W)
    col = jnp.tile(jnp.arange(GRID_W, dtype=jnp.int32), rows)
    n_freq = ATTN_HEAD_DIM // 4
    inv_freq = ROPE_THETA ** (-jnp.arange(n_freq, dtype=jnp.float32) / n_freq)
    pos = jnp.stack([row, col], axis=-1).astype(jnp.float32)
    ang = pos[:, :, None] * inv_freq
    return jnp.cos(ang), jnp.sin(ang)


def apply_axial_rope(x, cos, sin):
    B, n, H, dh = x.shape
    xr = x.reshape(B, n, H, 2, 2, dh // 4)
    x1, x2 = xr[..., 0, :], xr[..., 1, :]
    c = cos[None, :, None].astype(x.dtype)
    s = sin[None, :, None].astype(x.dtype)
    return jnp.stack([x1 * c - x2 * s, x2 * c + x1 * s], axis=-2).reshape(B, n, H, dh)


def gqa_attend(q, keys, vals):
    B, Lq, Hq, dh = q.shape
    Hkv = keys.shape[2]
    qg = q.reshape(B, Lq, Hkv, Hq // Hkv, dh)
    s = jnp.einsum('bqhgd,bkhd->bhgqk', qg, keys, preferred_element_type=jnp.float32) * (dh ** -0.5)
    p = jax.nn.softmax(s, axis=-1).astype(vals.dtype)
    o = jnp.einsum('bhgqk,bkhd->bqhgd', p, vals)
    return o.reshape(B, Lq, Hq * dh)


def attention_blocks(q, keys, vals):
    B, S, Hq, dh = q.shape
    nb = S // Q_BLOCK
    qb = jnp.moveaxis(q.reshape(B, nb, Q_BLOCK, Hq, dh), 1, 0)
    out = lax.map(lambda blk: gqa_attend(blk, keys, vals), qb)
    return jnp.moveaxis(out, 0, 1).reshape(B, S, Hq * dh)


def short_conv(a, w, b):
    pad = CONV_W // 2
    n = a.shape[1]
    ap = jnp.pad(a, ((0, 0), (pad, pad), (0, 0)))
    return sum(ap[:, j:j + n] * w[j] for j in range(CONV_W)) + b


def mlstm_inputs(mq, mk, mv, mi, mf, conv_w, conv_b, b_igate, b_fgate):
    B, n, _ = mq.shape
    qk = jax.nn.silu(short_conv(jnp.concatenate([mq, mk], axis=-1), conv_w, conv_b)).astype(jnp.float32)
    q, k = jnp.split(qk, 2, axis=-1)

    def heads(a):
        return a.reshape(B, n, MLSTM_HEADS, MLSTM_HEAD_DIM).transpose(0, 2, 1, 3)

    def gates(g, bias):
        return (g.astype(jnp.float32) + bias.astype(jnp.float32)).reshape(B, n, 2, MLSTM_HEADS).transpose(2, 0, 3, 1)

    q = heads(q) * (MLSTM_HEAD_DIM ** -0.5)
    k = heads(k)
    v = heads(mv.astype(jnp.float32))
    log_i = gates(mi, b_igate)
    log_f = jax.nn.log_sigmoid(gates(mf, b_fgate))
    return q, k, v, log_i, log_f


def mlstm_scan(q, k, v, log_i, log_f, state):
    B, H, n, dk = q.shape
    dv = v.shape[-1]
    nc = n // MLSTM_CHUNK

    def to_chunks(a):
        return jnp.moveaxis(a.reshape(B, H, nc, MLSTM_CHUNK, *a.shape[3:]), 2, 0)

    xs = (to_chunks(q), to_chunks(k), to_chunks(v), to_chunks(log_i), to_chunks(log_f))
    lower = jnp.tril(jnp.ones((MLSTM_CHUNK, MLSTM_CHUNK), dtype=bool))

    def step(carry, inp):
        C, nv, m = carry
        qc, kc, vc, li, lf = inp
        b = jnp.cumsum(lf, axis=-1)
        dmat = b[..., :, None] - b[..., None, :] + li[..., None, :]
        dmat = jnp.where(lower, dmat, -jnp.inf)
        inter = b + m[..., None]
        m_q = jnp.maximum(inter, jnp.max(dmat, axis=-1))
        w_intra = jnp.exp(dmat - m_q[..., None])
        w_inter = jnp.exp(inter - m_q)
        qk = jnp.einsum('bhjd,bhsd->bhjs', qc, kc) * w_intra
        num = w_inter[..., None] * jnp.einsum('bhvd,bhjd->bhjv', C, qc) + jnp.einsum('bhjs,bhsv->bhjv', qk, vc)
        den = w_inter * jnp.einsum('bhd,bhjd->bhj', nv, qc) + jnp.sum(qk, axis=-1)
        h = num / jnp.maximum(jnp.abs(den), jnp.exp(-m_q))[..., None]
        bL = b[..., -1]
        dec = bL[..., None] - b + li
        m_new = jnp.maximum(bL + m, jnp.max(dec, axis=-1))
        w_s = jnp.exp(dec - m_new[..., None])
        w_old = jnp.exp(bL + m - m_new)
        C_new = w_old[..., None, None] * C + jnp.einsum('bhsv,bhsd->bhvd', vc * w_s[..., None], kc)
        n_new = w_old[..., None] * nv + jnp.einsum('bhs,bhsd->bhd', w_s, kc)
        return (C_new, n_new, m_new), h

    state, hs = lax.scan(step, state, xs)
    h = jnp.moveaxis(hs, 0, 2).reshape(B, H, n, dv)
    return h, state


def mlstm_output(h, o, g):
    B, H, n, dv = h.shape
    hn = rms_norm(h, g.reshape(MLSTM_HEADS, 1, MLSTM_HEAD_DIM))
    hn = hn.transpose(0, 2, 1, 3).reshape(B, n, H * dv)
    return (hn * jax.nn.sigmoid(o.astype(jnp.float32))).astype(o.dtype)


def mlstm_branch(xin, cin, need_ctx, conv_w, conv_b, b_igate, b_fgate, g_mlstm):
    qx, kx, vx, lix, lfx = mlstm_inputs(xin[0], xin[1], xin[2], xin[4], xin[5], conv_w, conv_b, b_igate, b_fgate)
    qc, kc, vc, lic, lfc = mlstm_inputs(cin[0], cin[1], cin[2], cin[4], cin[5], conv_w, conv_b, b_igate, b_fgate)
    B = qx.shape[0]
    state0 = (jnp.zeros((B, MLSTM_HEADS, MLSTM_HEAD_DIM, MLSTM_HEAD_DIM), jnp.float32),
              jnp.zeros((B, MLSTM_HEADS, MLSTM_HEAD_DIM), jnp.float32),
              jnp.zeros((B, MLSTM_HEADS), jnp.float32))

    def fl(a):
        return jnp.flip(a, axis=2)

    hc_f, st_f = mlstm_scan(qc, kc, vc, lic[0], lfc[0], state0)
    hc_b, st_b = mlstm_scan(fl(qc), fl(kc), fl(vc), fl(lic[1]), fl(lfc[1]), state0)
    hx_f, _ = mlstm_scan(qx, kx, vx, lix[0], lfx[0], st_f)
    hx_b, _ = mlstm_scan(fl(qx), fl(kx), fl(vx), fl(lix[1]), fl(lfx[1]), st_b)
    out_x = mlstm_output(hx_f + fl(hx_b), xin[3], g_mlstm)
    out_c = mlstm_output(hc_f + fl(hc_b), cin[3], g_mlstm) if need_ctx else None
    return out_x, out_c


def merge_branches(a_out, m_out, ga, gm, w_br_attn, w_br_mlstm, w_out):
    y = jax.nn.sigmoid(ga) * (a_out @ w_br_attn) + jax.nn.sigmoid(gm) * (m_out @ w_br_mlstm)
    return y @ w_out


def token_mixers(hx, hc, need_ctx, cos, sin, w_in, g_q, g_k, conv_w, conv_b, b_igate, b_fgate, g_mlstm,
                 w_br_attn, w_br_mlstm, w_out):
    qx, kx, vx, mqx, mkx, mvx, mox, mix, mfx, gax, gmx = split_in(hx @ w_in)
    qc, kc, vc, mqc, mkc, mvc, moc, mic, mfc, gac, gmc = split_in(hc @ w_in)

    def qk_heads(a, H, g):
        return rms_norm(a.reshape(*a.shape[:-1], H, ATTN_HEAD_DIM), g)

    def v_heads(a):
        return a.reshape(*a.shape[:-1], ATTN_KV_HEADS, ATTN_HEAD_DIM)

    qx = apply_axial_rope(qk_heads(qx, ATTN_HEADS, g_q), cos, sin)
    kx = apply_axial_rope(qk_heads(kx, ATTN_KV_HEADS, g_k), cos, sin)
    kc = qk_heads(kc, ATTN_KV_HEADS, g_k)
    vc = v_heads(vc)
    keys = jnp.concatenate([kc, kx], axis=1)
    vals = jnp.concatenate([vc, v_heads(vx)], axis=1)
    ax = attention_blocks(qx, keys, vals)

    mx, mc = mlstm_branch((mqx, mkx, mvx, mox, mix, mfx), (mqc, mkc, mvc, moc, mic, mfc), need_ctx,
                          conv_w, conv_b, b_igate, b_fgate, g_mlstm)
    yx = merge_branches(ax, mx, gax, gmx, w_br_attn, w_br_mlstm, w_out)
    if need_ctx:
        ac = gqa_attend(qk_heads(qc, ATTN_HEADS, g_q), kc, vc)
        yc = merge_branches(ac, mc, gac, gmc, w_br_attn, w_br_mlstm, w_out)
    else:
        yc = None
    return yx, yc


def swiglu(h, wg, wu, wd):
    return (jax.nn.silu(h @ wg) * (h @ wu)) @ wd


def routed_experts(h, eidx, gate_w, w_gate, w_up, w_down):
    T, D = h.shape
    A = T * TOP_K
    flat_e = eidx.reshape(-1)
    flat_tok = jnp.repeat(jnp.arange(T, dtype=jnp.int32), TOP_K)
    flat_w = gate_w.reshape(-1)
    order = jnp.argsort(flat_e)
    se, stok, sw = flat_e[order], flat_tok[order], flat_w[order]
    counts = jax.ops.segment_sum(jnp.ones((A,), jnp.int32), flat_e, num_segments=N_EXPERTS)
    padded = (counts + MOE_BLOCK - 1) // MOE_BLOCK * MOE_BLOCK
    pend = jnp.cumsum(padded)
    pstart = pend - padded
    ustart = jnp.cumsum(counts) - counts
    dest = pstart[se] + (jnp.arange(A, dtype=jnp.int32) - ustart[se])
    n_blocks = (A + N_EXPERTS * (MOE_BLOCK - 1) + MOE_BLOCK - 1) // MOE_BLOCK
    P = n_blocks * MOE_BLOCK
    slot_tok = jnp.zeros((P,), jnp.int32).at[dest].set(stok)
    slot_w = jnp.zeros((P,), jnp.float32).at[dest].set(sw)
    block_e = jnp.minimum(jnp.searchsorted(pend, jnp.arange(n_blocks, dtype=jnp.int32) * MOE_BLOCK, side='right'),
                          N_EXPERTS - 1)

    def body(y, blk):
        tok_b, w_b, e = blk
        xb = h[tok_b]
        hid = jax.nn.silu(xb @ w_gate[e]) * (xb @ w_up[e])
        out = (hid @ w_down[e]) * w_b[:, None].astype(h.dtype)
        return y.at[tok_b].add(out), None

    y, _ = lax.scan(body, jnp.zeros((T, D), h.dtype),
                    (slot_tok.reshape(n_blocks, MOE_BLOCK), slot_w.reshape(n_blocks, MOE_BLOCK), block_e))
    return y


def moe(h, w_router, e_bias, w_exp_gate, w_exp_up, w_exp_down, w_sh_gate, w_sh_up, w_sh_down):
    T = h.shape[0]
    scores = jax.nn.sigmoid(jnp.dot(h, w_router, preferred_element_type=jnp.float32))
    sel = (scores + e_bias.astype(jnp.float32)).reshape(T, N_GROUPS, N_EXPERTS // N_GROUPS)
    group_score = jnp.sum(lax.top_k(sel, 2)[0], axis=-1)
    _, gidx = lax.top_k(group_score, TOPK_GROUPS)
    gmask = jnp.any(gidx[..., None] == jnp.arange(N_GROUPS, dtype=gidx.dtype), axis=-2)
    masked = jnp.where(gmask[..., None], sel, -jnp.inf).reshape(T, N_EXPERTS)
    _, eidx = lax.top_k(masked, TOP_K)
    w = jnp.take_along_axis(scores, eidx, axis=-1)
    w = w / jnp.sum(w, axis=-1, keepdims=True) * ROUTED_SCALE
    return routed_experts(h, eidx, w, w_exp_gate, w_exp_up, w_exp_down) + swiglu(h, w_sh_gate, w_sh_up, w_sh_down)


def setup_inputs(seed: int = 0) -> dict:
    key = jax.random.key(seed)
    ks = jax.random.split(key, 32)
    L, D, E = DEPTH, D_MODEL, N_EXPERTS

    def nrm(k, shape, s):
        return jax.random.normal(k, shape, jnp.float32) * s

    def gain(k, shape):
        return 1.0 + nrm(k, shape, 0.05)

    return {
        "x": nrm(ks[0], (BATCH, SEQ, D), 1.0),
        "c": nrm(ks[1], (BATCH, D), 1.0),
        "ctx": nrm(ks[2], (BATCH, CTX_LEN, D), 1.0),
        "c_ctx": nrm(ks[3], (D,), 1.0),
        "w_ada": nrm(ks[4], (L, D, N_MOD * D), 0.5 * D ** -0.5),
        "b_ada": nrm(ks[5], (L, N_MOD * D), 0.02),
        "g_pre_mix": gain(ks[6], (L, D)),
        "g_post_mix": gain(ks[7], (L, D)),
        "g_pre_ffn": gain(ks[8], (L, D)),
        "g_post_ffn": gain(ks[9], (L, D)),
        "w_in": nrm(ks[10], (L, D, IN_WIDTH), D ** -0.5),
        "g_q": gain(ks[11], (L, ATTN_HEAD_DIM)),
        "g_k": gain(ks[12], (L, ATTN_HEAD_DIM)),
        "conv_w": nrm(ks[13], (L, CONV_W, 2 * MLSTM_WIDTH), CONV_W ** -0.5),
        "conv_b": nrm(ks[14], (L, 2 * MLSTM_WIDTH), 0.02),
        "b_igate": nrm(ks[15], (L, 2 * MLSTM_HEADS), 0.1),
        "b_fgate": jnp.tile(jnp.linspace(3.0, 6.0, MLSTM_HEADS), 2)[None, :] + nrm(ks[16], (L, 2 * MLSTM_HEADS), 0.1),
        "g_mlstm": gain(ks[17], (L, MLSTM_WIDTH)),
        "w_br_attn": nrm(ks[18], (L, ATTN_WIDTH, D), ATTN_WIDTH ** -0.5),
        "w_br_mlstm": nrm(ks[19], (L, MLSTM_WIDTH, D), MLSTM_WIDTH ** -0.5),
        "w_out": nrm(ks[20], (L, D, D), D ** -0.5),
        "w_router": nrm(ks[21], (L, D, E), D ** -0.5),
        "e_bias": nrm(ks[22], (L, E), 0.01),
        "w_exp_gate": nrm(ks[23], (L, E, D, EXPERT_FF), D ** -0.5),
        "w_exp_up": nrm(ks[24], (L, E, D, EXPERT_FF), D ** -0.5),
        "w_exp_down": nrm(ks[25], (L, E, EXPERT_FF, D), EXPERT_FF ** -0.5),
        "w_sh_gate": nrm(ks[26], (L, D, SHARED_FF), D ** -0.5),
        "w_sh_up": nrm(ks[27], (L, D, SHARED_FF), D ** -0.5),
        "w_sh_down": nrm(ks[28], (L, SHARED_FF, D), SHARED_FF ** -0.5),
    }


def reference(x, c, ctx, c_ctx, w_ada, b_ada, g_pre_mix, g_post_mix, g_pre_ffn, g_post_ffn, w_in, g_q, g_k,
              conv_w, conv_b, b_igate, b_fgate, g_mlstm, w_br_attn, w_br_mlstm, w_out, w_router, e_bias,
              w_exp_gate, w_exp_up, w_exp_down, w_sh_gate, w_sh_up, w_sh_down):
    B, S, D = x.shape
    CL = ctx.shape[1]
    cos, sin = axial_rope_tables(S)
    for l in range(DEPTH):
        need_ctx = l < DEPTH - 1
        mod_x = (jax.nn.silu(c) @ w_ada[l] + b_ada[l])[:, None, :]
        mod_c = jax.nn.silu(c_ctx) @ w_ada[l] + b_ada[l]
        sh1, sc1, g1, sh2, sc2, g2 = jnp.split(mod_x, N_MOD, axis=-1)
        sh1c, sc1c, g1c, sh2c, sc2c, g2c = jnp.split(mod_c, N_MOD, axis=-1)

        hx = modulate(rms_norm(x, g_pre_mix[l]), sh1, sc1)
        hc = modulate(rms_norm(ctx, g_pre_mix[l]), sh1c, sc1c)
        yx, yc = token_mixers(hx, hc, need_ctx, cos, sin, w_in[l], g_q[l], g_k[l], conv_w[l], conv_b[l],
                              b_igate[l], b_fgate[l], g_mlstm[l], w_br_attn[l], w_br_mlstm[l], w_out[l])
        x = x + g1 * rms_norm(yx, g_post_mix[l])

        moe_w = (w_router[l], e_bias[l], w_exp_gate[l], w_exp_up[l], w_exp_down[l],
                 w_sh_gate[l], w_sh_up[l], w_sh_down[l])
        fin_x = modulate(rms_norm(x, g_pre_ffn[l]), sh2, sc2).reshape(B * S, D)
        if need_ctx:
            ctx = ctx + g1c * rms_norm(yc, g_post_mix[l])
            fin_c = modulate(rms_norm(ctx, g_pre_ffn[l]), sh2c, sc2c).reshape(B * CL, D)
            f = moe(jnp.concatenate([fin_x, fin_c], axis=0), *moe_w)
            fx = f[:B * S].reshape(B, S, D)
            ctx = ctx + g2c * rms_norm(f[B * S:].reshape(B, CL, D), g_post_ffn[l])
        else:
            fx = moe(fin_x, *moe_w).reshape(B, S, D)
        x = x + g2 * rms_norm(fx, g_post_ffn[l])
    return x
```

```cpp
#include <hip/hip_runtime.h>
#include <cstdio>
#include <cstdint>
#include <cstring>

constexpr int D = 1024, NB = 32, S = 2048, CL = 256, T = NB * S, TC = NB * CL, TA = T + TC, SL = S + CL;
constexpr int NMOD = 6, INW = 4880;
constexpr int AH = 8, AKV = 2, HD = 64, AW = 512, KVW = 128;
constexpr int MH = 4, MD = 128, MW = 512, MCH = 64;
constexpr int NE = 256, TOPK = 8, NG = 8, TKG = 4, EFF = 256;
constexpr float EPS = 1e-6f, RSCALE = 2.5f;
constexpr int C_Q = 0, C_K = 512, C_V = 640, C_MQ = 768, C_MK = 1280, C_MV = 1792, C_MO = 2304, C_MI = 2816, C_MF = 2824, C_GA = 2832, C_GM = 3856;

typedef unsigned short bf16;
__device__ __forceinline__ float bf2f(bf16 b) { return __uint_as_float(((unsigned)b) << 16); }
__device__ __forceinline__ bf16 f2bf(float f) { unsigned u = __float_as_uint(f); u += 0x7fffu + ((u >> 16) & 1u); return (bf16)(u >> 16); }
__device__ __forceinline__ float ldf(const float* p) { return *p; }
__device__ __forceinline__ float ldf(const bf16* p) { return bf2f(*p); }
__device__ __forceinline__ float sigmoidf_(float x) { return 1.f / (1.f + __expf(-x)); }
__device__ __forceinline__ float siluf_(float x) { return x / (1.f + __expf(-x)); }
__device__ __forceinline__ float wave_sum(float v) {
#pragma unroll
    for (int o = 1; o < 64; o <<= 1) v += __shfl_xor(v, o);
    return v;
}
__device__ __forceinline__ int seqrow_lat(int r) { const int b = r / S, t = r % S; return b * SL + CL + t; }
__device__ __forceinline__ int seqrow_ctx(int r) { const int b = r / CL, t = r % CL; return b * SL + t; }

constexpr size_t MiB = 1u << 20;
constexpr size_t WS_CTL = 0;
constexpr size_t WS_MOD = 1 * MiB;
constexpr size_t WS_GATES = 2 * MiB;
constexpr size_t WS_A1 = 8 * MiB;
constexpr size_t WS_Q = 152 * MiB;
constexpr size_t WS_K = 216 * MiB;
constexpr size_t WS_V = 234 * MiB;
constexpr size_t WS_MQ = 252 * MiB;
constexpr size_t WS_MK = 324 * MiB;
constexpr size_t WS_MV = 396 * MiB;
constexpr size_t WS_MO = 468 * MiB;
constexpr size_t WS_GA = 532 * MiB;
constexpr size_t WS_GM = 660 * MiB;
constexpr size_t WS_AM = 788 * MiB;
constexpr size_t WS_SC = 916 * MiB;
constexpr size_t WS_END0 = 1060 * MiB;
constexpr size_t WS_HH = 8 * MiB;
constexpr size_t WS_Y = 8 * MiB;
constexpr size_t WS_YO = 264 * MiB;
constexpr size_t WS_FIN = 8 * MiB;
constexpr size_t WS_SCORE = 136 * MiB;
constexpr size_t WS_EIDX = 200 * MiB;
constexpr size_t WS_EW = 202 * MiB;
constexpr size_t WS_LIST = 204 * MiB;
constexpr size_t WS_HID = 208 * MiB;
constexpr size_t WS_GBUF = 464 * MiB;
constexpr size_t WS_FX = 208 * MiB + 256 * MiB + 256 * MiB;
constexpr int CW_CNT = 0;
constexpr int CW_OFF = 256;
constexpr int CW_FILL = 1024;

struct GemmP {
    const void* A; const void* B;
    const int* rowidx;
    const int* zcnt; const int* zoff;
    long zA, zB;
    int lda, ldb, M, N, K, zBdiv, rshift, pad;
};
static GemmP mkp(const void* A, const void* B, int lda, int ldb, int M, int N, int K, long zA = 0, long zB = 0, int zBdiv = 1, const int* rowidx = nullptr, int rshift = 0, const int* zcnt = nullptr, const int* zoff = nullptr) {
    GemmP p; memset(&p, 0, sizeof(p)); p.A = A; p.B = B; p.rowidx = rowidx; p.zcnt = zcnt; p.zoff = zoff; p.zA = zA; p.zB = zB; p.lda = lda; p.ldb = ldb; p.M = M; p.N = N; p.K = K; p.zBdiv = zBdiv; p.rshift = rshift; p.pad = 0; return p; }
template <typename TA_, typename TB_, bool BT, class Epi>
__global__ __launch_bounds__(256) void gemm_k(GemmP p, Epi epi) {
    __shared__ float As[8][132];
    __shared__ float Bs[8][132];
    const int z = blockIdx.z, tid = threadIdx.x, tx = tid & 15, ty = tid >> 4;
    const TA_* A = (const TA_*)p.A + (size_t)z * p.zA;
    const TB_* B = (const TB_*)p.B + (size_t)(z / p.zBdiv) * p.zB;
    int M = p.M, rbase = 0;
    if (p.zcnt) { M = p.zcnt[z]; rbase = p.zoff[z]; }
    const int n0 = blockIdx.x * 128;
    for (int m0 = blockIdx.y * 128; m0 < M; m0 += gridDim.y * 128) {
        float acc[8][8];
#pragma unroll
        for (int i = 0; i < 8; ++i)
#pragma unroll
            for (int j = 0; j < 8; ++j) acc[i][j] = 0.f;
        const int ar = tid >> 1, ak = (tid & 1) * 4;
        long arow = -1;
        if (m0 + ar < M) { arow = p.rowidx ? (long)(p.rowidx[rbase + m0 + ar] >> p.rshift) : (long)(rbase + m0 + ar); }
        for (int k0 = 0; k0 < p.K; k0 += 8) {
            float av[4] = {0.f, 0.f, 0.f, 0.f};
            if (arow >= 0) {
#pragma unroll
                for (int j = 0; j < 4; ++j) av[j] = ldf(A + arow * p.lda + k0 + ak + j);
            }
            float bv[4] = {0.f, 0.f, 0.f, 0.f};
            int bk, bn;
            if (BT) { bn = tid >> 1; bk = (tid & 1) * 4;
                if (n0 + bn < p.N) {
#pragma unroll
                    for (int j = 0; j < 4; ++j) bv[j] = ldf(B + (size_t)(n0 + bn) * p.ldb + k0 + bk + j); }
            } else { bk = tid >> 5; bn = (tid & 31) * 4;
                if (n0 + bn < p.N) {
#pragma unroll
                    for (int j = 0; j < 4; ++j) bv[j] = ldf(B + (size_t)(k0 + bk) * p.ldb + n0 + bn + j); }
            }
            __syncthreads();
#pragma unroll
            for (int j = 0; j < 4; ++j) As[ak + j][ar] = av[j];
            if (BT) {
#pragma unroll
                for (int j = 0; j < 4; ++j) Bs[bk + j][bn] = bv[j];
            } else {
#pragma unroll
                for (int j = 0; j < 4; ++j) Bs[bk][bn + j] = bv[j];
            }
            __syncthreads();
#pragma unroll
            for (int k = 0; k < 8; ++k) {
                float a[8], b[8];
#pragma unroll
                for (int i = 0; i < 8; ++i) a[i] = As[k][ty * 8 + i];
#pragma unroll
                for (int j = 0; j < 8; ++j) b[j] = Bs[k][tx * 8 + j];
#pragma unroll
                for (int i = 0; i < 8; ++i)
#pragma unroll
                    for (int j = 0; j < 8; ++j) acc[i][j] += a[i] * b[j];
            }
        }
#pragma unroll
        for (int i = 0; i < 8; ++i) {
            const int m = m0 + ty * 8 + i;
            if (m < M) {
#pragma unroll
                for (int j = 0; j < 8; ++j) { const int n = n0 + tx * 8 + j; if (n < p.N) epi(z, rbase + m, n, acc[i][j]); }
            }
        }
        __syncthreads();
    }
}
template <typename TA_, typename TB_, bool BT, class Epi>
static void gemm(hipStream_t st, const GemmP& p, const Epi& e, int gy, int gz) {
    dim3 g((p.N + 127) / 128, gy, gz);
    hipLaunchKernelGGL((gemm_k<TA_, TB_, BT, Epi>), g, dim3(256), 0, st, p, e);
}

struct EpiSeqB { bf16* C; int ldc, pad; __device__ void operator()(int, int m, int n, float v) const { const int sr = m < T ? seqrow_lat(m) : seqrow_ctx(m - T); C[(size_t)sr * ldc + n] = f2bf(v); } };
struct EpiSigB { bf16* C; int ldc, pad; __device__ void operator()(int, int m, int n, float v) const { C[(size_t)m * ldc + n] = f2bf(sigmoidf_(v)); } };
struct EpiGates { float* GATES; const float *b_i, *b_f;
    __device__ void operator()(int, int m, int n, float v) const { const int sr = m < T ? seqrow_lat(m) : seqrow_ctx(m - T);
        float r; if (n < 8) r = v + b_i[n]; else { const float x = v + b_f[n - 8]; r = fminf(x, 0.f) - log1pf(__expf(-fabsf(x))); }
        GATES[(size_t)sr * 16 + n] = r; } };
struct EpiScore { float* Sc; __device__ void operator()(int z, int m, int n, float v) const { Sc[((size_t)z * S + m) * SL + n] = v * 0.125f; } };
struct EpiPV { bf16* AM; int b, pad; __device__ void operator()(int z, int m, int n, float v) const { AM[((size_t)b * S + m) * D + z * HD + n] = f2bf(v); } };
struct EpiMergeA { float* Y; const bf16* GA; __device__ void operator()(int, int m, int n, float v) const { Y[(size_t)m * D + n] = bf2f(GA[(size_t)m * D + n]) * v; } };
struct EpiMergeM { float* Y; const bf16* GM; __device__ void operator()(int, int m, int n, float v) const { float& y = Y[(size_t)m * D + n]; y = y + bf2f(GM[(size_t)m * D + n]) * v; } };
struct EpiStoreF { float* C; int ldc, pad; __device__ void operator()(int, int m, int n, float v) const { C[(size_t)m * ldc + n] = v; } };
struct EpiStoreB { bf16* C; int ldc, pad; __device__ void operator()(int, int m, int n, float v) const { C[(size_t)m * ldc + n] = f2bf(v); } };
struct EpiSwiglu { bf16* H; int ldc, pad; __device__ void operator()(int, int m, int n, float v) const { bf16& h = H[(size_t)m * ldc + n]; h = f2bf(siluf_(bf2f(h)) * v); } };
struct EpiScatterAdd { float* FX; const int* list; const float* ew; __device__ void operator()(int, int m, int n, float v) const { const int a = list[m]; atomicAdd(&FX[(size_t)(a >> 3) * D + n], ew[a] * v); } };
struct EpiAddF { float* C; int ldc, pad; __device__ void operator()(int, int m, int n, float v) const { C[(size_t)m * ldc + n] += v; } };

__global__ void k_mod(const float* c, const float* c_ctx, const float* w_ada, const float* b_ada, float* mod) {
    const int j = blockIdx.x * blockDim.x + threadIdx.x, r = blockIdx.y;
    if (j >= NMOD * D) return;
    const float* cv = r < NB ? c + (size_t)r * D : c_ctx;
    float s = 0.f;
    for (int k = 0; k < D; ++k) s += siluf_(cv[k]) * w_ada[(size_t)k * (NMOD * D) + j];
    mod[(size_t)r * (NMOD * D) + j] = s + b_ada[j];
}
__global__ void k_norm_mod(const float* x, const float* ctx, const float* g, const float* mod, bf16* out, int sh_off, int sc_off, int nrows, int pad) {
    const int row = blockIdx.x * (blockDim.x >> 6) + (threadIdx.x >> 6), lane = threadIdx.x & 63;
    if (row >= nrows) return;
    const float* xr = row < T ? x + (size_t)row * D : ctx + (size_t)(row - T) * D;
    const float* mr = mod + (size_t)(row < T ? row / S : NB) * (NMOD * D);
    float v[16]; float ss = 0.f;
#pragma unroll
    for (int j = 0; j < 16; ++j) { v[j] = xr[lane + 64 * j]; ss += v[j] * v[j]; }
    const float rs = rsqrtf(wave_sum(ss) * (1.f / D) + EPS);
#pragma unroll
    for (int j = 0; j < 16; ++j) { const int c = lane + 64 * j; out[(size_t)row * D + c] = f2bf(v[j] * rs * g[c] * (1.f + mr[sc_off + c]) + mr[sh_off + c]); }
}
__global__ void k_qk_norm_rope(bf16* X, const float* g, int ld, int nheads, int nrows, int mode  ) {
    const int idx = blockIdx.x * (blockDim.x >> 6) + (threadIdx.x >> 6), lane = threadIdx.x & 63;
    if (idx >= nrows * nheads) return;
    const int row = idx / nheads, h = idx % nheads;
    bf16* p = X + (size_t)row * ld + h * HD;
    const float v = bf2f(p[lane]);
    const float rs = rsqrtf(wave_sum(v * v) * (1.f / HD) + EPS);
    const float y = v * rs * g[lane];
    int t = -1;
    if (mode == 0) t = row % S; else { const int pos = row % SL; if (pos >= CL) t = pos - CL; }
    float o = y;
    if (t >= 0) {
        const int axis = lane >> 5, half = (lane >> 4) & 1, f = lane & 15;
        const float pos = axis == 0 ? (float)(t / 64) : (float)(t % 64);
        const float inv = powf(10000.f, -(float)f / 16.f);
        const float ang = pos * inv, cs = cosf(ang), sn = sinf(ang);
        const float other = __shfl_xor(y, 16);
        o = half == 0 ? y * cs - other * sn : y * cs + other * sn;
    }
    p[lane] = f2bf(o);
}
__global__ void k_softmax(float* Sc, int ncols, int pad) {
    const size_t row = (size_t)blockIdx.x * (blockDim.x >> 6) + (threadIdx.x >> 6); const int lane = threadIdx.x & 63;
    float* r = Sc + row * ncols;
    float mx = -INFINITY;
    for (int c = lane; c < ncols; c += 64) mx = fmaxf(mx, r[c]);
#pragma unroll
    for (int o = 1; o < 64; o <<= 1) mx = fmaxf(mx, __shfl_xor(mx, o));
    float s = 0.f;
    for (int c = lane; c < ncols; c += 64) { const float e = __expf(r[c] - mx); r[c] = e; s += e; }
    s = 1.f / wave_sum(s);
    for (int c = lane; c < ncols; c += 64) r[c] *= s;
}
__global__ void k_conv(const bf16* MQ, const bf16* MK, const float* cw, const float* cb, bf16* QC, bf16* KC) {
    const size_t i = (size_t)blockIdx.x * blockDim.x + threadIdx.x;
    if (i >= (size_t)TA * 1024) return;
    const int sr = (int)(i / 1024), ch = (int)(i % 1024), pos = sr % SL;
    const bf16* src = ch < 512 ? MQ : MK; const int c = ch & 511;
    const int lo = pos < CL ? 0 : CL, hi = pos < CL ? CL : SL;
    float s = cb[ch];
#pragma unroll
    for (int j = 0; j < 3; ++j) { const int pp = pos + j - 1; if (pp >= lo && pp < hi) s += bf2f(src[(size_t)(sr + j - 1) * MW + c]) * cw[j * 1024 + ch]; }
    s = siluf_(s);
    if (ch < 512) QC[(size_t)sr * MW + c] = f2bf(s * 0.08838834764831845f); else KC[(size_t)sr * MW + c] = f2bf(s);
}
__global__ __launch_bounds__(256) void k_mlstm(const bf16* QC, const bf16* KC, const bf16* MV, const float* GATES, float* HH) {
    const int b = blockIdx.x / 8, head = (blockIdx.x / 2) % 4, dir = blockIdx.x & 1, tid = threadIdx.x;
    __shared__ float qs[128], ks[128], vs[128];
    float C[64], nv[64];
#pragma unroll
    for (int i = 0; i < 64; ++i) { C[i] = 0.f; nv[i] = 0.f; }
    float m = 0.f;
    const int v = tid >> 1, dh = (tid & 1) * 64;
    for (int step = 0; step < SL; ++step) {
        int pos;
        if (step < CL) pos = dir == 0 ? step : CL - 1 - step; else { const int t = step - CL; pos = CL + (dir == 0 ? t : S - 1 - t); }
        const size_t sr = (size_t)b * SL + pos;
        __syncthreads();
        if (tid < 128) { qs[tid] = bf2f(QC[sr * MW + head * MD + tid]); ks[tid] = bf2f(KC[sr * MW + head * MD + tid]); }
        else { const int j = tid - 128; vs[j] = bf2f(MV[sr * MW + head * MD + j]); }
        const float li = GATES[sr * 16 + dir * 4 + head], lf = GATES[sr * 16 + 8 + dir * 4 + head];
        __syncthreads();
        const float mn = fmaxf(lf + m, li), fw = __expf(lf + m - mn), iw = __expf(li - mn);
        m = mn;
        const float vv = vs[v] * iw;
        float num = 0.f, den = 0.f;
#pragma unroll
        for (int i = 0; i < 64; ++i) { const float kk = ks[dh + i], qq = qs[dh + i]; C[i] = fw * C[i] + vv * kk; nv[i] = fw * nv[i] + iw * kk; num += C[i] * qq; den += nv[i] * qq; }
        num += __shfl_xor(num, 1); den += __shfl_xor(den, 1);
        if (step >= CL && (tid & 1) == 0) {
            const int t = pos - CL;
            HH[((size_t)dir * T + (size_t)b * S + t) * MW + head * MD + v] = num / fmaxf(fabsf(den), __expf(-mn));
        }
    }
}
__global__ void k_mlstm_out(const float* HH, const bf16* MO, const float* g, bf16* AM) {
    const int idx = blockIdx.x * (blockDim.x >> 6) + (threadIdx.x >> 6), lane = threadIdx.x & 63;
    if (idx >= T * MH) return;
    const int row = idx / MH, h = idx % MH;
    float v[2]; float ss = 0.f;
#pragma unroll
    for (int j = 0; j < 2; ++j) { const size_t o = (size_t)row * MW + h * MD + lane + 64 * j; v[j] = HH[o] + HH[(size_t)T * MW + o]; ss += v[j] * v[j]; }
    const float rs = rsqrtf(wave_sum(ss) * (1.f / MD) + EPS);
#pragma unroll
    for (int j = 0; j < 2; ++j) { const int c = h * MD + lane + 64 * j; AM[(size_t)row * D + AW + c] = f2bf(v[j] * rs * g[c] * sigmoidf_(bf2f(MO[(size_t)row * MW + c]))); }
}
__global__ void k_post_mix(const float* x, const float* YO, const float* g_post, const float* g_pre_ffn, const float* mod, float* out, bf16* FIN) {
    const int row = blockIdx.x * (blockDim.x >> 6) + (threadIdx.x >> 6), lane = threadIdx.x & 63;
    if (row >= T) return;
    const float* mr = mod + (size_t)(row / S) * (NMOD * D);
    float v[16]; float ss = 0.f;
#pragma unroll
    for (int j = 0; j < 16; ++j) { v[j] = YO[(size_t)row * D + lane + 64 * j]; ss += v[j] * v[j]; }
    const float rs = rsqrtf(wave_sum(ss) * (1.f / D) + EPS);
    float ss2 = 0.f;
#pragma unroll
    for (int j = 0; j < 16; ++j) { const int c = lane + 64 * j; v[j] = x[(size_t)row * D + c] + mr[2 * D + c] * (v[j] * rs * g_post[c]); out[(size_t)row * D + c] = v[j]; ss2 += v[j] * v[j]; }
    const float rs2 = rsqrtf(wave_sum(ss2) * (1.f / D) + EPS);
#pragma unroll
    for (int j = 0; j < 16; ++j) { const int c = lane + 64 * j; FIN[(size_t)row * D + c] = f2bf(v[j] * rs2 * g_pre_ffn[c] * (1.f + mr[4 * D + c]) + mr[3 * D + c]); }
}
__global__ void k_topk(const float* SCORE, const float* e_bias, int* EIDX, float* EW, int* cnt) {
    const int tok = blockIdx.x * blockDim.x + threadIdx.x;
    if (tok >= T) return;
    const float* sr = SCORE + (size_t)tok * NE;
    float gs[NG];
    for (int g = 0; g < NG; ++g) { float a = -INFINITY, b = -INFINITY;
        for (int j = 0; j < 32; ++j) { const float s = sigmoidf_(sr[g * 32 + j]) + e_bias[g * 32 + j]; if (s > a) { b = a; a = s; } else if (s > b) b = s; }
        gs[g] = a + b; }
    unsigned gmask = 0;
    for (int r = 0; r < TKG; ++r) { int best = -1; float bv = -INFINITY; for (int g = 0; g < NG; ++g) if (!((gmask >> g) & 1u) && gs[g] > bv) { bv = gs[g]; best = g; } gmask |= 1u << best; }
    int sel[TOPK]; float sw[TOPK]; float wsum = 0.f;
    for (int r = 0; r < TOPK; ++r) { int best = -1; float bv = -INFINITY;
        for (int e = 0; e < NE; ++e) { if (!((gmask >> (e >> 5)) & 1u)) continue; bool used = false; for (int q = 0; q < r; ++q) used |= (sel[q] == e); if (used) continue;
            const float s = sigmoidf_(sr[e]) + e_bias[e]; if (s > bv) { bv = s; best = e; } }
        sel[r] = best; sw[r] = sigmoidf_(sr[best]); wsum += sw[r]; }
    for (int r = 0; r < TOPK; ++r) { EIDX[tok * TOPK + r] = sel[r]; EW[tok * TOPK + r] = sw[r] / wsum * RSCALE; atomicAdd(&cnt[sel[r]], 1); }
}
__global__ void k_scan(int* ctl) { if (threadIdx.x == 0) { int s = 0; for (int e = 0; e < NE; ++e) { ctl[CW_OFF + e] = s; s += ctl[CW_CNT + e]; } ctl[CW_OFF + NE] = s; } }
__global__ void k_scatter(const int* EIDX, int* ctl, int* LIST) {
    const int a = blockIdx.x * blockDim.x + threadIdx.x;
    if (a >= T * TOPK) return;
    const int e = EIDX[a]; const int p = atomicAdd(&ctl[CW_FILL + e], 1);
    LIST[ctl[CW_OFF + e] + p] = a;
}
__global__ void k_final(const float* FX, const float* g_post_ffn, const float* mod, float* out) {
    const int row = blockIdx.x * (blockDim.x >> 6) + (threadIdx.x >> 6), lane = threadIdx.x & 63;
    if (row >= T) return;
    const float* mr = mod + (size_t)(row / S) * (NMOD * D);
    float v[16]; float ss = 0.f;
#pragma unroll
    for (int j = 0; j < 16; ++j) { v[j] = FX[(size_t)row * D + lane + 64 * j]; ss += v[j] * v[j]; }
    const float rs = rsqrtf(wave_sum(ss) * (1.f / D) + EPS);
#pragma unroll
    for (int j = 0; j < 16; ++j) { const int c = lane + 64 * j; out[(size_t)row * D + c] += mr[5 * D + c] * (v[j] * rs * g_post_ffn[c]); }
}

extern "C" void kernel_launch(void* const* d_in, const int* in_sizes, int n_in, void* d_out, int out_size, void* d_ws, size_t ws_size, hipStream_t st) {
    const float* x = (const float*)d_in[0]; const float* c = (const float*)d_in[1]; const float* ctx = (const float*)d_in[2]; const float* c_ctx = (const float*)d_in[3];
    const float* w_ada = (const float*)d_in[4]; const float* b_ada = (const float*)d_in[5]; const float* g_pre_mix = (const float*)d_in[6]; const float* g_post_mix = (const float*)d_in[7];
    const float* g_pre_ffn = (const float*)d_in[8]; const float* g_post_ffn = (const float*)d_in[9]; const float* w_in = (const float*)d_in[10]; const float* g_q = (const float*)d_in[11];
    const float* g_k = (const float*)d_in[12]; const float* conv_w = (const float*)d_in[13]; const float* conv_b = (const float*)d_in[14]; const float* b_igate = (const float*)d_in[15];
    const float* b_fgate = (const float*)d_in[16]; const float* g_mlstm = (const float*)d_in[17]; const float* w_br_attn = (const float*)d_in[18]; const float* w_br_mlstm = (const float*)d_in[19];
    const float* w_out = (const float*)d_in[20]; const float* w_router = (const float*)d_in[21]; const float* e_bias = (const float*)d_in[22]; const float* w_eg = (const float*)d_in[23];
    const float* w_eu = (const float*)d_in[24]; const float* w_ed = (const float*)d_in[25]; const float* w_sg = (const float*)d_in[26]; const float* w_su = (const float*)d_in[27]; const float* w_sd = (const float*)d_in[28];
    float* out = (float*)d_out; unsigned char* ws = (unsigned char*)d_ws;
    if (n_in != 29 || ws_size < 1060 * MiB) { fprintf(stderr, "kernel_launch: unexpected n_in %d / ws_size %zu\n", n_in, ws_size); return; }
    int* ctl = (int*)(ws + WS_CTL); float* mod = (float*)(ws + WS_MOD); float* GATES = (float*)(ws + WS_GATES);
    bf16* A1 = (bf16*)(ws + WS_A1); bf16* Q = (bf16*)(ws + WS_Q); bf16* K = (bf16*)(ws + WS_K); bf16* V = (bf16*)(ws + WS_V);
    bf16* MQ = (bf16*)(ws + WS_MQ); bf16* MK = (bf16*)(ws + WS_MK); bf16* MV = (bf16*)(ws + WS_MV); bf16* MO = (bf16*)(ws + WS_MO);
    bf16* GA = (bf16*)(ws + WS_GA); bf16* GM = (bf16*)(ws + WS_GM); bf16* AM = (bf16*)(ws + WS_AM); float* SC = (float*)(ws + WS_SC);
    (void)hipMemsetAsync(ctl, 0, 1 * MiB, st);
    hipLaunchKernelGGL(k_mod, dim3(NMOD * D / 256, NB + 1), dim3(256), 0, st, c, c_ctx, w_ada, b_ada, mod);
    hipLaunchKernelGGL(k_norm_mod, dim3(TA / 4), dim3(256), 0, st, x, ctx, g_pre_mix, mod, A1, 0, D, TA, 0);
#define INPROJ(col, ncols, rows, EPI) { GemmP p = mkp(A1, w_in + (col), D, INW, rows, ncols, D, 0, 0, 1, nullptr, 0, nullptr, nullptr); gemm<bf16, float, false>(st, p, EPI, (rows) / 128, 1); }
    INPROJ(C_Q, AW, T, (EpiStoreB{Q, AW}));
    INPROJ(C_K, KVW, TA, (EpiSeqB{K, KVW}));
    INPROJ(C_V, KVW, TA, (EpiSeqB{V, KVW}));
    INPROJ(C_MQ, MW, TA, (EpiSeqB{MQ, MW}));
    INPROJ(C_MK, MW, TA, (EpiSeqB{MK, MW}));
    INPROJ(C_MV, MW, TA, (EpiSeqB{MV, MW}));
    INPROJ(C_MO, MW, T, (EpiStoreB{MO, MW}));
    INPROJ(C_MI, 16, TA, (EpiGates{GATES, b_igate, b_fgate}));
    INPROJ(C_GA, D, T, (EpiSigB{GA, D}));
    INPROJ(C_GM, D, T, (EpiSigB{GM, D}));
    hipLaunchKernelGGL(k_qk_norm_rope, dim3(T * AH / 4), dim3(256), 0, st, Q, g_q, AW, AH, T, 0);
    hipLaunchKernelGGL(k_qk_norm_rope, dim3(TA * AKV / 4), dim3(256), 0, st, K, g_k, KVW, AKV, TA, 1);
    for (int b = 0; b < NB; ++b) {
        { GemmP p = mkp(Q + (size_t)b * S * AW, K + (size_t)b * SL * KVW, AW, KVW, S, SL, HD, HD, HD, 4, nullptr, 0, nullptr, nullptr); EpiScore e{SC}; gemm<bf16, bf16, true>(st, p, e, S / 128, AH); }
        hipLaunchKernelGGL(k_softmax, dim3(AH * S / 4), dim3(256), 0, st, SC, SL, 0);
        { GemmP p = mkp(SC, V + (size_t)b * SL * KVW, SL, KVW, S, HD, SL, (long)S * SL, HD, 4, nullptr, 0, nullptr, nullptr); EpiPV e{AM, b}; gemm<float, bf16, false>(st, p, e, S / 128, AH); }
    }
    bf16* QC = (bf16*)(ws + WS_SC); bf16* KC = QC + (size_t)TA * MW;
    float* HH = (float*)(ws + WS_A1);
    hipLaunchKernelGGL(k_conv, dim3((unsigned)(((size_t)TA * 1024 + 255) / 256)), dim3(256), 0, st, MQ, MK, conv_w, conv_b, QC, KC);
    hipLaunchKernelGGL(k_mlstm, dim3(NB * MH * 2), dim3(256), 0, st, QC, KC, MV, GATES, HH);
    hipLaunchKernelGGL(k_mlstm_out, dim3(T * MH / 4), dim3(256), 0, st, HH, MO, g_mlstm, AM);
    float* Y = (float*)(ws + WS_Y); float* YO = (float*)(ws + WS_YO);
    { GemmP p = mkp(AM, w_br_attn, D, D, T, D, AW, 0, 0, 1, nullptr, 0, nullptr, nullptr); EpiMergeA e{Y, GA}; gemm<bf16, float, false>(st, p, e, T / 128, 1); }
    { GemmP p = mkp(AM + AW, w_br_mlstm, D, D, T, D, MW, 0, 0, 1, nullptr, 0, nullptr, nullptr); EpiMergeM e{Y, GM}; gemm<bf16, float, false>(st, p, e, T / 128, 1); }
    { GemmP p = mkp(Y, w_out, D, D, T, D, D, 0, 0, 1, nullptr, 0, nullptr, nullptr); EpiStoreF e{YO, D}; gemm<float, float, false>(st, p, e, T / 128, 1); }
    bf16* FIN = (bf16*)(ws + WS_FIN);
    hipLaunchKernelGGL(k_post_mix, dim3(T / 4), dim3(256), 0, st, x, YO, g_post_mix, g_pre_ffn, mod, out, FIN);
    float* SCORE = (float*)(ws + WS_SCORE); int* EIDX = (int*)(ws + WS_EIDX); float* EW = (float*)(ws + WS_EW); int* LIST = (int*)(ws + WS_LIST);
    bf16* HID = (bf16*)(ws + WS_HID); float* FX = (float*)(ws + WS_FX);
    { GemmP p = mkp(FIN, w_router, D, NE, T, NE, D, 0, 0, 1, nullptr, 0, nullptr, nullptr); EpiStoreF e{SCORE, NE}; gemm<bf16, float, false>(st, p, e, T / 128, 1); }
    hipLaunchKernelGGL(k_topk, dim3(T / 256), dim3(256), 0, st, SCORE, e_bias, EIDX, EW, ctl + CW_CNT);
    hipLaunchKernelGGL(k_scan, dim3(1), dim3(64), 0, st, ctl);
    hipLaunchKernelGGL(k_scatter, dim3(T * TOPK / 256), dim3(256), 0, st, EIDX, ctl, LIST);
    (void)hipMemsetAsync(FX, 0, (size_t)T * D * 4, st);
    { GemmP p = mkp(FIN, w_eg, D, EFF, 0, EFF, D, 0, (long)D * EFF, 1, LIST, 3, ctl + CW_CNT, ctl + CW_OFF); EpiStoreB e{HID, EFF}; gemm<bf16, float, false>(st, p, e, 8, NE); }
    { GemmP p = mkp(FIN, w_eu, D, EFF, 0, EFF, D, 0, (long)D * EFF, 1, LIST, 3, ctl + CW_CNT, ctl + CW_OFF); EpiSwiglu e{HID, EFF}; gemm<bf16, float, false>(st, p, e, 8, NE); }
    { GemmP p = mkp(HID, w_ed, EFF, D, 0, D, EFF, 0, (long)EFF * D, 1, nullptr, 0, ctl + CW_CNT, ctl + CW_OFF); EpiScatterAdd e{FX, LIST, EW}; gemm<bf16, float, false>(st, p, e, 8, NE); }
    { GemmP p = mkp(FIN, w_sg, D, EFF, T, EFF, D, 0, 0, 1, nullptr, 0, nullptr, nullptr); EpiStoreB e{HID, EFF}; gemm<bf16, float, false>(st, p, e, T / 128, 1); }
    { GemmP p = mkp(FIN, w_su, D, EFF, T, EFF, D, 0, 0, 1, nullptr, 0, nullptr, nullptr); EpiSwiglu e{HID, EFF}; gemm<bf16, float, false>(st, p, e, T / 128, 1); }
    { GemmP p = mkp(HID, w_sd, EFF, D, T, D, EFF, 0, 0, 1, nullptr, 0, nullptr, nullptr); EpiAddF e{FX, D}; gemm<bf16, float, false>(st, p, e, T / 128, 1); }
    hipLaunchKernelGGL(k_final, dim3(T / 4), dim3(256), 0, st, FX, g_post_ffn, mod, out);
}
```

```cpp
#include <hip/hip_runtime.h>
#include <cstdio>
#include <cstdint>
#include <cstring>

constexpr int D = 1024, NB = 32, S = 2048, CL = 256, T = NB * S, TC = NB * CL, TA = T + TC, SL = S + CL;
constexpr int NMOD = 6, INW = 4880;
constexpr int AH = 8, AKV = 2, HD = 64, AW = 512, KVW = 128;
constexpr int MH = 4, MD = 128, MW = 512, MCH = 64;
constexpr int NE = 256, TOPK = 8, NG = 8, TKG = 4, EFF = 256;
constexpr float EPS = 1e-6f, RSCALE = 2.5f;
constexpr int C_Q = 0, C_K = 512, C_V = 640, C_MQ = 768, C_MK = 1280, C_MV = 1792, C_MO = 2304, C_MI = 2816, C_MF = 2824, C_GA = 2832, C_GM = 3856;
constexpr int N1 = 4864;

typedef unsigned short bf16;
typedef short bf16x8 __attribute__((ext_vector_type(8)));
typedef float f32x4 __attribute__((ext_vector_type(4)));
typedef float f32x2 __attribute__((ext_vector_type(2)));
typedef unsigned u32x4 __attribute__((ext_vector_type(4)));
typedef unsigned u32x2 __attribute__((ext_vector_type(2)));
#define LAS __attribute__((address_space(3)))
#define GAS __attribute__((address_space(1)))
__device__ __forceinline__ float bf2f(bf16 b) { return __uint_as_float(((unsigned)b) << 16); }
__device__ __forceinline__ bf16 f2bf(float f) { unsigned u = __float_as_uint(f); u += 0x7fffu + ((u >> 16) & 1u); return (bf16)(u >> 16); }
__device__ __forceinline__ unsigned cvt_pk_bf16(float lo, float hi) { unsigned r; asm volatile("v_cvt_pk_bf16_f32 %0, %1, %2" : "=v"(r) : "v"(lo), "v"(hi)); return r; }
__device__ __forceinline__ float ldf(const float* p) { return *p; }
__device__ __forceinline__ float ldf(const bf16* p) { return bf2f(*p); }
__device__ __forceinline__ float sigmoidf_(float x) { return 1.f / (1.f + __expf(-x)); }
__device__ __forceinline__ float siluf_(float x) { return x / (1.f + __expf(-x)); }
__device__ __forceinline__ float wave_sum(float v) {
#pragma unroll
    for (int o = 1; o < 64; o <<= 1) v += __shfl_xor(v, o);
    return v;
}
__device__ __forceinline__ int seqrow_lat(int r) { const int b = r / S, t = r % S; return b * SL + CL + t; }
__device__ __forceinline__ int seqrow_ctx(int r) { const int b = r / CL, t = r % CL; return b * SL + t; }

constexpr size_t MiB = 1u << 20;
constexpr size_t WS_CTL = 0, CTL_ZERO_BYTES = 1 * MiB;
constexpr size_t WS_MOD = 1 * MiB;
constexpr size_t WS_GATES = 2 * MiB;
constexpr size_t WS_ROPE = 7 * MiB;
constexpr size_t WS_BT1 = 8 * MiB;
constexpr size_t WS_WAT = 18 * MiB;
constexpr size_t WS_WMT = 19 * MiB;
constexpr size_t WS_WOT = 20 * MiB;
constexpr size_t WS_WRT = 22 * MiB;
constexpr size_t WS_WSGU = 23 * MiB;
constexpr size_t WS_WSD = 24 * MiB;
constexpr size_t WS_RS1 = 25 * MiB;
constexpr size_t WS_RS2 = 29 * MiB;
constexpr size_t WS_TOPI = 33 * MiB;
constexpr size_t WS_TOPW = 35 * MiB;
constexpr size_t WS_LIST = 37 * MiB;
constexpr size_t WS_LISTW = 40 * MiB;
constexpr size_t WS_TILE = 43 * MiB;
constexpr size_t WS_RA = 44 * MiB;
constexpr size_t WS_RW = 188 * MiB;
constexpr size_t WS_GA = 572 * MiB;
constexpr size_t WS_GM = 700 * MiB;
constexpr size_t WS_Q = 828 * MiB;
constexpr size_t WS_MO = 892 * MiB;
constexpr size_t WS_H = 956 * MiB;
constexpr size_t WS_NEED = 1084 * MiB;
constexpr size_t DO_MQ = 0, DO_MK = 72 * MiB, DO_MV = 144 * MiB, DO_K = 216 * MiB, DO_V = 234 * MiB;
constexpr int CW_CNT = 0;
constexpr int CW_OFF = 256;
constexpr int CW_FILL = 1024;
constexpr int CW_BAR = 4096;
constexpr int RING_BYTES = 131072, LDSCTL_OFF = 143360  , LDS_BYTES = 147456;
constexpr int NWAVES = 8;
namespace eng {
constexpr int BM = 256, BK = 64, HALF = 128, HTB = HALF * BK * 2, STAGE_BYTES = 8 * HTB;
__host__ __device__ __forceinline__ int lds_byte(int r, int c) { const int st = (r >> 4) * 2 + (c >> 5), rr = r & 15, cc = c & 31, ob = rr * 64 + cc * 2; return st * 1024 + (ob ^ (((ob >> 9) & 1) << 5)); }
__host__ __device__ __forceinline__ void stage_rc(int b, int& R, int& C) { const int st = b / 1024, sb = b % 1024, swz = sb ^ (((sb >> 9) & 1) << 5); R = (st >> 1) * 16 + swz / 64; C = (st & 1) * 32 + (swz % 64) / 2; }
__host__ __device__ __forceinline__ int perm32(int rho) { const int n = rho >> 4, i = rho & 15; return 8 * (i >> 2) + 4 * n + (i & 3); }

struct UnitD { const char* A; const char* B; unsigned lda, ldb; int nt, type, r0, r1, r2, r3; };

typedef f32x4 Acc[2][2][4][2];

template <class Prog, int AUX_A>
__device__ __forceinline__ void gemm_stream(LAS unsigned char* lds, const Prog& P) {
    int tid = threadIdx.x; asm volatile("" : "+v"(tid));
    const int wid = __builtin_amdgcn_readfirstlane(tid >> 6), lane = tid & 63, wr = wid >> 2, wc = wid & 3, fr = lane & 15, fq = lane >> 4;
    int Rr[2], Cc[2], Rb[2];
#pragma unroll
    for (int i = 0; i < 2; ++i) { int R, C; stage_rc(tid * 16 + i * 8192, R, C); Rr[i] = R; Cc[i] = C * 2; Rb[i] = (R & ~31) + perm32(R & 31); }
    const size_t kstep = (size_t)(BK * 2);
    const unsigned ldsw = (unsigned)wid * 1024u;
    const int aoff = lds_byte(wr * 64 + fr, fq * 8), boff = lds_byte(wc * 32 + fr, fq * 8);
#define EG_SA(b, h) (((b) * 2 + (h)) * HTB)
#define EG_SB(b, h) ((4 + (b) * 2 + (h)) * HTB)
#define EG_STAGE_B(bufoff, gbase) do { _Pragma("unroll") for (int _i = 0; _i < 2; ++_i) \
        __builtin_amdgcn_global_load_lds((const unsigned*)((const char*)(gbase) + oB[_i]), (LAS unsigned*)(lds + (bufoff) + ldsw + _i * 8192), 16, 0, 0); } while (0)
#define EG_STAGE_A(bufoff, gbase, h) do { _Pragma("unroll") for (int _i = 0; _i < 2; ++_i) \
        __builtin_amdgcn_global_load_lds((const unsigned*)((const char*)(gbase) + oA[h][_i]), (LAS unsigned*)(lds + (bufoff) + ldsw + _i * 8192), 16, 0, AUX_A); } while (0)
#define EG_LDA(dst, b, h) do { _Pragma("unroll") for (int m = 0; m < 4; ++m) _Pragma("unroll") for (int k = 0; k < 2; ++k) dst[m][k] = *(const LAS bf16x8*)(lds + EG_SA(b, h) + aoff + m * 2048 + k * 1024); } while (0)
#define EG_LDB(dst, b, h) do { _Pragma("unroll") for (int n = 0; n < 2; ++n) _Pragma("unroll") for (int k = 0; k < 2; ++k) dst[n][k] = *(const LAS bf16x8*)(lds + EG_SB(b, h) + boff + n * 2048 + k * 1024); } while (0)
#define EG_MMA(ai, bj, At, Bt) do { __builtin_amdgcn_s_setprio(1); _Pragma("unroll") for (int m = 0; m < 4; ++m) _Pragma("unroll") for (int n = 0; n < 2; ++n) _Pragma("unroll") for (int k = 0; k < 2; ++k) \
        acc[ai][bj][m][n] = __builtin_amdgcn_mfma_f32_16x16x32_bf16(Bt[n][k], At[m][k], acc[ai][bj][m][n], 0, 0, 0); __builtin_amdgcn_s_setprio(0); } while (0)
#define EG_WAIT_V(n) asm volatile("s_waitcnt vmcnt(" #n ")" ::: "memory")
#define EG_WAIT_L(n) asm volatile("s_waitcnt lgkmcnt(" #n ")" ::: "memory")
#define EG_BAR __builtin_amdgcn_s_barrier()
#define EG_SCHED __builtin_amdgcn_sched_barrier(0)
    UnitD cur, nxt; int ui = 0;
    if (!P.next(0, cur, lds)) return;
    Acc acc;
#pragma unroll
    for (int a = 0; a < 2; ++a)
#pragma unroll
        for (int b = 0; b < 2; ++b)
#pragma unroll
            for (int m = 0; m < 4; ++m)
#pragma unroll
                for (int n = 0; n < 2; ++n) acc[a][b][m][n] = (f32x4){0.f, 0.f, 0.f, 0.f};
    bf16x8 At[4][2], B0[2][2], B1[2][2];
    unsigned oA[2][2], oB[2];
    P.first(cur, lds);
    P.offsets(cur, Rr, Cc, oA, lds);
#pragma unroll
    for (int i = 0; i < 2; ++i) oB[i] = (unsigned)Rb[i] * cur.ldb + (unsigned)Cc[i];
    const char* cA = cur.A; const char* cB = cur.B; size_t hB = (size_t)HALF * cur.ldb;
    EG_STAGE_B(EG_SB(0, 0), cB); EG_STAGE_B(EG_SB(0, 1), cB + hB); EG_STAGE_A(EG_SA(0, 0), cA, 0); EG_STAGE_A(EG_SA(0, 1), cA, 1);
    if (wr == 1) EG_BAR;
    EG_WAIT_V(2); EG_BAR;
    EG_STAGE_B(EG_SB(1, 0), cB + kstep); EG_STAGE_A(EG_SA(1, 0), cA + kstep, 0); EG_STAGE_B(EG_SB(1, 1), cB + hB + kstep);
    EG_WAIT_V(6); EG_BAR;
    for (;;) {
        const bool has_next = P.next(ui + 1, nxt, lds);
        if (has_next) P.prefetch(nxt, lds);
        const int nt = cur.nt;
        for (int t = 0; t < nt; t += 2) {
            const bool last = (t == nt - 2);
            EG_LDB(B0, 0, 0); EG_LDB(B1, 0, 1); EG_SCHED; EG_LDA(At, 0, 0); EG_STAGE_A(EG_SA(1, 1), cA + (size_t)(t + 1) * kstep, 1);
            EG_WAIT_V(8); EG_WAIT_L(0); EG_BAR; EG_MMA(0, 0, At, B0); EG_MMA(0, 1, At, B1); EG_BAR; EG_SCHED;
            const char *a2, *b2;
            if (last) {
                if (has_next) {
                    P.offsets(nxt, Rr, Cc, oA, lds);
#pragma unroll
                    for (int i = 0; i < 2; ++i) oB[i] = (unsigned)Rb[i] * nxt.ldb + (unsigned)Cc[i];
                    cA = nxt.A; cB = nxt.B; hB = (size_t)HALF * nxt.ldb;
                }
                a2 = cA; b2 = cB;
            } else { a2 = cA + (size_t)(t + 2) * kstep; b2 = cB + (size_t)(t + 2) * kstep; }
            const char* a3 = a2 + kstep; const char* b3 = b2 + kstep;
            EG_LDA(At, 0, 1); EG_STAGE_B(EG_SB(0, 0), b2); EG_STAGE_B(EG_SB(0, 1), b2 + hB); EG_STAGE_A(EG_SA(0, 0), a2, 0);
            EG_WAIT_V(8); EG_WAIT_L(0); EG_BAR; EG_MMA(1, 0, At, B0); EG_MMA(1, 1, At, B1); EG_BAR; EG_SCHED;
            EG_LDB(B0, 1, 0); EG_LDB(B1, 1, 1); EG_SCHED; EG_LDA(At, 1, 0); EG_STAGE_A(EG_SA(0, 1), a2, 1);
            EG_WAIT_V(8); EG_WAIT_L(0); EG_BAR; EG_MMA(0, 0, At, B0); EG_MMA(0, 1, At, B1); EG_BAR; EG_SCHED;
            EG_LDA(At, 1, 1); EG_STAGE_B(EG_SB(1, 0), b3); EG_STAGE_B(EG_SB(1, 1), b3 + hB); EG_STAGE_A(EG_SA(1, 0), a3, 0);
            EG_WAIT_V(8); EG_WAIT_L(0); EG_BAR; EG_MMA(1, 0, At, B0); EG_MMA(1, 1, At, B1); EG_BAR; EG_SCHED;
        }
        if (wr == 0) EG_BAR;
        P.epilogue(acc, cur, wr, wc, fr, fq, lds);
        if (!has_next) break;
#pragma unroll
        for (int a = 0; a < 2; ++a)
#pragma unroll
            for (int b = 0; b < 2; ++b)
#pragma unroll
                for (int m = 0; m < 4; ++m)
#pragma unroll
                    for (int n = 0; n < 2; ++n) acc[a][b][m][n] = (f32x4){0.f, 0.f, 0.f, 0.f};
        cur = nxt; ++ui;
        if (wr == 1) EG_BAR;
    }
    EG_WAIT_V(0);
    EG_BAR;
#undef EG_SA
#undef EG_SB
#undef EG_STAGE_A
#undef EG_STAGE_B
#undef EG_LDA
#undef EG_LDB
#undef EG_MMA
#undef EG_WAIT_V
#undef EG_WAIT_L
#undef EG_BAR
#undef EG_SCHED
}
template <int ACT  >
__device__ __forceinline__ void store_tile_bf16(const Acc& acc, bf16* dst, size_t ld) {
#pragma unroll
    for (int ai = 0; ai < 2; ++ai)
#pragma unroll
        for (int m = 0; m < 4; ++m) { bf16* rowp = dst + (size_t)(ai * HALF + m * 16) * ld;
#pragma unroll
            for (int bj = 0; bj < 2; ++bj) { f32x4 v0 = acc[ai][bj][m][0], v1 = acc[ai][bj][m][1];
                if (ACT == 1) {
#pragma unroll
                    for (int e = 0; e < 4; ++e) { v0[e] = sigmoidf_(v0[e]); v1[e] = sigmoidf_(v1[e]); } }
                u32x4 w; w.x = cvt_pk_bf16(v0[0], v0[1]); w.y = cvt_pk_bf16(v0[2], v0[3]); w.z = cvt_pk_bf16(v1[0], v1[1]); w.w = cvt_pk_bf16(v1[2], v1[3]);
                *(u32x4*)(rowp + bj * HALF) = w; } }
}
}
#define RLX_AGENT __ATOMIC_RELAXED, __HIP_MEMORY_SCOPE_AGENT
#define LDS_WAIT() asm volatile("s_waitcnt lgkmcnt(0)" ::: "memory")
#define VM_WAIT() asm volatile("s_waitcnt vmcnt(0)" ::: "memory")
#define XB_TMO      128
#define XB_XCNT(j)  (256  + 64 * (j))
#define XB_XSUB(j)  (1280 + 64 * (j))
#define XB_XGEN(j)  (2304 + 64 * (j))
#define XB_TOP      3328
#define XB_TOPGEN   3392
#define XCD_BAR_WORDS 3456
#define XB_SPIN_CAP (1u << 18)

__device__ __forceinline__ unsigned xb_ld(unsigned* p)              { return __hip_atomic_load(p, __ATOMIC_RELAXED, __HIP_MEMORY_SCOPE_AGENT); }
__device__ __forceinline__ unsigned xb_add(unsigned* p, unsigned v) { return __hip_atomic_fetch_add(p, v, __ATOMIC_RELAXED, __HIP_MEMORY_SCOPE_AGENT); }
__device__ __forceinline__ unsigned xb_xcc_id() { return (unsigned)__builtin_amdgcn_s_getreg((3 << 11) | 20) & 0xFu; }
#define XB_SPIN(cond, bar) do { unsigned _sp = 0; while (cond) { __builtin_amdgcn_s_sleep(1); \
    if ((++_sp & 255u) == 0u) { if (xb_ld(&(bar)[XB_TMO])) break; if (_sp > XB_SPIN_CAP) { atomicAdd(&(bar)[XB_TMO], 1u); break; } } } } while (0)

struct XcdBarrier {
    unsigned* bar; unsigned x;
    volatile LAS unsigned* st;
};

__device__ __forceinline__ XcdBarrier xcd_barrier_post(unsigned* bar, volatile LAS unsigned* st) {
    XcdBarrier b; b.bar = bar; b.x = xb_xcc_id(); b.st = st;
    if (threadIdx.x == 0) (void)xb_add(&bar[XB_XCNT(b.x)], 1u);
    return b;
}
__device__ __forceinline__ void xcd_barrier_complete(unsigned* bar, unsigned x, unsigned& nloc, unsigned& nx) {
    const unsigned G = gridDim.x * gridDim.y * gridDim.z;
    unsigned sum, cnt, mine, sp = 0u;
    for (;;) {
        sum = 0u; cnt = 0u; mine = 0u;
#pragma unroll
        for (unsigned j = 0; j < 16; ++j) { const unsigned c = xb_ld(&bar[XB_XCNT(j)]); sum += c; cnt += (c > 0u) ? 1u : 0u; mine = (j == x) ? c : mine; }
        if (sum == G) break;
        __builtin_amdgcn_s_sleep(1);
        if ((++sp & 255u) == 0u) { if (xb_ld(&bar[XB_TMO])) break; if (sp > XB_SPIN_CAP) { atomicAdd(&bar[XB_TMO], 1u); break; } }
    }
    nloc = mine > 0u ? mine : 1u; nx = cnt > 0u ? cnt : 1u;
}

__device__ __forceinline__ void xcd_barrier(const XcdBarrier& b) {
    asm volatile("s_waitcnt vmcnt(0)" ::: "memory");
    __syncthreads();
    if (threadIdx.x == 0) {
        unsigned* bar = b.bar;
        __builtin_amdgcn_s_waitcnt(0);
        unsigned nloc = b.st[0], nx = b.st[1];
        if (nloc == 0u) { xcd_barrier_complete(bar, b.x, nloc, nx); b.st[0] = nloc; b.st[1] = nx; }
        const unsigned old = xb_add(&bar[XB_XSUB(b.x)], 1u);
        const unsigned gen = old / nloc;
        if (old + 1u == (gen + 1u) * nloc) {
            __builtin_amdgcn_fence(__ATOMIC_RELEASE, "agent");
            asm volatile("s_waitcnt vmcnt(0)" ::: "memory");
            const unsigned og = xb_add(&bar[XB_TOP], 1u);
            const unsigned tg = og / nx;
            if (og + 1u == (tg + 1u) * nx) xb_add(&bar[XB_TOPGEN], 1u);
            else XB_SPIN(xb_ld(&bar[XB_TOPGEN]) == tg, bar);
            __builtin_amdgcn_fence(__ATOMIC_ACQUIRE, "agent");
            xb_add(&bar[XB_XGEN(b.x)], 1u);
            asm volatile("s_waitcnt vmcnt(0)" ::: "memory");
        } else {
            XB_SPIN(xb_ld(&bar[XB_XGEN(b.x)]) == gen, bar);
            __builtin_amdgcn_fence(__ATOMIC_ACQUIRE, "agent");
            asm volatile("s_waitcnt vmcnt(0)" ::: "memory");
        }
    }
    __syncthreads();
}

struct Args { const float* in[29]; float* out; unsigned char* ws; int ph_lo, ph_hi; };
struct Frame {
    LAS unsigned char* lds;
    int vcu, G;
    unsigned char* ws; unsigned char* dout;
};
__device__ __forceinline__ int sigma_in(int np) {
    if (np < 768) { const int p = np & 255, bj = p >> 7, wc = (p >> 5) & 3, j = p & 31;
        if (np < 512) return C_Q + (4 * (np >> 8) + wc) * 64 + (j >> 4) * 32 + bj * 16 + (j & 15);
        if (wc < 2) return C_K + wc * 64 + (j >> 4) * 32 + bj * 16 + (j & 15);
        return C_V + (wc - 2) * 64 + bj * 32 + j; }
    return np < 2816 ? np : np + 16;
}
__device__ __forceinline__ void transpose_item(const float* W, size_t ldw, int k0, int scol, bf16* WT, size_t ldt, int n0, LAS float* scr, int lane) {
#pragma unroll 8
    for (int i = 0; i < 32; ++i) { const int kk = 2 * i + (lane >> 5); scr[kk * 33 + (lane & 31)] = W[(size_t)(k0 + kk) * ldw + scol]; }
    LDS_WAIT(); asm volatile("" ::: "memory");
    const int c = lane & 7;
#pragma unroll
    for (int j = 0; j < 4; ++j) { const int n = (lane >> 3) + 8 * j; const LAS float* s = scr + (8 * c) * 33 + n;
        u32x4 o; o.x = cvt_pk_bf16(s[0 * 33], s[1 * 33]); o.y = cvt_pk_bf16(s[2 * 33], s[3 * 33]); o.z = cvt_pk_bf16(s[4 * 33], s[5 * 33]); o.w = cvt_pk_bf16(s[6 * 33], s[7 * 33]);
        *(u32x4*)(WT + (size_t)(n0 + n) * ldt + k0 + 8 * c) = o; }
    LDS_WAIT(); asm volatile("" ::: "memory");
}
__device__ __forceinline__ void transpose_job(const float* W, size_t ldw, int Kr, int Nd, int scol0, bf16* WT, size_t ldt, int drow0, LAS float* scr, int lane, int gw, int NGW) {
    const int nnb = Nd / 32, nit = (Kr / 64) * nnb;
    for (int it = gw; it < nit; it += NGW) { const int kb = it / nnb, nb = it % nnb; transpose_item(W, ldw, 64 * kb, scol0 + 32 * nb + (lane & 31), WT, ldt, drow0 + 32 * nb, scr, lane); }
}
__device__ __forceinline__ void p0_prologue(Frame& F, const Args& a) {
    int tid_ = threadIdx.x; asm volatile("" : "+v"(tid_)); const int lane_ = tid_ & 63, wave_ = __builtin_amdgcn_readfirstlane(tid_ >> 6);
    LAS float* scr = (LAS float*)(F.lds + wave_ * 16384);
    const int gw = F.vcu * NWAVES + wave_, NGW = F.G * NWAVES, lane = lane_;
    { const float* w_in = a.in[10]; bf16* BT1 = (bf16*)(F.ws + WS_BT1);
      constexpr int NIT = (D / 64) * (N1 / 32);
      for (int it = gw; it < NIT; it += NGW) { const int kb = it / (N1 / 32), nb = it % (N1 / 32); transpose_item(w_in, INW, 64 * kb, sigma_in(32 * nb + (lane & 31)), BT1, D, 32 * nb, scr, lane); } }
    transpose_job(a.in[18], D, 512, D, 0, (bf16*)(F.ws + WS_WAT), 512, 0, scr, lane, gw, NGW);
    transpose_job(a.in[19], D, 512, D, 0, (bf16*)(F.ws + WS_WMT), 512, 0, scr, lane, gw, NGW);
    transpose_job(a.in[20], D, D, D, 0, (bf16*)(F.ws + WS_WOT), D, 0, scr, lane, gw, NGW);
    transpose_job(a.in[21], NE, D, NE, 0, (bf16*)(F.ws + WS_WRT), D, 0, scr, lane, gw, NGW);
    for (int n = 0; n < 2; ++n) {
        transpose_job(a.in[26], EFF, D, 128, 128 * n, (bf16*)(F.ws + WS_WSGU), D, 256 * n, scr, lane, gw, NGW);
        transpose_job(a.in[27], EFF, D, 128, 128 * n, (bf16*)(F.ws + WS_WSGU), D, 256 * n + 128, scr, lane, gw, NGW); }
    transpose_job(a.in[28], D, EFF, D, 0, (bf16*)(F.ws + WS_WSD), EFF, 0, scr, lane, gw, NGW);
    { float* rc = (float*)(F.ws + WS_ROPE); float* rsn = rc + 1024;
      for (int i = F.vcu * 512 + tid_; i < 1024; i += F.G * 512) { const int pos = i >> 4, f = i & 15; const float inv = exp2f(-(float)f * (13.287712379549449f / 16.f)); const float ang = (float)pos * inv; rc[i] = cosf(ang); rsn[i] = sinf(ang); } }
    __syncthreads();
    { const float* c = a.in[1]; const float* c_ctx = a.in[3]; const float* w_ada = a.in[4]; const float* b_ada = a.in[5]; float* mod = (float*)(F.ws + WS_MOD);
      LAS float* sC = (LAS float*)F.lds;
      for (int i = tid_; i < 33 * 1024; i += 512) { const int r = i >> 10, k = i & 1023; const float v = r < NB ? c[i] : c_ctx[k]; sC[r * 1025 + k] = siluf_(v); }
      __syncthreads();
      for (int cb = F.vcu; cb < 256; cb += F.G)
          for (int o = tid_; o < 33 * 24; o += 512) { const int r = o / 24, col = cb * 24 + o % 24; float s = 0.f;
#pragma unroll 8
              for (int k = 0; k < 1024; ++k) s += sC[r * 1025 + k] * w_ada[(size_t)k * (NMOD * D) + col];
              mod[(size_t)r * (NMOD * D) + col] = s + b_ada[col]; }
      __syncthreads(); }
}
__device__ __forceinline__ void p1_norm_gates(Frame& F, const Args& a) {
    int tid_ = threadIdx.x; asm volatile("" : "+v"(tid_)); const int lane_ = tid_ & 63, wave_ = __builtin_amdgcn_readfirstlane(tid_ >> 6);
    const float* x = a.in[0]; const float* ctx = a.in[2]; const float* g = a.in[6]; const float* w_in = a.in[10]; const float* b_i = a.in[15]; const float* b_f = a.in[16];
    const float* mod = (const float*)(F.ws + WS_MOD); bf16* A1 = (bf16*)(F.ws + WS_RA); float* GATES = (float*)(F.ws + WS_GATES);
    LAS float* wT = (LAS float*)F.lds;
    for (int i = tid_; i < 16 * 1024; i += 512) { const int k = i >> 4, gi = i & 15; wT[gi * 1024 + k] = w_in[(size_t)k * INW + C_MI + gi]; }
    __syncthreads();
    const int gw = F.vcu * NWAVES + wave_, NGW = F.G * NWAVES, lane = lane_;
    const f32x4* g4 = (const f32x4*)g;
    for (int row = gw; row < TA; row += NGW) {
        const bool lat = row < T;
        const f32x4* xr = (const f32x4*)(lat ? x + (size_t)row * D : ctx + (size_t)(row - T) * D);
        const f32x4* mr = (const f32x4*)(mod + (size_t)(lat ? row / S : NB) * (NMOD * D));
        f32x4 v[4]; float ss = 0.f;
#pragma unroll
        for (int j = 0; j < 4; ++j) { v[j] = xr[64 * j + lane]; ss += (v[j][0] * v[j][0] + v[j][1] * v[j][1]) + (v[j][2] * v[j][2] + v[j][3] * v[j][3]); }
        const float rs = rsqrtf(wave_sum(ss) * (1.f / D) + EPS);
        u32x2* o8 = (u32x2*)(A1 + (size_t)row * D);
#pragma unroll
        for (int j = 0; j < 4; ++j) { const f32x4 gg = g4[64 * j + lane], sh = mr[64 * j + lane], sc = mr[256 + 64 * j + lane];
            v[j] = v[j] * rs * gg * (sc + 1.f) + sh;
            u32x2 w; w.x = cvt_pk_bf16(v[j][0], v[j][1]); w.y = cvt_pk_bf16(v[j][2], v[j][3]); o8[64 * j + lane] = w; }
        float p[16];
#pragma unroll
        for (int gi = 0; gi < 16; ++gi) { float s = 0.f;
#pragma unroll
            for (int j = 0; j < 4; ++j) { const f32x4 w = *(const LAS f32x4*)(wT + gi * 1024 + 256 * j + 4 * lane); s += (v[j][0] * w[0] + v[j][1] * w[1]) + (v[j][2] * w[2] + v[j][3] * w[3]); }
            p[gi] = wave_sum(s); }
        float mine = 0.f;
#pragma unroll
        for (int gi = 0; gi < 16; ++gi) mine = (lane == gi) ? p[gi] : mine;
        if (lane < 16) { const int sr = lat ? seqrow_lat(row) : seqrow_ctx(row - T); float r;
            if (lane < 8) r = mine + b_i[lane]; else { const float xx = mine + b_f[lane - 8]; r = fminf(xx, 0.f) - log1pf(__expf(-fabsf(xx))); }
            GATES[(size_t)sr * 16 + lane] = r; }
    }
    __syncthreads();
}
constexpr float QSCALE = 0.125f * 1.4426950408889634f;
struct ProgInProj {
    const char* A1; const char* BT1; int G, c;
    bf16 *Q, *K, *V, *MQ, *MO, *GA; const LAS float* tab;
    __device__ __forceinline__ bool next(int i, eng::UnitD& u, LAS unsigned char*) const {
        const long L = (long)i * G + c; if (L >= 5088) return false;
        int pm, pn;
        if (L < 4864) { int wgid = (int)L; { const int q = 4864 / 8, xcd = wgid % 8, off = wgid / 8; wgid = xcd * q + off; }
            const int nig = 8 * 19, gid = wgid / nig, fm = gid * 8; pm = fm + ((wgid % nig) % 8); pn = (wgid % nig) / 8; }
        else { const int j = (int)L - 4864; pm = 256 + (j & 31); pn = 2 + (j >> 5); }
        u.A = A1 + (size_t)pm * (256 * 2048); u.B = BT1 + (size_t)pn * (256 * 2048); u.lda = 2048; u.ldb = 2048; u.nt = 16; u.type = 0; u.r0 = pm; u.r1 = pn; u.r2 = 0; u.r3 = 0; return true;
    }
    __device__ __forceinline__ void first(const eng::UnitD&, LAS unsigned char*) const {}
    __device__ __forceinline__ void prefetch(const eng::UnitD&, LAS unsigned char*) const {}
    __device__ __forceinline__ void offsets(const eng::UnitD& u, const int (&Rr)[2], const int (&Cc)[2], unsigned (&oA)[2][2], LAS unsigned char*) const {
#pragma unroll
        for (int h = 0; h < 2; ++h)
#pragma unroll
            for (int i = 0; i < 2; ++i) oA[h][i] = (unsigned)(128 * h + Rr[i]) * u.lda + (unsigned)Cc[i];
    }
    template <bool ROPE>
    __device__ __forceinline__ void qk_epi(const eng::Acc& acc, bf16* dst  , size_t ld, const LAS float* gain, float scale, int pm, int wr, int fr, int fq) const {
        const LAS float* rope = tab;
        f32x4 gv[2][2];
#pragma unroll
        for (int bj = 0; bj < 2; ++bj)
#pragma unroll
            for (int n = 0; n < 2; ++n) gv[bj][n] = *(const LAS f32x4*)(gain + (fq >> 1) * 32 + bj * 16 + 8 * (fq & 1) + 4 * n);
#pragma unroll
        for (int ai = 0; ai < 2; ++ai)
#pragma unroll
            for (int m = 0; m < 4; ++m) {
                float ss = 0.f;
#pragma unroll
                for (int bj = 0; bj < 2; ++bj)
#pragma unroll
                    for (int n = 0; n < 2; ++n) { const f32x4 v = acc[ai][bj][m][n]; ss += (v[0] * v[0] + v[1] * v[1]) + (v[2] * v[2] + v[3] * v[3]); }
                ss += __shfl_xor(ss, 16); ss += __shfl_xor(ss, 32);
                const float rs = rsqrtf(ss * (1.f / HD) + EPS) * scale;
                f32x4 o1[2], o2[2];
#pragma unroll
                for (int n = 0; n < 2; ++n) { const f32x4 x1 = acc[ai][0][m][n] * rs * gv[0][n], x2 = acc[ai][1][m][n] * rs * gv[1][n];
                    if (ROPE) { const int pos = (fq >> 1) ? (16 * m + fr) : ((4 * pm + 2 * ai + wr) & 31);
                        const f32x4 cs = *(const LAS f32x4*)(rope + pos * 16 + 8 * (fq & 1) + 4 * n), sn = *(const LAS f32x4*)(rope + 1024 + pos * 16 + 8 * (fq & 1) + 4 * n);
                        o1[n] = x1 * cs - x2 * sn; o2[n] = x2 * cs + x1 * sn; }
                    else { o1[n] = x1; o2[n] = x2; } }
                bf16* rowp = dst + (size_t)(ai * 128 + m * 16) * ld;
                u32x4 w; w.x = cvt_pk_bf16(o1[0][0], o1[0][1]); w.y = cvt_pk_bf16(o1[0][2], o1[0][3]); w.z = cvt_pk_bf16(o1[1][0], o1[1][1]); w.w = cvt_pk_bf16(o1[1][2], o1[1][3]);
                *(u32x4*)(rowp) = w;
                w.x = cvt_pk_bf16(o2[0][0], o2[0][1]); w.y = cvt_pk_bf16(o2[0][2], o2[0][3]); w.z = cvt_pk_bf16(o2[1][0], o2[1][1]); w.w = cvt_pk_bf16(o2[1][2], o2[1][3]);
                *(u32x4*)(rowp + 32) = w;
            }
    }
    __device__ __forceinline__ void v_epi(const eng::Acc& acc, bf16* dst, size_t ld) const {
#pragma unroll
        for (int ai = 0; ai < 2; ++ai)
#pragma unroll
            for (int m = 0; m < 4; ++m) { bf16* rowp = dst + (size_t)(ai * 128 + m * 16) * ld;
#pragma unroll
                for (int bj = 0; bj < 2; ++bj) { const f32x4 v0 = acc[ai][bj][m][0], v1 = acc[ai][bj][m][1];
                    u32x4 w; w.x = cvt_pk_bf16(v0[0], v0[1]); w.y = cvt_pk_bf16(v0[2], v0[3]); w.z = cvt_pk_bf16(v1[0], v1[1]); w.w = cvt_pk_bf16(v1[2], v1[3]);
                    *(u32x4*)(rowp + bj * 32) = w; } }
    }
    __device__ __forceinline__ void epilogue(eng::Acc& acc, const eng::UnitD& u, int wr, int wc, int fr, int fq, LAS unsigned char*) const {
        const int pm = u.r0, pn = u.r1; const bool lat = pm < 256;
        const int lrow = wr * 64 + fr;
        const size_t r0 = (size_t)pm * 256;
        const size_t sr0 = lat ? r0 + (size_t)(pm / 8 + 1) * CL : (size_t)(pm - 256) * SL;
        if (pn < 2) { qk_epi<true>(acc, Q + (r0 + lrow) * AW + (4 * pn + wc) * 64 + 8 * fq, AW, tab + 2048, QSCALE, pm, wr, fr, fq); }
        else if (pn == 2) {
            if (wc < 2) { bf16* d = K + (sr0 + lrow) * KVW + wc * 64 + 8 * fq; if (lat) qk_epi<true>(acc, d, KVW, tab + 2112, 1.f, pm, wr, fr, fq); else qk_epi<false>(acc, d, KVW, tab + 2112, 1.f, pm, wr, fr, fq); }
            else v_epi(acc, V + (sr0 + lrow) * KVW + (wc - 2) * 64 + 8 * fq, KVW);
        }
        else if (pn < 9) { bf16* base = MQ + (size_t)((pn - 3) >> 1) * ((size_t)TA * MW); const int ct = ((pn - 3) & 1) * 256;
            eng::store_tile_bf16<0>(acc, base + (sr0 + lrow) * MW + ct + wc * 32 + 8 * fq, MW); }
        else if (pn < 11) eng::store_tile_bf16<0>(acc, MO + (r0 + lrow) * MW + (pn - 9) * 256 + wc * 32 + 8 * fq, MW);
        else { bf16* base = GA + (size_t)((pn - 11) >> 2) * ((size_t)T * D);
            eng::store_tile_bf16<1>(acc, base + (r0 + lrow) * D + ((pn - 11) & 3) * 256 + wc * 32 + 8 * fq, D); }
    }
};
#include <hip/hip_bf16.h>
#include <cmath>
namespace attn_body {
using bf16=__hip_bfloat16;
using bf16x8=__attribute__((ext_vector_type(8)))short;
using s16x4=__attribute__((ext_vector_type(4)))short;
using f32x16=__attribute__((ext_vector_type(16)))float;
using u32x4=__attribute__((ext_vector_type(4)))unsigned;
constexpr int BATCH=32,NHEAD=8,SEQ=2048,SKV=2304,D=64,QP=512,KP=128,OP=1024;
constexpr int NW=8,QBLK=32,QB=QBLK*NW,KVBLK=64,NQB=SEQ/QB;
constexpr int ATTN_UNIT_ROWS=QB;
__device__ __forceinline__ int crow(int r,int hi){return (r&3)+8*(r>>2)+4*hi;}
#define SBAR() __builtin_amdgcn_sched_barrier(0)
__device__ __forceinline__ void cmask(f32x16&p0,f32x16&p1,int jb,int qrel,int hi){
  const float NEG=-INFINITY; int kb=64*jb+4*hi;
  #pragma unroll
  for(int r=0;r<16;++r){int kv=kb+(r&3)+8*(r>>2); if(kv>qrel)p0[r]=NEG; if(kv+32>qrel)p1[r]=NEG;}
}

constexpr int NSLOT=3, SLOTB=8192;
constexpr int LDS_K=0, LDS_V=NSLOT*SLOTB, LDS_WS=2*NSLOT*SLOTB, LDS_OST=LDS_WS+NW*64*4, LDS_BYTES=LDS_OST+NW*4096;
constexpr float C2=0.125f*1.4426950408889634f;
__device__ __forceinline__ void glds16(const void*gsrc,unsigned lds_dst){unsigned keep;
  asm volatile("s_mov_b32 %0, m0\n\ts_mov_b32 m0, %2\n\ts_nop 0\n\tglobal_load_lds_dwordx4 %1, off\n\ts_mov_b32 m0, %0":"=&s"(keep):"v"(gsrc),"s"(lds_dst):"memory");}
__device__ __forceinline__ float max3f(float a,float b,float c){float r;asm("v_max3_f32 %0, %1, %2, %3":"=v"(r):"v"(a),"v"(b),"v"(c));return r;}
__device__ __forceinline__ float max2f(float a,float b){float r;asm("v_max_f32_e32 %0, %1, %2":"=v"(r):"v"(a),"v"(b));return r;}
__device__ __forceinline__ float fadd_s(float a,float b){float r;asm("v_add_f32_e32 %0, %1, %2":"=v"(r):"v"(a),"v"(b));return r;}
__device__ __forceinline__ float fsub_s(float a,float b){float r;asm("v_sub_f32_e32 %0, %1, %2":"=v"(r):"v"(a),"v"(b));return r;}
typedef float f32x2_t __attribute__((ext_vector_type(2))); typedef __bf16 bf16x2_t __attribute__((ext_vector_type(2)));
__device__ __forceinline__ unsigned cvtpk_s(float lo,float hi){f32x2_t v={lo,hi};bf16x2_t b=__builtin_convertvector(v,bf16x2_t);return __builtin_bit_cast(unsigned,b);}
#define WAIT_BAR(N) asm volatile("s_waitcnt vmcnt(" #N ") lgkmcnt(0)\n\ts_barrier":::"memory")

__device__ __forceinline__ void qkt(f32x16&p0,f32x16&p1,const char*Kslot,const bf16x8*qr,const f32x16&negm,int r32,int hi){
  const char*kb=Kslot+hi*1024+r32*16;
  #pragma unroll
  for(int d0=0;d0<4;++d0){
    const bf16x8 b0=*reinterpret_cast<const bf16x8*>(kb+d0*2048);
    const bf16x8 b1=*reinterpret_cast<const bf16x8*>(kb+d0*2048+512);
    if(d0==0){p0=__builtin_amdgcn_mfma_f32_32x32x16_bf16(b0,qr[0],negm,0,0,0);p1=__builtin_amdgcn_mfma_f32_32x32x16_bf16(b1,qr[0],negm,0,0,0);}
    else{p0=__builtin_amdgcn_mfma_f32_32x32x16_bf16(b0,qr[d0],p0,0,0,0);p1=__builtin_amdgcn_mfma_f32_32x32x16_bf16(b1,qr[d0],p1,0,0,0);}}
}
typedef __attribute__((address_space(3))) const char* lds_cptr;
typedef short v4i16_t __attribute__((ext_vector_type(4)));
__device__ __forceinline__ void kload8(bf16x8*kf,lds_cptr kp){
  kf[0]=*(const __attribute__((address_space(3))) bf16x8*)(kp);      kf[1]=*(const __attribute__((address_space(3))) bf16x8*)(kp+512);
  kf[2]=*(const __attribute__((address_space(3))) bf16x8*)(kp+2048); kf[3]=*(const __attribute__((address_space(3))) bf16x8*)(kp+2560);
  kf[4]=*(const __attribute__((address_space(3))) bf16x8*)(kp+4096); kf[5]=*(const __attribute__((address_space(3))) bf16x8*)(kp+4608);
  kf[6]=*(const __attribute__((address_space(3))) bf16x8*)(kp+6144); kf[7]=*(const __attribute__((address_space(3))) bf16x8*)(kp+6656);
}
__device__ __forceinline__ void kload2(bf16x8*kf,lds_cptr kp,int j){ kf[2*j]=*(const __attribute__((address_space(3))) bf16x8*)(kp+j*2048); kf[2*j+1]=*(const __attribute__((address_space(3))) bf16x8*)(kp+j*2048+512); }
__device__ __forceinline__ s16x4 vtr(lds_cptr p){ return __builtin_bit_cast(s16x4,__builtin_amdgcn_ds_read_tr16_b64_v4i16((__attribute__((address_space(3))) v4i16_t*)p)); }
__device__ __forceinline__ float rowmax(const f32x16&p0,const f32x16&p1){
  float a=max3f(p0[0],p0[1],p1[0]),b=max3f(p0[2],p0[3],p1[1]);a=max3f(a,p1[2],p1[3]);
  #pragma unroll
  for(int r=4;r<16;r+=4){a=max3f(a,p0[r],p0[r+1]);b=max3f(b,p0[r+2],p0[r+3]);a=max3f(a,p1[r],p1[r+1]);b=max3f(b,p1[r+2],p1[r+3]);}
  const float m=max2f(a,b);
  auto rr=__builtin_amdgcn_permlane32_swap(__float_as_uint(m),__float_as_uint(m),false,false);
  return max2f(__uint_as_float(rr[0]),__uint_as_float(rr[1]));
}
__device__ __forceinline__ void pv(f32x16*o,int vb,bf16x8 pa0,bf16x8 pa1,bf16x8 pa2,bf16x8 pa3){
  #pragma unroll
  for(int d0=0;d0<2;++d0){s16x4 lo[4],hi[4];
    #pragma unroll
    for(int ks=0;ks<4;++ks){
      asm volatile("ds_read_b64_tr_b16 %0,%1 offset:%c2":"=&v"(lo[ks]):"v"(vb),"i"(d0*4096+ks*1024):"memory");
      asm volatile("ds_read_b64_tr_b16 %0,%1 offset:%c2":"=&v"(hi[ks]):"v"(vb),"i"(d0*4096+ks*1024+512):"memory");}
    asm volatile("s_waitcnt lgkmcnt(0)":::"memory");SBAR();
    #define PK(k) (bf16x8){lo[k][0],lo[k][1],lo[k][2],lo[k][3],hi[k][0],hi[k][1],hi[k][2],hi[k][3]}
    o[d0]=__builtin_amdgcn_mfma_f32_32x32x16_bf16(pa0,PK(0),o[d0],0,0,0);
    o[d0]=__builtin_amdgcn_mfma_f32_32x32x16_bf16(pa1,PK(1),o[d0],0,0,0);
    o[d0]=__builtin_amdgcn_mfma_f32_32x32x16_bf16(pa2,PK(2),o[d0],0,0,0);
    o[d0]=__builtin_amdgcn_mfma_f32_32x32x16_bf16(pa3,PK(3),o[d0],0,0,0);
    #undef PK
  }
}

#ifndef ATTN_STORE16
#define ATTN_STORE16(p,v) (*(u32x4*)(p)=(v))
#endif
template<int THRL> __device__ __forceinline__ void attn_unit(int b,int h,int qb,const bf16*Q,const bf16*__restrict__ K,const bf16*__restrict__ V,bf16*O,char*shm){
  const int tid=threadIdx.x,lane=tid&63,r32=lane&31,hi=lane>>5; const int wid=__builtin_amdgcn_readfirstlane(tid>>6);
  const long rowbase=(long)b*SEQ, kvbase=(long)b*SKV; const int q0=qb*QB;
  const bf16*Qw=Q+(rowbase+q0+wid*QBLK)*QP+h*D;
  const bf16*Kh=K+kvbase*KP+(h>>2)*D,*Vh=V+kvbase*KP+(h>>2)*D;
  const unsigned lds0=(unsigned)(uintptr_t)shm;
  float*wsf=(float*)(shm+LDS_WS)+wid*64;
  const bf16*ksrc=Kh+(long)lane*KP+wid*8;
  const bf16*vsrc=Vh+(long)(16*(wid&3)+(lane>>2))*KP+(wid>>2)*32+(lane&3)*8;
  const unsigned kdst=lds0+LDS_K+wid*1024, vdst=lds0+LDS_V+wid*1024;
  #define DMA_K(t,slot) glds16(ksrc+(long)(t)*KVBLK*KP,(unsigned)__builtin_amdgcn_readfirstlane(kdst+(slot)))
  #define DMA_V(t,slot) glds16(vsrc+(long)(t)*KVBLK*KP,(unsigned)__builtin_amdgcn_readfirstlane(vdst+(slot)))
  const int vb0=(int)(lds0+LDS_V)+((lane>>4)&1)*32+(lane&3)*8+(4*hi+((lane&15)>>2))*64;
  const char*Kbase=shm+LDS_K; bf16x8 kf[8];
  const lds_cptr shm3=(lds_cptr)shm; const lds_cptr kp0=shm3+LDS_K+hi*1024+r32*16; const lds_cptr vp0=shm3+LDS_V+((lane>>4)&1)*32+(lane&3)*8+(4*hi+((lane&15)>>2))*64;
  const int NT=SKV/KVBLK;
  DMA_K(0,0);DMA_V(0,0);DMA_K(1,SLOTB);
  bf16x8 qr[4];
  #pragma unroll
  for(int d0=0;d0<4;++d0)qr[d0]=*reinterpret_cast<const bf16x8*>(&Qw[(long)r32*QP+d0*16+hi*8]);
  float mhat=0.f,l_reg=0.f;f32x16 o[2];o[0]=f32x16{};o[1]=f32x16{};f32x16 negm=f32x16{};asm volatile("":"+v"(negm));
  const int qrel=wid*QBLK+r32;
  #define CMASK(P0,P1,t) do{}while(0)
  bool resc=false;
  #define START(P0,P1) do{ const float rm=rowmax(P0,P1); resc=false; \
    { const float dl=rm; mhat=fadd_s(mhat,dl); \
      _Pragma("unroll") for(int r=0;r<16;++r){P0[r]=fsub_s(P0[r],dl);P1[r]=fsub_s(P1[r],dl);} \
      _Pragma("unroll") for(int r=0;r<16;++r)negm[r]=-mhat; asm volatile("":"+v"(negm)); } \
    _Pragma("unroll") for(int r=0;r<16;++r)P0[r]=__builtin_amdgcn_exp2f(P0[r]); }while(0)
  #define RESC() do{ if(resc){ asm volatile("s_waitcnt lgkmcnt(0)":::"memory"); \
      _Pragma("unroll") for(int d_=0;d_<2;++d_) _Pragma("unroll") for(int r=0;r<16;++r)o[d_][r]*=wsf[crow(r,hi)]; } }while(0)
  f32x16 pA0,pA1,pB0,pB1;
  int sl_prev=0,sl_cur=0,sl_next=SLOTB;
  #define ROT() do{sl_prev=sl_cur;sl_cur=sl_next;sl_next=(sl_next==(NSLOT-1)*SLOTB)?0:sl_next+SLOTB;}while(0)
  DMA_K(2,2*SLOTB);
  WAIT_BAR(3);
  qkt(pA0,pA1,Kbase,qr,negm,r32,hi);asm volatile("s_nop 15\n\ts_nop 7":"+v"(pA0),"+v"(pA1));CMASK(pA0,pA1,0);
  START(pA0,pA1);
  _Pragma("unroll") for(int r=0;r<16;++r)pA1[r]=__builtin_amdgcn_exp2f(pA1[r]);
  WAIT_BAR(0);
  DMA_K(3,0);DMA_V(1,SLOTB);
  ROT();
  kload8(kf,kp0+sl_cur);
  WAIT_BAR(2);
  s16x4 vlo[8],vhi[8]; u32x4 pw0,pw1,pw2,pw3;
  #define PKW(P,B) cvtpk_s(P[B],P[B+1])
  #define PAF(k) __builtin_bit_cast(bf16x8,pw##k)
  #define VFR(i) (bf16x8){vlo[i][0],vlo[i][1],vlo[i][2],vlo[i][3],vhi[i][0],vhi[i][1],vhi[i][2],vhi[i][3]}
  #define PIN(x) asm volatile("":"+v"(x))
  #define MX3(a,b,c) __builtin_fmaxf(__builtin_fmaxf((a),(b)),(c))
  #define GAPA(MF,A0,A1,A2,A3,W0,W1,PW) do{ MF; sacc+=A0; sacc+=A1; sacc+=A2; sacc+=A3; PIN(sacc); W0; W1; PIN(PW); SBAR(); }while(0)
  #define EX(v) __builtin_amdgcn_exp2f(v)
  #define GAPB(MF,X,B) do{ MF; X[B]=EX(X[B]); X[B+1]=EX(X[B+1]); X[B+2]=EX(X[B+2]); X[B+3]=EX(X[B+3]); PIN(X); SBAR(); }while(0)
  #define VRD(i) do{ vlo[i]=vtr(vp_+(((i)>>2)*4096+((i)&3)*1024)); vhi[i]=vtr(vp_+(((i)>>2)*4096+((i)&3)*1024+512)); }while(0)
  #define KRD(G,j) do{ if(G){ kload2(kf,kp0+sl_next,j); SBAR(); } }while(0)
  #define STEP(C0,C1,P0,P1,t,GK,GV,GL) do{ SBAR(); \
    const lds_cptr vp_=vp0+sl_prev; \
    VRD(0); SBAR(); float sacc=(P0[0]+P0[1]); \
    GAPA(C0=__builtin_amdgcn_mfma_f32_32x32x16_bf16(kf[0],qr[0],negm,0,0,0), P0[2],P0[3],P0[4],P0[5],     pw0[0]=PKW(P0,0), pw0[1]=PKW(P0,2), pw0); \
    VRD(4); SBAR(); GAPA(C1=__builtin_amdgcn_mfma_f32_32x32x16_bf16(kf[1],qr[0],negm,0,0,0), P0[6],P0[7],P0[8],P0[9],     pw0[2]=PKW(P0,4), pw0[3]=PKW(P0,6), pw0); \
    VRD(1); SBAR(); GAPA(C0=__builtin_amdgcn_mfma_f32_32x32x16_bf16(kf[2],qr[1],C0,0,0,0),   P0[10],P0[11],P0[12],P0[13], pw1[0]=PKW(P0,8), pw1[1]=PKW(P0,10), pw1); \
    VRD(5); SBAR(); GAPA(C1=__builtin_amdgcn_mfma_f32_32x32x16_bf16(kf[3],qr[1],C1,0,0,0),   P0[14],P0[15],P1[0],P1[1],   pw1[2]=PKW(P0,12),pw1[3]=PKW(P0,14), pw1); \
    VRD(2); SBAR(); GAPA(C0=__builtin_amdgcn_mfma_f32_32x32x16_bf16(kf[4],qr[2],C0,0,0,0),   P1[2],P1[3],P1[4],P1[5],     pw2[0]=PKW(P1,0), pw2[1]=PKW(P1,2), pw2); \
    VRD(6); SBAR(); GAPA(C1=__builtin_amdgcn_mfma_f32_32x32x16_bf16(kf[5],qr[2],C1,0,0,0),   P1[6],P1[7],P1[8],P1[9],     pw2[2]=PKW(P1,4), pw2[3]=PKW(P1,6), pw2); \
    VRD(3); SBAR(); GAPA(C0=__builtin_amdgcn_mfma_f32_32x32x16_bf16(kf[6],qr[3],C0,0,0,0),   P1[10],P1[11],P1[12],P1[13], pw3[0]=PKW(P1,8), pw3[1]=PKW(P1,10), pw3); \
    VRD(7); SBAR(); GAPA(C1=__builtin_amdgcn_mfma_f32_32x32x16_bf16(kf[7],qr[3],C1,0,0,0),   P1[14],P1[15],0.f,0.f,       pw3[2]=PKW(P1,12),pw3[3]=PKW(P1,14), pw3); \
    l_reg+=sacc; \
    if(GK){DMA_K((t)+3,sl_cur);} if(GV){DMA_V((t)+1,sl_next);} \
    CMASK(C0,C1,t); \
    { float a=MX3(C0[0],C0[1],C1[0]),b=MX3(C0[2],C0[3],C1[1]); a=MX3(a,C1[2],C1[3]); \
      _Pragma("unroll") for(int r=4;r<16;r+=4){a=MX3(a,C0[r],C0[r+1]);b=MX3(b,C0[r+2],C0[r+3]);a=MX3(a,C1[r],C1[r+1]);b=MX3(b,C1[r+2],C1[r+3]);} \
      float rm=__builtin_fmaxf(a,b); { auto rr=__builtin_amdgcn_permlane32_swap(__float_as_uint(rm),__float_as_uint(rm),false,false); rm=__builtin_fmaxf(__uint_as_float(rr[0]),__uint_as_float(rr[1])); } \
      resc=false; \
      if(__builtin_expect(__any(rm>(float)THRL),0)){ const float dl=__builtin_fmaxf(rm,0.f); mhat+=dl; \
        _Pragma("unroll") for(int r=0;r<16;++r){C0[r]-=dl;C1[r]-=dl;} \
        _Pragma("unroll") for(int r=0;r<16;++r)negm[r]=-mhat; asm volatile("":"+v"(negm)); \
        const float f=__builtin_amdgcn_exp2f(-dl); l_reg*=f; if(hi==0)wsf[r32]=f; resc=true; } } \
    SBAR(); \
    GAPB(o[0]=__builtin_amdgcn_mfma_f32_32x32x16_bf16(PAF(0),VFR(0),o[0],0,0,0), C0,0); \
    GAPB(o[1]=__builtin_amdgcn_mfma_f32_32x32x16_bf16(PAF(0),VFR(4),o[1],0,0,0), C0,4); \
    KRD(GL,0); GAPB(o[0]=__builtin_amdgcn_mfma_f32_32x32x16_bf16(PAF(1),VFR(1),o[0],0,0,0), C0,8); \
    KRD(GL,1); GAPB(o[1]=__builtin_amdgcn_mfma_f32_32x32x16_bf16(PAF(1),VFR(5),o[1],0,0,0), C0,12); \
    KRD(GL,2); GAPB(o[0]=__builtin_amdgcn_mfma_f32_32x32x16_bf16(PAF(2),VFR(2),o[0],0,0,0), C1,0); \
    KRD(GL,3); GAPB(o[1]=__builtin_amdgcn_mfma_f32_32x32x16_bf16(PAF(2),VFR(6),o[1],0,0,0), C1,4); \
    GAPB(o[0]=__builtin_amdgcn_mfma_f32_32x32x16_bf16(PAF(3),VFR(3),o[0],0,0,0), C1,8); \
    GAPB(o[1]=__builtin_amdgcn_mfma_f32_32x32x16_bf16(PAF(3),VFR(7),o[1],0,0,0), C1,12); \
    }while(0)
  int t=1;
  #undef CMASK
  #define CMASK(P0,P1,t) do{}while(0)
  for(;t+5<NT;t+=2){
    STEP(pB0,pB1,pA0,pA1,t,true,true,true);     WAIT_BAR(2); RESC(); ROT();
    STEP(pA0,pA1,pB0,pB1,t+1,true,true,true);   WAIT_BAR(2); RESC(); ROT();
  }
  #undef CMASK
  #define CMASK(P0,P1,t) do{}while(0)
  #define ENDW(tt) do{ if((tt)+3<NT){WAIT_BAR(2);} else if((tt)+2<NT){WAIT_BAR(1);} else {WAIT_BAR(0);} }while(0)
  for(;t+1<NT;t+=2){
    STEP(pB0,pB1,pA0,pA1,t,(t+3<NT),(t+1<NT),(t+1<NT));       ENDW(t);   RESC(); ROT();
    STEP(pA0,pA1,pB0,pB1,t+1,(t+4<NT),(t+2<NT),(t+2<NT));     ENDW(t+1); RESC(); ROT();
  }
  STEP(pB0,pB1,pA0,pA1,NT-1,false,false,false); RESC();
  { float sacc=pB0[0]+pB0[1]; _Pragma("unroll") for(int r=2;r<16;++r)sacc+=pB0[r]; _Pragma("unroll") for(int r=0;r<16;++r)sacc+=pB1[r]; l_reg+=sacc;
    pw0=(u32x4){PKW(pB0,0),PKW(pB0,2),PKW(pB0,4),PKW(pB0,6)};pw1=(u32x4){PKW(pB0,8),PKW(pB0,10),PKW(pB0,12),PKW(pB0,14)};pw2=(u32x4){PKW(pB1,0),PKW(pB1,2),PKW(pB1,4),PKW(pB1,6)};pw3=(u32x4){PKW(pB1,8),PKW(pB1,10),PKW(pB1,12),PKW(pB1,14)};
    SBAR(); pv(o,vb0+sl_cur,PAF(0),PAF(1),PAF(2),PAF(3)); }
  #undef PKW
  #undef PAF
  #undef VFR
  #undef PIN
  #undef MX3
  #undef GAPA
  #undef GAPB
  #undef EX
  #undef VRD
  #undef KRD
  #undef STEP
  #undef ENDW
  {auto rr=__builtin_amdgcn_permlane32_swap(__float_as_uint(l_reg),__float_as_uint(l_reg),false,false);l_reg=__uint_as_float(rr[0])+__uint_as_float(rr[1]);}
  if(hi==0)wsf[32+r32]=l_reg;asm volatile("s_waitcnt lgkmcnt(0)":::"memory");
  float rli[16];
  #pragma unroll
  for(int r=0;r<16;++r)rli[r]=__builtin_amdgcn_rcpf(wsf[32+crow(r,hi)]);
  bf16*Ow=O+(rowbase+q0+wid*QBLK)*OP+h*D;
  { bf16*stg=(bf16*)(shm+LDS_OST)+wid*2048;
    #pragma unroll
    for(int r=0;r<16;++r){const int orow=crow(r,hi);
      #pragma unroll
      for(int d0=0;d0<2;++d0)stg[orow*64+d0*32+r32]=__float2bfloat16(o[d0][r]*rli[r]);}
    asm volatile("s_waitcnt lgkmcnt(0)":::"memory");
    #pragma unroll
    for(int i=0;i<4;++i){const int row=i*8+(lane>>3),ch=lane&7; const u32x4 v=*(const u32x4*)(stg+row*64+ch*8); ATTN_STORE16(Ow+(long)row*OP+ch*8,v);} }
  asm volatile("s_waitcnt lgkmcnt(0)\n\ts_barrier":::"memory");
  #undef DMA_K
  #undef DMA_V
  #undef CMASK
  #undef START
  #undef RESC
  #undef ROT
}
constexpr int ATTN_LDS_BYTES=LDS_BYTES;
struct AttnTensors { const bf16* Q; const bf16* K; const bf16* V; bf16* O; };
struct AttnUnit { int b; int h; int qb; };
struct StaticOrder {
  int vcu, G;
  __device__ __forceinline__ StaticOrder(int grid,int v):vcu(v),G(grid){}
  __device__ __forceinline__ bool next(int i,AttnUnit&u)const{ const int L=(i>>3)*G+vcu; if(L>=256)return false; u.b=L>>3; u.qb=L&7; u.h=i&7; return true; }
};
template<class Sched,int THRL=8> __device__ __forceinline__ void attn_phase(char*lds,const AttnTensors&T,const Sched&S){
  AttnUnit u;
  for(int i=0;S.next(i,u);++i){ attn_unit<THRL>(u.b,u.h,u.qb,T.Q,T.K,T.V,T.O,lds); }
}
#undef SBAR
#undef WAIT_BAR
}
__device__ __forceinline__ void tile_of(int L, int nN, int& pm, int& pn) {
    const int nwg = 256 * nN, q = nwg / 8; int wgid = (L % 8) * q + L / 8;
    const int nig = 8 * nN, gid = wgid / nig, fm = gid * 8; pm = fm + ((wgid % nig) % 8); pn = (wgid % nig) / 8;
}
struct ProgMerge {
    const char* AM; const char* WAT; const char* WMT; bf16* Y; const bf16* GA; int G, c;
    __device__ __forceinline__ bool next(int i, eng::UnitD& u, LAS unsigned char*) const {
        const long L = (long)(i >> 1) * G + c; if (L >= 1024) return false;
        int pm, pn; tile_of((int)L, 4, pm, pn); const int part = i & 1;
        u.A = AM + (size_t)pm * (256 * 2048) + part * 1024; u.B = (part ? WMT : WAT) + (size_t)pn * (256 * 1024); u.lda = 2048; u.ldb = 1024; u.nt = 8; u.type = part; u.r0 = pm; u.r1 = pn; u.r2 = 0; u.r3 = 0; return true;
    }
    __device__ __forceinline__ void first(const eng::UnitD&, LAS unsigned char*) const {}
    __device__ __forceinline__ void prefetch(const eng::UnitD&, LAS unsigned char*) const {}
    __device__ __forceinline__ void offsets(const eng::UnitD& u, const int (&Rr)[2], const int (&Cc)[2], unsigned (&oA)[2][2], LAS unsigned char*) const {
#pragma unroll
        for (int h = 0; h < 2; ++h)
#pragma unroll
            for (int i = 0; i < 2; ++i) oA[h][i] = (unsigned)(128 * h + Rr[i]) * u.lda + (unsigned)Cc[i];
    }
    __device__ __forceinline__ void epilogue(eng::Acc& acc, const eng::UnitD& u, int wr, int wc, int fr, int fq, LAS unsigned char*) const {
        const size_t off0 = ((size_t)u.r0 * 256 + wr * 64 + fr) * D + u.r1 * 256 + wc * 32 + 8 * fq;
        if (u.type == 0) { eng::store_tile_bf16<0>(acc, Y + off0, D); return; }
        const bf16* GMp = GA + (size_t)T * D;
#pragma unroll
        for (int ai = 0; ai < 2; ++ai)
#pragma unroll
            for (int m = 0; m < 4; ++m) {
#pragma unroll
                for (int bj = 0; bj < 2; ++bj) { const size_t o = off0 + (size_t)(ai * 128 + m * 16) * D + bj * 128;
                    const u32x4 p1 = *(const u32x4*)(Y + o), ga = *(const u32x4*)(GA + o), gm = *(const u32x4*)(GMp + o);
                    u32x4 w;
#pragma unroll
                    for (int q = 0; q < 4; ++q) { const int n = q >> 1, e = (q & 1) * 2;
                        const float y0 = __uint_as_float(ga[q] << 16) * __uint_as_float(p1[q] << 16) + __uint_as_float(gm[q] << 16) * acc[ai][bj][m][n][e];
                        const float y1 = __uint_as_float(ga[q] & 0xffff0000u) * __uint_as_float(p1[q] & 0xffff0000u) + __uint_as_float(gm[q] & 0xffff0000u) * acc[ai][bj][m][n][e + 1];
                        w[q] = cvt_pk_bf16(y0, y1); }
                    *(u32x4*)(Y + o) = w; }
                asm volatile("" ::: "memory"); }
        __builtin_amdgcn_s_waitcnt(0x0F70);
    }
};
struct ProgOut {
    const char* Yb; const char* WOT; bf16* YO; float* RS1; int G, c;
    __device__ __forceinline__ bool next(int i, eng::UnitD& u, LAS unsigned char*) const {
        const long L = (long)i * G + c; if (L >= 1024) return false;
        int pm, pn; tile_of((int)L, 4, pm, pn);
        u.A = Yb + (size_t)pm * (256 * 2048); u.B = WOT + (size_t)pn * (256 * 2048); u.lda = 2048; u.ldb = 2048; u.nt = 16; u.type = 0; u.r0 = pm; u.r1 = pn; u.r2 = 0; u.r3 = 0; return true;
    }
    __device__ __forceinline__ void first(const eng::UnitD&, LAS unsigned char*) const {}
    __device__ __forceinline__ void prefetch(const eng::UnitD&, LAS unsigned char*) const {}
    __device__ __forceinline__ void offsets(const eng::UnitD& u, const int (&Rr)[2], const int (&Cc)[2], unsigned (&oA)[2][2], LAS unsigned char*) const {
#pragma unroll
        for (int h = 0; h < 2; ++h)
#pragma unroll
            for (int i = 0; i < 2; ++i) oA[h][i] = (unsigned)(128 * h + Rr[i]) * u.lda + (unsigned)Cc[i];
    }
    __device__ __forceinline__ void epilogue(eng::Acc& acc, const eng::UnitD& u, int wr, int wc, int fr, int fq, LAS unsigned char*) const {
        const size_t row0 = (size_t)u.r0 * 256 + wr * 64 + fr;
        eng::store_tile_bf16<0>(acc, YO + row0 * D + u.r1 * 256 + wc * 32 + 8 * fq, D);
#pragma unroll
        for (int ai = 0; ai < 2; ++ai)
#pragma unroll
            for (int m = 0; m < 4; ++m) { float ss = 0.f;
#pragma unroll
                for (int bj = 0; bj < 2; ++bj)
#pragma unroll
                    for (int n = 0; n < 2; ++n) { const f32x4 v = acc[ai][bj][m][n]; ss += (v[0] * v[0] + v[1] * v[1]) + (v[2] * v[2] + v[3] * v[3]); }
                ss += __shfl_xor(ss, 16); ss += __shfl_xor(ss, 32);
                if (fq == 0) RS1[(row0 + ai * 128 + m * 16) * 16 + u.r1 * 4 + wc] = ss; }
    }
};
template <bool WRITE_X1>
__device__ __forceinline__ void p6_rowpass(Frame& F, const Args& a) {
    int tid_ = threadIdx.x; asm volatile("" : "+v"(tid_)); const int lane_ = tid_ & 63, wave_ = __builtin_amdgcn_readfirstlane(tid_ >> 6);
    const float* x = a.in[0]; const f32x4* gpost = (const f32x4*)a.in[7]; const f32x4* gpre = (const f32x4*)a.in[8];
    const float* mod = (const float*)(F.ws + WS_MOD); const bf16* YO = (const bf16*)(F.ws + WS_RA); const float* RS1 = (const float*)(F.ws + WS_RS1); bf16* FIN = (bf16*)(F.ws + WS_GA);
    const int gw = F.vcu * NWAVES + wave_, NGW = F.G * NWAVES, lane = lane_;
    for (int row = gw; row < T; row += NGW) {
        const f32x4* mr = (const f32x4*)(mod + (size_t)(row / S) * (NMOD * D));
        const f32x4* xr = (const f32x4*)(x + (size_t)row * D); const u32x2* yr = (const u32x2*)(YO + (size_t)row * D);
        float s1 = (lane < 16) ? RS1[(size_t)row * 16 + lane] : 0.f;
        s1 += __shfl_xor(s1, 1); s1 += __shfl_xor(s1, 2); s1 += __shfl_xor(s1, 4); s1 += __shfl_xor(s1, 8);
        s1 = __shfl(s1, 0);
        const float rs1 = rsqrtf(s1 * (1.f / D) + EPS);
        f32x4 v[4]; float ss = 0.f;
#pragma unroll
        for (int j = 0; j < 4; ++j) { const int i4 = 64 * j + lane; const u32x2 yb = yr[i4]; const f32x4 xv = xr[i4], g1 = mr[512 + i4], gp = gpost[i4];
            f32x4 y; y[0] = __uint_as_float(yb.x << 16); y[1] = __uint_as_float(yb.x & 0xffff0000u); y[2] = __uint_as_float(yb.y << 16); y[3] = __uint_as_float(yb.y & 0xffff0000u);
            v[j] = xv + g1 * (y * rs1 * gp); ss += (v[j][0] * v[j][0] + v[j][1] * v[j][1]) + (v[j][2] * v[j][2] + v[j][3] * v[j][3]); }
        const float rs2 = rsqrtf(wave_sum(ss) * (1.f / D) + EPS);
        u32x2* o8 = (u32x2*)(FIN + (size_t)row * D);
#pragma unroll
        for (int j = 0; j < 4; ++j) { const int i4 = 64 * j + lane; const f32x4 sh = mr[768 + i4], sc = mr[1024 + i4], gg = gpre[i4];
            if (WRITE_X1) ((f32x4*)(a.out + (size_t)row * D))[i4] = v[j];
            const f32x4 o = v[j] * rs2 * gg * (sc + 1.f) + sh;
            u32x2 w; w.x = cvt_pk_bf16(o[0], o[1]); w.y = cvt_pk_bf16(o[2], o[3]); o8[i4] = w; }
    }
}
constexpr int NCH = 2, TCH = T / NCH;
constexpr size_t WS_SCORE = WS_GM;
constexpr size_t WS_WGU = WS_RW, WS_WD = WS_RW + 256 * MiB;
constexpr size_t WS_HIDS = WS_H, WS_HIDSH = WS_H + 64 * MiB;
constexpr size_t WS_EOHI = WS_GM;
constexpr int CW_CNT2 = 2048, CW_FILL2 = 2560;
constexpr int LIST_CAP = 327680;
constexpr int LDS_TOFF = RING_BYTES;
constexpr int LDS_IDX = RING_BYTES + 4096;
__device__ __forceinline__ bf16* eo_block(unsigned char* dout, unsigned char* ws, int k) { return (bf16*)((k < 4 ? dout : ws + WS_EOHI) + (size_t)(k & 3) * (64 * MiB)); }

__device__ __forceinline__ void p0_expert_weights(Frame& F, const Args& a) {
    int tid_ = threadIdx.x; asm volatile("" : "+v"(tid_)); const int lane_ = tid_ & 63, wave_ = __builtin_amdgcn_readfirstlane(tid_ >> 6);
    LAS float* scr = (LAS float*)(F.lds + wave_ * 16384);
    const int gw = F.vcu * NWAVES + wave_, NGW = F.G * NWAVES, lane = lane_;
    const float* w_eg = a.in[23]; const float* w_eu = a.in[24]; const float* w_ed = a.in[25];
    bf16* WGU = (bf16*)(F.ws + WS_WGU); bf16* WD = (bf16*)(F.ws + WS_WD);
    for (int it = gw; it < NE * 384; it += NGW) {
        const int e = it / 384, r = it % 384;
        if (r < 256) { const int job = r >> 6, q = r & 63, kb = q >> 2, nb = q & 3, n = job >> 1, up = job & 1;
            transpose_item((up ? w_eu : w_eg) + (size_t)e * D * EFF, EFF, 64 * kb, 128 * n + 32 * nb + (lane & 31), WGU + (size_t)e * 512 * D, D, 256 * n + 128 * up + 32 * nb, scr, lane); }
        else { const int q = r - 256, kb = q >> 5, nb = q & 31;
            transpose_item(w_ed + (size_t)e * EFF * D, D, 64 * kb, 32 * nb + (lane & 31), WD + (size_t)e * D * EFF, EFF, 32 * nb, scr, lane); }
    }
}
struct ProgRouter {
    const char* FINb; const char* WRT; float* SCORE; int G, c;
    __device__ __forceinline__ bool next(int i, eng::UnitD& u, LAS unsigned char*) const {
        const long L = (long)i * G + c; if (L >= 256) return false;
        u.A = FINb + (size_t)L * (256 * 2048); u.B = WRT; u.lda = 2048; u.ldb = 2048; u.nt = 16; u.type = 0; u.r0 = (int)L; u.r1 = 0; u.r2 = 0; u.r3 = 0; return true;
    }
    __device__ __forceinline__ void first(const eng::UnitD&, LAS unsigned char*) const {}
    __device__ __forceinline__ void prefetch(const eng::UnitD&, LAS unsigned char*) const {}
    __device__ __forceinline__ void offsets(const eng::UnitD& u, const int (&Rr)[2], const int (&Cc)[2], unsigned (&oA)[2][2], LAS unsigned char*) const {
#pragma unroll
        for (int h = 0; h < 2; ++h)
#pragma unroll
            for (int i = 0; i < 2; ++i) oA[h][i] = (unsigned)(128 * h + Rr[i]) * u.lda + (unsigned)Cc[i];
    }
    __device__ __forceinline__ void epilogue(eng::Acc& acc, const eng::UnitD& u, int wr, int wc, int fr, int fq, LAS unsigned char*) const {
        float* dst = SCORE + ((size_t)u.r0 * 256 + wr * 64 + fr) * NE + wc * 32 + 8 * fq;
#pragma unroll
        for (int ai = 0; ai < 2; ++ai)
#pragma unroll
            for (int m = 0; m < 4; ++m)
#pragma unroll
                for (int bj = 0; bj < 2; ++bj)
#pragma unroll
                    for (int n = 0; n < 2; ++n) *(f32x4*)(dst + (size_t)(ai * 128 + m * 16) * NE + bj * 128 + 4 * n) = acc[ai][bj][m][n];
    }
};
__device__ __forceinline__ void p_topk(Frame& F, const Args& a) {
    int tid_ = threadIdx.x; asm volatile("" : "+v"(tid_)); const int lane_ = tid_ & 63, wave_ = __builtin_amdgcn_readfirstlane(tid_ >> 6);
    const float* SCORE = (const float*)(F.ws + WS_SCORE); const float* e_bias = a.in[22];
    int* TOPI = (int*)(F.ws + WS_TOPI); float* TOPW = (float*)(F.ws + WS_TOPW); int* cnt = (int*)(F.ws + WS_CTL) + CW_CNT2;
    LAS float* sb = (LAS float*)F.lds;
    for (int i = tid_; i < NE; i += 512) sb[i] = e_bias[i];
    __syncthreads();
    for (int tok = F.vcu * 512 + tid_; tok < T; tok += F.G * 512) {
        const float* sr = SCORE + (size_t)tok * NE;
        float gv4[TKG]; int gi4[TKG];
#pragma unroll
        for (int q = 0; q < TKG; ++q) { gv4[q] = -INFINITY; gi4[q] = 0; }
        for (int g = 0; g < NG; ++g) { float m1 = -INFINITY, m2 = -INFINITY;
            for (int j = 0; j < 32; j += 4) { const f32x4 v = *(const f32x4*)(sr + g * 32 + j);
#pragma unroll
                for (int q = 0; q < 4; ++q) { const float s = sigmoidf_(v[q]) + sb[g * 32 + j + q]; if (s > m1) { m2 = m1; m1 = s; } else if (s > m2) m2 = s; } }
            float s = m1 + m2; int id = g; bool placed = false;
#pragma unroll
            for (int p = 0; p < TKG; ++p) { const bool sw = placed || (s > gv4[p]); const float t1 = gv4[p]; const int t2 = gi4[p]; gv4[p] = sw ? s : t1; gi4[p] = sw ? id : t2; s = sw ? t1 : s; id = sw ? t2 : id; placed = sw; } }
        unsigned gmask = 0;
#pragma unroll
        for (int q = 0; q < TKG; ++q) gmask |= 1u << gi4[q];
        float tv[TOPK]; int ti[TOPK];
#pragma unroll
        for (int q = 0; q < TOPK; ++q) { tv[q] = -INFINITY; ti[q] = 0; }
        for (int g = 0; g < NG; ++g) { if (!((gmask >> g) & 1u)) continue;
            for (int j = 0; j < 32; j += 4) { const f32x4 v = *(const f32x4*)(sr + g * 32 + j);
#pragma unroll
                for (int q = 0; q < 4; ++q) { const int e = g * 32 + j + q; float s = sigmoidf_(v[q]) + sb[e]; int id = e;
                    if (s > tv[TOPK - 1]) { bool placed = false;
#pragma unroll
                        for (int p = 0; p < TOPK; ++p) { const bool sw = placed || (s > tv[p]); const float t1 = tv[p]; const int t2 = ti[p]; tv[p] = sw ? s : t1; ti[p] = sw ? id : t2; s = sw ? t1 : s; id = sw ? t2 : id; placed = sw; } } } } }
        float w[TOPK]; float wsum = 0.f;
#pragma unroll
        for (int q = 0; q < TOPK; ++q) { w[q] = sigmoidf_(sr[ti[q]]); wsum += w[q]; }
        const float inv = RSCALE / wsum; const int ch = tok / TCH;
#pragma unroll
        for (int q = 0; q < TOPK; ++q) { TOPI[tok * TOPK + q] = ti[q]; TOPW[tok * TOPK + q] = w[q] * inv; atomicAdd(&cnt[ch * NE + ti[q]], 1); }
    }
    __syncthreads();
}
__device__ __forceinline__ void moe_tile_offsets(Frame& F) {
    int tid_ = threadIdx.x; asm volatile("" : "+v"(tid_)); const int lane_ = tid_ & 63, wave_ = __builtin_amdgcn_readfirstlane(tid_ >> 6);
    const int* cnt = (const int*)(F.ws + WS_CTL) + CW_CNT2; LAS int* toff = (LAS int*)(F.lds + LDS_TOFF);
    if (tid_ < NCH) { int s = 0; for (int e = 0; e < NE; ++e) { toff[tid_ * 257 + e] = s; s += (cnt[tid_ * NE + e] + 255) >> 8; } toff[tid_ * 257 + NE] = s; }
    __syncthreads();
}
__device__ __forceinline__ void p_scatter(Frame& F) {
    int tid_ = threadIdx.x; asm volatile("" : "+v"(tid_)); const int lane_ = tid_ & 63, wave_ = __builtin_amdgcn_readfirstlane(tid_ >> 6);
    moe_tile_offsets(F);
    const LAS int* toff = (const LAS int*)(F.lds + LDS_TOFF); int* ctl = (int*)(F.ws + WS_CTL);
    const int* TOPI = (const int*)(F.ws + WS_TOPI); const float* TOPW = (const float*)(F.ws + WS_TOPW); int* LIST = (int*)(F.ws + WS_LIST); float* LISTW = (float*)(F.ws + WS_LISTW);
    for (int ce = F.vcu; ce < NCH * NE; ce += F.G) { const int c = ce >> 8, e = ce & 255, n = ctl[CW_CNT2 + ce], base = toff[c * 257 + e] * 256, cap = ((n + 255) >> 8) << 8;
        for (int p = n + tid_; p < cap; p += 512) { LIST[c * LIST_CAP + base + p] = -1; LISTW[c * LIST_CAP + base + p] = 0.f; } }
    for (int asg = F.vcu * 512 + tid_; asg < T * TOPK; asg += F.G * 512) { const int e = TOPI[asg], c = (asg >> 3) / TCH;
        const int p = atomicAdd(&ctl[CW_FILL2 + c * NE + e], 1); const int slot = c * LIST_CAP + toff[c * 257 + e] * 256 + p;
        LIST[slot] = asg; LISTW[slot] = TOPW[asg]; }
    __syncthreads();
}
struct ProgMoE {
    unsigned char* dout; unsigned char* ws; const char* FINb; const char* WGU; const char* WD; char* HID;
    const int* LIST; const float* LISTW; int chunk, ntiles, vcu, G, ns, drain;
    __device__ __forceinline__ int expert_of(int j, LAS unsigned char* lds) const {
        const LAS int* toff = (const LAS int*)(lds + LDS_TOFF) + chunk * 257; int lo = 0, hi = NE;
#pragma unroll
        for (int it = 0; it < 8; ++it) { const int mid = (lo + hi) >> 1; const bool ge = j >= toff[mid]; lo = ge ? mid : lo; hi = ge ? hi : mid; }
        return __builtin_amdgcn_readfirstlane(lo);
    }
    __device__ __forceinline__ bool next(int i, eng::UnitD& u, LAS unsigned char* lds) const {
        int s, kind, n;
        if (drain) { if (i >= 4 || ns == 0) return false; s = ns - 1; kind = 1; n = i; }
        else { if (i < 2) { s = 0; kind = 0; n = i; } else { const int ii = i - 2; s = 1 + ii / 6; const int r = ii % 6; if (r < 2) { kind = 0; n = r; } else { kind = 1; n = r - 2; s -= 1; } }
               if (kind == 0 ? (s >= ns) : (s + 1 >= ns)) return false; }
        const int j = s * G + vcu;
        const int e = expert_of(j, lds);
        u.type = kind; u.r0 = s; u.r1 = n; u.r2 = j; u.r3 = e;
        if (kind == 0) { u.A = FINb; u.lda = 2048; u.B = WGU + (size_t)e * (512 * 2048) + (size_t)n * (256 * 2048); u.ldb = 2048; u.nt = 16; }
        else { u.A = HID + (size_t)(s & 1) * (256 * 512); u.lda = 512; u.B = WD + (size_t)e * (1024 * 512) + (size_t)n * (256 * 512); u.ldb = 512; u.nt = 4; }
        return true;
    }
    __device__ __forceinline__ void idx_dma(const eng::UnitD& u, LAS unsigned char* lds) const {
        if (threadIdx.x < 64) { const size_t base = (size_t)chunk * LIST_CAP + (size_t)u.r2 * 256 + threadIdx.x * 4; LAS unsigned char* dst = lds + LDS_IDX + (u.r0 % 3) * 2048;
            __builtin_amdgcn_global_load_lds((const unsigned*)(LIST + base), (LAS unsigned*)dst, 16, 0, 0);
            __builtin_amdgcn_global_load_lds((const unsigned*)(LISTW + base), (LAS unsigned*)(dst + 1024), 16, 0, 0); }
    }
    __device__ __forceinline__ void first(const eng::UnitD& u, LAS unsigned char* lds) const {
        if (!drain) { idx_dma(u, lds); asm volatile("s_waitcnt vmcnt(0)" ::: "memory"); __builtin_amdgcn_s_barrier(); asm volatile("" ::: "memory"); }
    }
    __device__ __forceinline__ void prefetch(const eng::UnitD& nxt, LAS unsigned char* lds) const { if (nxt.type == 0 && nxt.r1 == 0) idx_dma(nxt, lds); }
    __device__ __forceinline__ void offsets(const eng::UnitD& u, const int (&Rr)[2], const int (&Cc)[2], unsigned (&oA)[2][2], LAS unsigned char* lds) const {
        if (u.type == 0) { const LAS int* idx = (const LAS int*)(lds + LDS_IDX + (u.r0 % 3) * 2048);
#pragma unroll
            for (int h = 0; h < 2; ++h)
#pragma unroll
                for (int i = 0; i < 2; ++i) { const int v = idx[128 * h + Rr[i]]; oA[h][i] = (unsigned)((v < 0 ? 0 : v) >> 3) * 2048u + (unsigned)Cc[i]; } }
        else {
#pragma unroll
            for (int h = 0; h < 2; ++h)
#pragma unroll
                for (int i = 0; i < 2; ++i) oA[h][i] = (unsigned)(128 * h + Rr[i]) * 512u + (unsigned)Cc[i]; }
    }
    __device__ __forceinline__ void epilogue(eng::Acc& acc, const eng::UnitD& u, int wr, int wc, int fr, int fq, LAS unsigned char* lds) const {
        if (u.type == 0) {
            bf16* dst = (bf16*)(HID + (size_t)(u.r0 & 1) * (256 * 512)) + (size_t)(wr * 64 + fr) * 256 + u.r1 * 128 + wc * 32 + 8 * fq;
#pragma unroll
            for (int ai = 0; ai < 2; ++ai)
#pragma unroll
                for (int m = 0; m < 4; ++m) { f32x4 h0, h1;
#pragma unroll
                    for (int e = 0; e < 4; ++e) { h0[e] = siluf_(acc[ai][0][m][0][e]) * acc[ai][1][m][0][e]; h1[e] = siluf_(acc[ai][0][m][1][e]) * acc[ai][1][m][1][e]; }
                    u32x4 w; w.x = cvt_pk_bf16(h0[0], h0[1]); w.y = cvt_pk_bf16(h0[2], h0[3]); w.z = cvt_pk_bf16(h1[0], h1[1]); w.w = cvt_pk_bf16(h1[2], h1[3]);
                    *(u32x4*)(dst + (size_t)(ai * 128 + m * 16) * 256) = w; }
        } else {
            const LAS int* idx = (const LAS int*)(lds + LDS_IDX + (u.r0 % 3) * 2048); const LAS float* wgt = (const LAS float*)(idx + 256);
            const int col = u.r1 * 256 + wc * 32 + 8 * fq;
#pragma unroll
            for (int ai = 0; ai < 2; ++ai)
#pragma unroll
                for (int m = 0; m < 4; ++m) { const int r = ai * 128 + wr * 64 + m * 16 + fr; const int asg = idx[r]; const float w = wgt[r];
                    if (asg >= 0) { bf16* rowp = eo_block(dout, ws, asg & 7) + (size_t)((asg >> 3) - chunk * TCH) * D + col;
#pragma unroll
                        for (int bj = 0; bj < 2; ++bj) { const f32x4 v0 = acc[ai][bj][m][0] * w, v1 = acc[ai][bj][m][1] * w;
                            u32x4 o; o.x = cvt_pk_bf16(v0[0], v0[1]); o.y = cvt_pk_bf16(v0[2], v0[3]); o.z = cvt_pk_bf16(v1[0], v1[1]); o.w = cvt_pk_bf16(v1[2], v1[3]);
                            *(u32x4*)(rowp + bj * 128) = o; } } }
        }
    }
};
struct ProgSharedG1 {
    const char* FINb; const char* WSGU; bf16* HIDSH; int G, c;
    __device__ __forceinline__ bool next(int i, eng::UnitD& u, LAS unsigned char*) const {
        const long L = (long)i * G + c; if (L >= 512) return false;
        const int pm = (int)(L >> 1), n = (int)(L & 1);
        u.A = FINb + (size_t)pm * (256 * 2048); u.B = WSGU + (size_t)n * (256 * 2048); u.lda = 2048; u.ldb = 2048; u.nt = 16; u.type = 0; u.r0 = pm; u.r1 = n; u.r2 = 0; u.r3 = 0; return true;
    }
    __device__ __forceinline__ void first(const eng::UnitD&, LAS unsigned char*) const {}
    __device__ __forceinline__ void prefetch(const eng::UnitD&, LAS unsigned char*) const {}
    __device__ __forceinline__ void offsets(const eng::UnitD& u, const int (&Rr)[2], const int (&Cc)[2], unsigned (&oA)[2][2], LAS unsigned char*) const {
#pragma unroll
        for (int h = 0; h < 2; ++h)
#pragma unroll
            for (int i = 0; i < 2; ++i) oA[h][i] = (unsigned)(128 * h + Rr[i]) * u.lda + (unsigned)Cc[i];
    }
    __device__ __forceinline__ void epilogue(eng::Acc& acc, const eng::UnitD& u, int wr, int wc, int fr, int fq, LAS unsigned char*) const {
        bf16* dst = HIDSH + ((size_t)u.r0 * 256 + wr * 64 + fr) * 256 + u.r1 * 128 + wc * 32 + 8 * fq;
#pragma unroll
        for (int ai = 0; ai < 2; ++ai)
#pragma unroll
            for (int m = 0; m < 4; ++m) { f32x4 h0, h1;
#pragma unroll
                for (int e = 0; e < 4; ++e) { h0[e] = siluf_(acc[ai][0][m][0][e]) * acc[ai][1][m][0][e]; h1[e] = siluf_(acc[ai][0][m][1][e]) * acc[ai][1][m][1][e]; }
                u32x4 w; w.x = cvt_pk_bf16(h0[0], h0[1]); w.y = cvt_pk_bf16(h0[2], h0[3]); w.z = cvt_pk_bf16(h1[0], h1[1]); w.w = cvt_pk_bf16(h1[2], h1[3]);
                *(u32x4*)(dst + (size_t)(ai * 128 + m * 16) * 256) = w; }
    }
};
struct ProgCombine {
    unsigned char* dout; unsigned char* ws; const char* HIDSHb; const char* WSD; bf16* FX; float* RS2; int chunk, G, c;
    __device__ __forceinline__ bool next(int i, eng::UnitD& u, LAS unsigned char*) const {
        const long L = (long)i * G + c; if (L >= (TCH / 256) * 4) return false;
        const int pm = chunk * (TCH / 256) + (int)(L >> 2), n = (int)(L & 3);
        u.A = HIDSHb + (size_t)pm * (256 * 512); u.B = WSD + (size_t)n * (256 * 512); u.lda = 512; u.ldb = 512; u.nt = 4; u.type = 0; u.r0 = pm; u.r1 = n; u.r2 = 0; u.r3 = 0; return true;
    }
    __device__ __forceinline__ void first(const eng::UnitD&, LAS unsigned char*) const {}
    __device__ __forceinline__ void prefetch(const eng::UnitD&, LAS unsigned char*) const {}
    __device__ __forceinline__ void offsets(const eng::UnitD& u, const int (&Rr)[2], const int (&Cc)[2], unsigned (&oA)[2][2], LAS unsigned char*) const {
#pragma unroll
        for (int h = 0; h < 2; ++h)
#pragma unroll
            for (int i = 0; i < 2; ++i) oA[h][i] = (unsigned)(128 * h + Rr[i]) * u.lda + (unsigned)Cc[i];
    }
    __device__ __forceinline__ void epilogue(eng::Acc& acc, const eng::UnitD& u, int wr, int wc, int fr, int fq, LAS unsigned char*) const {
        const size_t row0 = (size_t)u.r0 * 256 + wr * 64 + fr; const size_t lrow0 = row0 - (size_t)chunk * TCH; const int col = u.r1 * 256 + wc * 32 + 8 * fq;
        const bf16* elo = (const bf16*)dout; const bf16* ehi = (const bf16*)(ws + WS_EOHI);
#pragma unroll
        for (int ai = 0; ai < 2; ++ai)
#pragma unroll
            for (int m = 0; m < 4; ++m) { const size_t ro = (lrow0 + ai * 128 + m * 16) * D + col; float ss = 0.f;
#pragma unroll
                for (int bj = 0; bj < 2; ++bj) { f32x4 v0 = acc[ai][bj][m][0], v1 = acc[ai][bj][m][1];
#pragma unroll
                    for (int k = 0; k < TOPK; ++k) { const u32x4 p = *(const u32x4*)((k < 4 ? elo : ehi) + (size_t)(k & 3) * (32 * MiB) + ro + bj * 128);
                        v0[0] += __uint_as_float(p.x << 16); v0[1] += __uint_as_float(p.x & 0xffff0000u); v0[2] += __uint_as_float(p.y << 16); v0[3] += __uint_as_float(p.y & 0xffff0000u);
                        v1[0] += __uint_as_float(p.z << 16); v1[1] += __uint_as_float(p.z & 0xffff0000u); v1[2] += __uint_as_float(p.w << 16); v1[3] += __uint_as_float(p.w & 0xffff0000u); }
                    ss += (v0[0] * v0[0] + v0[1] * v0[1]) + (v0[2] * v0[2] + v0[3] * v0[3]) + (v1[0] * v1[0] + v1[1] * v1[1]) + (v1[2] * v1[2] + v1[3] * v1[3]);
                    u32x4 o; o.x = cvt_pk_bf16(v0[0], v0[1]); o.y = cvt_pk_bf16(v0[2], v0[3]); o.z = cvt_pk_bf16(v1[0], v1[1]); o.w = cvt_pk_bf16(v1[2], v1[3]);
                    *(u32x4*)(FX + (row0 + ai * 128 + m * 16) * D + col + bj * 128) = o; }
                ss += __shfl_xor(ss, 16); ss += __shfl_xor(ss, 32);
                if (fq == 0) RS2[(row0 + ai * 128 + m * 16) * 16 + u.r1 * 4 + wc] = ss;
                asm volatile("" ::: "memory"); }
        __builtin_amdgcn_s_waitcnt(0x0F70);
    }
};
__device__ __forceinline__ void p_final(Frame& F, const Args& a) {
    int tid_ = threadIdx.x; asm volatile("" : "+v"(tid_)); const int lane_ = tid_ & 63, wave_ = __builtin_amdgcn_readfirstlane(tid_ >> 6);
    const float* x = a.in[0]; const f32x4* gpost = (const f32x4*)a.in[7]; const f32x4* gpf = (const f32x4*)a.in[9];
    const float* mod = (const float*)(F.ws + WS_MOD); const bf16* YO = (const bf16*)(F.ws + WS_RA); const bf16* FX = (const bf16*)(F.ws + WS_GA);
    const float* RS1 = (const float*)(F.ws + WS_RS1); const float* RS2 = (const float*)(F.ws + WS_RS2);
    const int gw = F.vcu * NWAVES + wave_, NGW = F.G * NWAVES, lane = lane_;
    for (int row = gw; row < T; row += NGW) {
        const f32x4* mr = (const f32x4*)(mod + (size_t)(row / S) * (NMOD * D));
        const f32x4* xr = (const f32x4*)(x + (size_t)row * D); const u32x2* yr = (const u32x2*)(YO + (size_t)row * D); const u32x2* fr_ = (const u32x2*)(FX + (size_t)row * D);
        float s1 = (lane < 16) ? RS1[(size_t)row * 16 + lane] : ((lane < 32) ? RS2[(size_t)row * 16 + lane - 16] : 0.f);
        s1 += __shfl_xor(s1, 1); s1 += __shfl_xor(s1, 2); s1 += __shfl_xor(s1, 4); s1 += __shfl_xor(s1, 8);
        const float rs1 = rsqrtf(__shfl(s1, 0) * (1.f / D) + EPS), rs2 = rsqrtf(__shfl(s1, 16) * (1.f / D) + EPS);
        f32x4* orow = (f32x4*)(a.out + (size_t)row * D);
#pragma unroll
        for (int j = 0; j < 4; ++j) { const int i4 = 64 * j + lane; const u32x2 yb = yr[i4], fb = fr_[i4]; const f32x4 xv = xr[i4], g1 = mr[512 + i4], g2 = mr[1280 + i4], gp = gpost[i4], gf = gpf[i4];
            f32x4 y, f; y[0] = __uint_as_float(yb.x << 16); y[1] = __uint_as_float(yb.x & 0xffff0000u); y[2] = __uint_as_float(yb.y << 16); y[3] = __uint_as_float(yb.y & 0xffff0000u);
            f[0] = __uint_as_float(fb.x << 16); f[1] = __uint_as_float(fb.x & 0xffff0000u); f[2] = __uint_as_float(fb.y << 16); f[3] = __uint_as_float(fb.y & 0xffff0000u);
            orow[i4] = xv + g1 * (y * rs1 * gp) + g2 * (f * rs2 * gf); }
    }
}
struct GemmP {
    const void* A; const void* B;
    const int* rowidx;
    const int* zcnt; const int* zoff;
    long zA, zB;
    int lda, ldb, M, N, K, zBdiv, rshift, pad;
};
static GemmP mkp(const void* A, const void* B, int lda, int ldb, int M, int N, int K, long zA = 0, long zB = 0, int zBdiv = 1, const int* rowidx = nullptr, int rshift = 0, const int* zcnt = nullptr, const int* zoff = nullptr) {
    GemmP p; memset(&p, 0, sizeof(p)); p.A = A; p.B = B; p.rowidx = rowidx; p.zcnt = zcnt; p.zoff = zoff; p.zA = zA; p.zB = zB; p.lda = lda; p.ldb = ldb; p.M = M; p.N = N; p.K = K; p.zBdiv = zBdiv; p.rshift = rshift; p.pad = 0; return p; }
template <typename TA_, typename TB_, bool BT, class Epi>
__global__ __launch_bounds__(256) void gemm_k(GemmP p, Epi epi) {
    __shared__ float As[8][132];
    __shared__ float Bs[8][132];
    const int z = blockIdx.z, tid = threadIdx.x, tx = tid & 15, ty = tid >> 4;
    const TA_* A = (const TA_*)p.A + (size_t)z * p.zA;
    const TB_* B = (const TB_*)p.B + (size_t)(z / p.zBdiv) * p.zB;
    int M = p.M, rbase = 0;
    if (p.zcnt) { M = p.zcnt[z]; rbase = p.zoff[z]; }
    const int n0 = blockIdx.x * 128;
    for (int m0 = blockIdx.y * 128; m0 < M; m0 += gridDim.y * 128) {
        float acc[8][8];
#pragma unroll
        for (int i = 0; i < 8; ++i)
#pragma unroll
            for (int j = 0; j < 8; ++j) acc[i][j] = 0.f;
        const int ar = tid >> 1, ak = (tid & 1) * 4;
        long arow = -1;
        if (m0 + ar < M) { arow = p.rowidx ? (long)(p.rowidx[rbase + m0 + ar] >> p.rshift) : (long)(rbase + m0 + ar); }
        for (int k0 = 0; k0 < p.K; k0 += 8) {
            float av[4] = {0.f, 0.f, 0.f, 0.f};
            if (arow >= 0) {
#pragma unroll
                for (int j = 0; j < 4; ++j) av[j] = ldf(A + arow * p.lda + k0 + ak + j);
            }
            float bv[4] = {0.f, 0.f, 0.f, 0.f};
            int bk, bn;
            if (BT) { bn = tid >> 1; bk = (tid & 1) * 4;
                if (n0 + bn < p.N) {
#pragma unroll
                    for (int j = 0; j < 4; ++j) bv[j] = ldf(B + (size_t)(n0 + bn) * p.ldb + k0 + bk + j); }
            } else { bk = tid >> 5; bn = (tid & 31) * 4;
                if (n0 + bn < p.N) {
#pragma unroll
                    for (int j = 0; j < 4; ++j) bv[j] = ldf(B + (size_t)(k0 + bk) * p.ldb + n0 + bn + j); }
            }
            __syncthreads();
#pragma unroll
            for (int j = 0; j < 4; ++j) As[ak + j][ar] = av[j];
            if (BT) {
#pragma unroll
                for (int j = 0; j < 4; ++j) Bs[bk + j][bn] = bv[j];
            } else {
#pragma unroll
                for (int j = 0; j < 4; ++j) Bs[bk][bn + j] = bv[j];
            }
            __syncthreads();
#pragma unroll
            for (int k = 0; k < 8; ++k) {
                float a[8], b[8];
#pragma unroll
                for (int i = 0; i < 8; ++i) a[i] = As[k][ty * 8 + i];
#pragma unroll
                for (int j = 0; j < 8; ++j) b[j] = Bs[k][tx * 8 + j];
#pragma unroll
                for (int i = 0; i < 8; ++i)
#pragma unroll
                    for (int j = 0; j < 8; ++j) acc[i][j] += a[i] * b[j];
            }
        }
#pragma unroll
        for (int i = 0; i < 8; ++i) {
            const int m = m0 + ty * 8 + i;
            if (m < M) {
#pragma unroll
                for (int j = 0; j < 8; ++j) { const int n = n0 + tx * 8 + j; if (n < p.N) epi(z, rbase + m, n, acc[i][j]); }
            }
        }
        __syncthreads();
    }
}
template <typename TA_, typename TB_, bool BT, class Epi>
static void gemm(hipStream_t st, const GemmP& p, const Epi& e, int gy, int gz) {
    dim3 g((p.N + 127) / 128, gy, gz);
    hipLaunchKernelGGL((gemm_k<TA_, TB_, BT, Epi>), g, dim3(256), 0, st, p, e);
}

struct EpiSeqB { bf16* C; int ldc, pad; __device__ void operator()(int, int m, int n, float v) const { const int sr = m < T ? seqrow_lat(m) : seqrow_ctx(m - T); C[(size_t)sr * ldc + n] = f2bf(v); } };
struct EpiSigB { bf16* C; int ldc, pad; __device__ void operator()(int, int m, int n, float v) const { C[(size_t)m * ldc + n] = f2bf(sigmoidf_(v)); } };
struct EpiGates { float* GATES; const float *b_i, *b_f;
    __device__ void operator()(int, int m, int n, float v) const { const int sr = m < T ? seqrow_lat(m) : seqrow_ctx(m - T);
        float r; if (n < 8) r = v + b_i[n]; else { const float x = v + b_f[n - 8]; r = fminf(x, 0.f) - log1pf(__expf(-fabsf(x))); }
        GATES[(size_t)sr * 16 + n] = r; } };
struct EpiScore { float* Sc; __device__ void operator()(int z, int m, int n, float v) const { Sc[((size_t)z * S + m) * SL + n] = v * 0.125f; } };
struct EpiPV { bf16* AM; int b, pad; __device__ void operator()(int z, int m, int n, float v) const { AM[((size_t)b * S + m) * D + z * HD + n] = f2bf(v); } };
struct EpiMergeA { float* Y; const bf16* GA; __device__ void operator()(int, int m, int n, float v) const { Y[(size_t)m * D + n] = bf2f(GA[(size_t)m * D + n]) * v; } };
struct EpiMergeM { float* Y; const bf16* GM; __device__ void operator()(int, int m, int n, float v) const { float& y = Y[(size_t)m * D + n]; y = y + bf2f(GM[(size_t)m * D + n]) * v; } };
struct EpiStoreF { float* C; int ldc, pad; __device__ void operator()(int, int m, int n, float v) const { C[(size_t)m * ldc + n] = v; } };
struct EpiStoreB { bf16* C; int ldc, pad; __device__ void operator()(int, int m, int n, float v) const { C[(size_t)m * ldc + n] = f2bf(v); } };
struct EpiSwiglu { bf16* H; int ldc, pad; __device__ void operator()(int, int m, int n, float v) const { bf16& h = H[(size_t)m * ldc + n]; h = f2bf(siluf_(bf2f(h)) * v); } };
struct EpiScatterAdd { float* FX; const int* list; const float* ew; __device__ void operator()(int, int m, int n, float v) const { const int a = list[m]; atomicAdd(&FX[(size_t)(a >> 3) * D + n], ew[a] * v); } };
struct EpiAddF { float* C; int ldc, pad; __device__ void operator()(int, int m, int n, float v) const { C[(size_t)m * ldc + n] += v; } };

__global__ void k_softmax(float* Sc, int ncols, int pad) {
    const size_t row = (size_t)blockIdx.x * (blockDim.x >> 6) + (threadIdx.x >> 6); const int lane = threadIdx.x & 63;
    float* r = Sc + row * ncols;
    float mx = -INFINITY;
    for (int c = lane; c < ncols; c += 64) mx = fmaxf(mx, r[c]);
#pragma unroll
    for (int o = 1; o < 64; o <<= 1) mx = fmaxf(mx, __shfl_xor(mx, o));
    float s = 0.f;
    for (int c = lane; c < ncols; c += 64) { const float e = __expf(r[c] - mx); r[c] = e; s += e; }
    s = 1.f / wave_sum(s);
    for (int c = lane; c < ncols; c += 64) r[c] *= s;
}
__global__ void k_conv(const bf16* MQ, const bf16* MK, const float* cw, const float* cb, bf16* QC, bf16* KC) {
    const size_t i = (size_t)blockIdx.x * blockDim.x + threadIdx.x;
    if (i >= (size_t)TA * 1024) return;
    const int sr = (int)(i / 1024), ch = (int)(i % 1024), pos = sr % SL;
    const bf16* src = ch < 512 ? MQ : MK; const int c = ch & 511;
    const int lo = pos < CL ? 0 : CL, hi = pos < CL ? CL : SL;
    float s = cb[ch];
#pragma unroll
    for (int j = 0; j < 3; ++j) { const int pp = pos + j - 1; if (pp >= lo && pp < hi) s += bf2f(src[(size_t)(sr + j - 1) * MW + c]) * cw[j * 1024 + ch]; }
    s = siluf_(s);
    if (ch < 512) QC[(size_t)sr * MW + c] = f2bf(s * 0.08838834764831845f); else KC[(size_t)sr * MW + c] = f2bf(s);
}
__global__ __launch_bounds__(256) void k_mlstm(const bf16* QC, const bf16* KC, const bf16* MV, const float* GATES, bf16* HH) {
    const int b = blockIdx.x / 8, head = (blockIdx.x / 2) % 4, dir = blockIdx.x & 1, tid = threadIdx.x;
    __shared__ float qs[128], ks[128], vs[128];
    float C[64], nv[64];
#pragma unroll
    for (int i = 0; i < 64; ++i) { C[i] = 0.f; nv[i] = 0.f; }
    float m = 0.f;
    const int v = tid >> 1, dh = (tid & 1) * 64;
    for (int step = 0; step < SL; ++step) {
        int pos;
        if (step < CL) pos = dir == 0 ? step : CL - 1 - step; else { const int t = step - CL; pos = CL + (dir == 0 ? t : S - 1 - t); }
        const size_t sr = (size_t)b * SL + pos;
        __syncthreads();
        if (tid < 128) { qs[tid] = bf2f(QC[sr * MW + head * MD + tid]); ks[tid] = bf2f(KC[sr * MW + head * MD + tid]); }
        else { const int j = tid - 128; vs[j] = bf2f(MV[sr * MW + head * MD + j]); }
        const float li = GATES[sr * 16 + dir * 4 + head], lf = GATES[sr * 16 + 8 + dir * 4 + head];
        __syncthreads();
        const float mn = fmaxf(lf + m, li), fw = __expf(lf + m - mn), iw = __expf(li - mn);
        m = mn;
        const float vv = vs[v] * iw;
        float num = 0.f, den = 0.f;
#pragma unroll
        for (int i = 0; i < 64; ++i) { const float kk = ks[dh + i], qq = qs[dh + i]; C[i] = fw * C[i] + vv * kk; nv[i] = fw * nv[i] + iw * kk; num += C[i] * qq; den += nv[i] * qq; }
        num += __shfl_xor(num, 1); den += __shfl_xor(den, 1);
        if (step >= CL && (tid & 1) == 0) {
            const int t = pos - CL;
            HH[((size_t)dir * T + (size_t)b * S + t) * MW + head * MD + v] = f2bf(num / fmaxf(fabsf(den), __expf(-mn)));
        }
    }
}
__global__ void k_mlstm_out(const bf16* HH, const bf16* MO, const float* g, bf16* AM) {
    const int idx = blockIdx.x * (blockDim.x >> 6) + (threadIdx.x >> 6), lane = threadIdx.x & 63;
    if (idx >= T * MH) return;
    const int row = idx / MH, h = idx % MH;
    float v[2]; float ss = 0.f;
#pragma unroll
    for (int j = 0; j < 2; ++j) { const size_t o = (size_t)row * MW + h * MD + lane + 64 * j; v[j] = bf2f(HH[o]) + bf2f(HH[(size_t)T * MW + o]); ss += v[j] * v[j]; }
    const float rs = rsqrtf(wave_sum(ss) * (1.f / MD) + EPS);
#pragma unroll
    for (int j = 0; j < 2; ++j) { const int c = h * MD + lane + 64 * j; AM[(size_t)row * D + AW + c] = f2bf(v[j] * rs * g[c] * sigmoidf_(bf2f(MO[(size_t)row * MW + c]))); }
}
__global__ void k_post_mix(const float* x, const float* YO, const float* g_post, const float* g_pre_ffn, const float* mod, float* out, bf16* FIN) {
    const int row = blockIdx.x * (blockDim.x >> 6) + (threadIdx.x >> 6), lane = threadIdx.x & 63;
    if (row >= T) return;
    const float* mr = mod + (size_t)(row / S) * (NMOD * D);
    float v[16]; float ss = 0.f;
#pragma unroll
    for (int j = 0; j < 16; ++j) { v[j] = YO[(size_t)row * D + lane + 64 * j]; ss += v[j] * v[j]; }
    const float rs = rsqrtf(wave_sum(ss) * (1.f / D) + EPS);
    float ss2 = 0.f;
#pragma unroll
    for (int j = 0; j < 16; ++j) { const int c = lane + 64 * j; v[j] = x[(size_t)row * D + c] + mr[2 * D + c] * (v[j] * rs * g_post[c]); out[(size_t)row * D + c] = v[j]; ss2 += v[j] * v[j]; }
    const float rs2 = rsqrtf(wave_sum(ss2) * (1.f / D) + EPS);
#pragma unroll
    for (int j = 0; j < 16; ++j) { const int c = lane + 64 * j; FIN[(size_t)row * D + c] = f2bf(v[j] * rs2 * g_pre_ffn[c] * (1.f + mr[4 * D + c]) + mr[3 * D + c]); }
}
__global__ void k_topk(const float* SCORE, const float* e_bias, int* EIDX, float* EW, int* cnt) {
    const int tok = blockIdx.x * blockDim.x + threadIdx.x;
    if (tok >= T) return;
    const float* sr = SCORE + (size_t)tok * NE;
    float gs[NG];
    for (int g = 0; g < NG; ++g) { float a = -INFINITY, b = -INFINITY;
        for (int j = 0; j < 32; ++j) { const float s = sigmoidf_(sr[g * 32 + j]) + e_bias[g * 32 + j]; if (s > a) { b = a; a = s; } else if (s > b) b = s; }
        gs[g] = a + b; }
    unsigned gmask = 0;
    for (int r = 0; r < TKG; ++r) { int best = -1; float bv = -INFINITY; for (int g = 0; g < NG; ++g) if (!((gmask >> g) & 1u) && gs[g] > bv) { bv = gs[g]; best = g; } gmask |= 1u << best; }
    int sel[TOPK]; float sw[TOPK]; float wsum = 0.f;
    for (int r = 0; r < TOPK; ++r) { int best = -1; float bv = -INFINITY;
        for (int e = 0; e < NE; ++e) { if (!((gmask >> (e >> 5)) & 1u)) continue; bool used = false; for (int q = 0; q < r; ++q) used |= (sel[q] == e); if (used) continue;
            const float s = sigmoidf_(sr[e]) + e_bias[e]; if (s > bv) { bv = s; best = e; } }
        sel[r] = best; sw[r] = sigmoidf_(sr[best]); wsum += sw[r]; }
    for (int r = 0; r < TOPK; ++r) { EIDX[tok * TOPK + r] = sel[r]; EW[tok * TOPK + r] = sw[r] / wsum * RSCALE; atomicAdd(&cnt[sel[r]], 1); }
}
__global__ void k_scan(int* ctl) { if (threadIdx.x == 0) { int s = 0; for (int e = 0; e < NE; ++e) { ctl[CW_OFF + e] = s; s += ctl[CW_CNT + e]; } ctl[CW_OFF + NE] = s; } }
__global__ void k_scatter(const int* EIDX, int* ctl, int* LIST) {
    const int a = blockIdx.x * blockDim.x + threadIdx.x;
    if (a >= T * TOPK) return;
    const int e = EIDX[a]; const int p = atomicAdd(&ctl[CW_FILL + e], 1);
    LIST[ctl[CW_OFF + e] + p] = a;
}
__global__ void k_final(const float* FX, const float* g_post_ffn, const float* mod, float* out) {
    const int row = blockIdx.x * (blockDim.x >> 6) + (threadIdx.x >> 6), lane = threadIdx.x & 63;
    if (row >= T) return;
    const float* mr = mod + (size_t)(row / S) * (NMOD * D);
    float v[16]; float ss = 0.f;
#pragma unroll
    for (int j = 0; j < 16; ++j) { v[j] = FX[(size_t)row * D + lane + 64 * j]; ss += v[j] * v[j]; }
    const float rs = rsqrtf(wave_sum(ss) * (1.f / D) + EPS);
#pragma unroll
    for (int j = 0; j < 16; ++j) { const int c = lane + 64 * j; out[(size_t)row * D + c] += mr[5 * D + c] * (v[j] * rs * g_post_ffn[c]); }
}

__global__ void __launch_bounds__(NWAVES * 64, 2) mk_fwd(Args args) {
    extern __shared__ __attribute__((aligned(16))) unsigned char lds_raw[];
    Frame F;
    F.lds = (LAS unsigned char*)lds_raw;
    F.G = gridDim.x; { const int bx = blockIdx.x; F.vcu = (F.G % 8 == 0) ? (bx % 8) * (F.G / 8) + bx / 8 : bx; }
    F.ws = args.ws; F.dout = (unsigned char*)args.out;
    volatile LAS unsigned* MISC = (volatile LAS unsigned*)(F.lds + LDSCTL_OFF);
    for (int u = threadIdx.x; u < (LDS_BYTES - LDSCTL_OFF) / 4; u += NWAVES * 64) ((LAS unsigned*)(F.lds + LDSCTL_OFF))[u] = 0u;
    __syncthreads();
    XcdBarrier bar = xcd_barrier_post((unsigned*)(F.ws + WS_CTL) + CW_BAR, MISC + 8);
    const int lo = args.ph_lo, hi = args.ph_hi;
#define IN(k) (lo <= (k) && (k) < hi)
#define BOTH(k) (IN(k) && IN((k) + 1))
    if (IN(0)) { p0_prologue(F, args); if (BOTH(0)) xcd_barrier(bar); }
    if (IN(1)) { p1_norm_gates(F, args); if (BOTH(1)) xcd_barrier(bar); }
    if (IN(2)) {
        ProgInProj P; P.A1 = (const char*)(F.ws + WS_RA); P.BT1 = (const char*)(F.ws + WS_BT1); P.G = F.G; P.c = (int)blockIdx.x;
        P.Q = (bf16*)(F.ws + WS_Q); P.K = (bf16*)(F.dout + DO_K); P.V = (bf16*)(F.dout + DO_V); P.MQ = (bf16*)(F.dout + DO_MQ);
        P.MO = (bf16*)(F.ws + WS_MO); P.GA = (bf16*)(F.ws + WS_GA); { LAS float* tab = (LAS float*)(F.lds + RING_BYTES); const float* rp = (const float*)(F.ws + WS_ROPE);
          int tq = threadIdx.x; asm volatile("" : "+v"(tq));
          for (int i = tq; i < 2048; i += 512) tab[i] = rp[i];
          if (tq < 64) tab[2048 + tq] = args.in[11][tq]; else if (tq < 128) tab[2048 + tq] = args.in[12][tq - 64];
          __syncthreads(); P.tab = tab; }
        eng::gemm_stream<ProgInProj, 0>(F.lds, P);
        if (BOTH(2)) xcd_barrier(bar);
    }
    if (IN(3)) {
        const attn_body::AttnTensors AT{(const attn_body::bf16*)(F.ws + WS_Q), (const attn_body::bf16*)(F.dout + DO_K), (const attn_body::bf16*)(F.dout + DO_V), (attn_body::bf16*)(F.ws + WS_RA)};
        const attn_body::StaticOrder SO(F.G, F.vcu);
        attn_body::attn_phase<attn_body::StaticOrder>((char*)lds_raw, AT, SO);
        if (BOTH(3)) xcd_barrier(bar);
    }
    if (IN(4)) {
        ProgMerge P; P.AM = (const char*)(F.ws + WS_RA); P.WAT = (const char*)(F.ws + WS_WAT); P.WMT = (const char*)(F.ws + WS_WMT); P.Y = (bf16*)(F.dout); P.GA = (const bf16*)(F.ws + WS_GA); P.G = F.G; P.c = (int)blockIdx.x;
        eng::gemm_stream<ProgMerge, 0>(F.lds, P);
        if (BOTH(4)) xcd_barrier(bar);
    }
    if (IN(5)) {
        ProgOut P; P.Yb = (const char*)(F.dout); P.WOT = (const char*)(F.ws + WS_WOT); P.YO = (bf16*)(F.ws + WS_RA); P.RS1 = (float*)(F.ws + WS_RS1); P.G = F.G; P.c = (int)blockIdx.x;
        eng::gemm_stream<ProgOut, 0>(F.lds, P);
        if (BOTH(5)) xcd_barrier(bar);
    }
    if (IN(6)) { p6_rowpass<false>(F, args); if (BOTH(6)) xcd_barrier(bar); }
    if (IN(7)) { p0_expert_weights(F, args); if (BOTH(7)) xcd_barrier(bar); }
    if (IN(8)) {
        ProgRouter P; P.FINb = (const char*)(F.ws + WS_GA); P.WRT = (const char*)(F.ws + WS_WRT); P.SCORE = (float*)(F.ws + WS_SCORE); P.G = F.G; P.c = F.vcu;
        eng::gemm_stream<ProgRouter, 0>(F.lds, P);
        if (BOTH(8)) xcd_barrier(bar);
    }
    if (IN(9)) { p_topk(F, args); if (BOTH(9)) xcd_barrier(bar); }
    if (IN(10)) { p_scatter(F); if (BOTH(10)) xcd_barrier(bar); }

        if (IN(11)) {
            moe_tile_offsets(F);
            ProgMoE P; P.dout = F.dout; P.ws = F.ws; P.FINb = (const char*)(F.ws + WS_GA); P.WGU = (const char*)(F.ws + WS_WGU); P.WD = (const char*)(F.ws + WS_WD); P.HID = (char*)(F.ws + WS_HIDS) + (size_t)F.vcu * (2 * 256 * 512);
            P.LIST = (const int*)(F.ws + WS_LIST); P.LISTW = (const float*)(F.ws + WS_LISTW); P.chunk = 0; P.vcu = F.vcu; P.G = F.G;
            P.ntiles = __builtin_amdgcn_readfirstlane(((const LAS int*)(F.lds + LDS_TOFF))[0 * 257 + NE]);
            P.ns = P.ntiles > F.vcu ? (P.ntiles - F.vcu + F.G - 1) / F.G : 0;
            P.drain = 0; eng::gemm_stream<ProgMoE, 16>(F.lds, P);
            P.drain = 1; eng::gemm_stream<ProgMoE, 16>(F.lds, P);
            { ProgSharedG1 Q1; Q1.FINb = (const char*)(F.ws + WS_GA); Q1.WSGU = (const char*)(F.ws + WS_WSGU); Q1.HIDSH = (bf16*)(F.ws + WS_HIDSH); Q1.G = F.G; Q1.c = F.vcu;
                eng::gemm_stream<ProgSharedG1, 0>(F.lds, Q1); }
            if (BOTH(11)) xcd_barrier(bar);
        }
        if (IN(12)) {
            ProgCombine P; P.dout = F.dout; P.ws = F.ws; P.HIDSHb = (const char*)(F.ws + WS_HIDSH); P.WSD = (const char*)(F.ws + WS_WSD); P.FX = (bf16*)(F.ws + WS_GA); P.RS2 = (float*)(F.ws + WS_RS2); P.chunk = 0; P.G = F.G; P.c = F.vcu;
            eng::gemm_stream<ProgCombine, 0>(F.lds, P);
            if (BOTH(12)) xcd_barrier(bar);
        }

        if (IN(13)) {
            moe_tile_offsets(F);
            ProgMoE P; P.dout = F.dout; P.ws = F.ws; P.FINb = (const char*)(F.ws + WS_GA); P.WGU = (const char*)(F.ws + WS_WGU); P.WD = (const char*)(F.ws + WS_WD); P.HID = (char*)(F.ws + WS_HIDS) + (size_t)F.vcu * (2 * 256 * 512);
            P.LIST = (const int*)(F.ws + WS_LIST); P.LISTW = (const float*)(F.ws + WS_LISTW); P.chunk = 1; P.vcu = F.vcu; P.G = F.G;
            P.ntiles = __builtin_amdgcn_readfirstlane(((const LAS int*)(F.lds + LDS_TOFF))[1 * 257 + NE]);
            P.ns = P.ntiles > F.vcu ? (P.ntiles - F.vcu + F.G - 1) / F.G : 0;
            P.drain = 0; eng::gemm_stream<ProgMoE, 16>(F.lds, P);
            P.drain = 1; eng::gemm_stream<ProgMoE, 16>(F.lds, P);
            if (BOTH(13)) xcd_barrier(bar);
        }
        if (IN(14)) {
            ProgCombine P; P.dout = F.dout; P.ws = F.ws; P.HIDSHb = (const char*)(F.ws + WS_HIDSH); P.WSD = (const char*)(F.ws + WS_WSD); P.FX = (bf16*)(F.ws + WS_GA); P.RS2 = (float*)(F.ws + WS_RS2); P.chunk = 1; P.G = F.G; P.c = F.vcu;
            eng::gemm_stream<ProgCombine, 0>(F.lds, P);
            if (BOTH(14)) xcd_barrier(bar);
        }
        if (IN(15)) p_final(F, args);
#undef IN
#undef BOTH
}

static void launch_mk(hipStream_t st, const Args& a0, int grid, int lo, int hi) {
    Args a = a0; a.ph_lo = lo; a.ph_hi = hi;
    hipLaunchKernelGGL(mk_fwd, dim3(grid), dim3(NWAVES * 64), LDS_BYTES, st, a);
}
extern "C" void kernel_launch(void* const* d_in, const int* in_sizes, int n_in, void* d_out, int out_size, void* d_ws, size_t ws_size, hipStream_t st) {
    static int grid = 0;
    if (grid == 0) {
        if (n_in != 29 || ws_size < WS_NEED) { fprintf(stderr, "kernel_launch: unexpected n_in %d / ws_size %zu\n", n_in, ws_size); grid = -1; return; }
        int dev = 0, cus = 0;
        if (hipGetDevice(&dev) != hipSuccess || hipDeviceGetAttribute(&cus, hipDeviceAttributeMultiprocessorCount, dev) != hipSuccess) { grid = -1; return; }
        if (hipFuncSetAttribute((const void*)mk_fwd, hipFuncAttributeMaxDynamicSharedMemorySize, LDS_BYTES) != hipSuccess) { fprintf(stderr, "kernel_launch: hipFuncSetAttribute failed\n"); grid = -1; return; }
        int per_cu = 0;
        if (hipOccupancyMaxActiveBlocksPerMultiprocessor(&per_cu, (const void*)mk_fwd, NWAVES * 64, LDS_BYTES) != hipSuccess || per_cu < 1) fprintf(stderr, "kernel_launch: occupancy query says %d\n", per_cu);
        (void)hipGetLastError();
        grid = cus;
    }
    if (grid < 0) return;
    const float* x = (const float*)d_in[0];
    const float* g_post_mix = (const float*)d_in[7]; const float* g_pre_ffn = (const float*)d_in[8]; const float* g_post_ffn = (const float*)d_in[9];
    const float* conv_w = (const float*)d_in[13]; const float* conv_b = (const float*)d_in[14];
    const float* g_mlstm = (const float*)d_in[17]; const float* w_br_attn = (const float*)d_in[18]; const float* w_br_mlstm = (const float*)d_in[19];
    const float* w_out = (const float*)d_in[20]; const float* w_router = (const float*)d_in[21]; const float* e_bias = (const float*)d_in[22]; const float* w_eg = (const float*)d_in[23];
    const float* w_eu = (const float*)d_in[24]; const float* w_ed = (const float*)d_in[25]; const float* w_sg = (const float*)d_in[26]; const float* w_su = (const float*)d_in[27]; const float* w_sd = (const float*)d_in[28];
    float* out = (float*)d_out; unsigned char* ws = (unsigned char*)d_ws; unsigned char* dob = (unsigned char*)d_out;
    (void)hipMemsetAsync(ws + WS_CTL, 0, CTL_ZERO_BYTES, st);
    Args a; memset(&a, 0, sizeof(a));
    for (int i = 0; i < 29; ++i) a.in[i] = (const float*)d_in[i];
    a.out = out; a.ws = ws;
    launch_mk(st, a, grid, 0, 1);
    launch_mk(st, a, grid, 1, 2);
    launch_mk(st, a, grid, 2, 3);
    launch_mk(st, a, grid, 3, 4);
    int* ctl = (int*)(ws + WS_CTL); float* mod = (float*)(ws + WS_MOD); float* GATES = (float*)(ws + WS_GATES);
    bf16* Q = (bf16*)(ws + WS_Q); bf16* K = (bf16*)(dob + DO_K); bf16* V = (bf16*)(dob + DO_V);
    bf16* MQ = (bf16*)(dob + DO_MQ); bf16* MK = (bf16*)(dob + DO_MK); bf16* MV = (bf16*)(dob + DO_MV); bf16* MO = (bf16*)(ws + WS_MO);
    bf16* GA = (bf16*)(ws + WS_GA); bf16* GM = (bf16*)(ws + WS_GM); bf16* AM = (bf16*)(ws + WS_RA);
    bf16* QC = (bf16*)(ws + WS_RW); bf16* KC = QC + (size_t)TA * MW; bf16* HH = (bf16*)(ws + WS_H);
    hipLaunchKernelGGL(k_conv, dim3((unsigned)(((size_t)TA * 1024 + 255) / 256)), dim3(256), 0, st, MQ, MK, conv_w, conv_b, QC, KC);
    hipLaunchKernelGGL(k_mlstm, dim3(NB * MH * 2), dim3(256), 0, st, QC, KC, MV, GATES, HH);
    hipLaunchKernelGGL(k_mlstm_out, dim3(T * MH / 4), dim3(256), 0, st, HH, MO, g_mlstm, AM);
    for (int ph = 4; ph < 16; ++ph) launch_mk(st, a, grid, ph, ph + 1);
}
```

```cpp
#include <hip/hip_runtime.h>
#include <cstdio>
#include <cstdint>
#include <cstring>

constexpr int D = 1024, NB = 32, S = 2048, CL = 256, T = NB * S, TC = NB * CL, TA = T + TC, SL = S + CL;
constexpr int NMOD = 6, INW = 4880;
constexpr int AH = 8, AKV = 2, HD = 64, AW = 512, KVW = 128;
constexpr int MH = 4, MD = 128, MW = 512, MCH = 64;
constexpr int NE = 256, TOPK = 8, NG = 8, TKG = 4, EFF = 256;
constexpr float EPS = 1e-6f, RSCALE = 2.5f;
constexpr int C_Q = 0, C_K = 512, C_V = 640, C_MQ = 768, C_MK = 1280, C_MV = 1792, C_MO = 2304, C_MI = 2816, C_MF = 2824, C_GA = 2832, C_GM = 3856;
constexpr int N1 = 4864;

typedef unsigned short bf16;
typedef short bf16x8 __attribute__((ext_vector_type(8)));
typedef float f32x4 __attribute__((ext_vector_type(4)));
typedef float f32x2 __attribute__((ext_vector_type(2)));
typedef unsigned u32x4 __attribute__((ext_vector_type(4)));
typedef unsigned u32x2 __attribute__((ext_vector_type(2)));
#define LAS __attribute__((address_space(3)))
#define GAS __attribute__((address_space(1)))
__device__ __forceinline__ float bf2f(bf16 b) { return __uint_as_float(((unsigned)b) << 16); }
__device__ __forceinline__ bf16 f2bf(float f) { unsigned u = __float_as_uint(f); u += 0x7fffu + ((u >> 16) & 1u); return (bf16)(u >> 16); }
typedef __bf16 bf16x2_t __attribute__((ext_vector_type(2)));
__device__ __forceinline__ unsigned cvt_pk_bf16(float lo, float hi) { unsigned r; asm volatile("v_cvt_pk_bf16_f32 %0, %1, %2" : "=v"(r) : "v"(lo), "v"(hi)); return r; }
__device__ __forceinline__ unsigned cvt_pk_bf16_s(float lo, float hi) { const f32x2 v = {lo, hi}; return __builtin_bit_cast(unsigned, __builtin_convertvector(v, bf16x2_t)); }
__device__ __forceinline__ float ldf(const float* p) { return *p; }
__device__ __forceinline__ float ldf(const bf16* p) { return bf2f(*p); }
__device__ __forceinline__ float sigmoidf_(float x) { return 1.f / (1.f + __expf(-x)); }
__device__ __forceinline__ float siluf_(float x) { return x / (1.f + __expf(-x)); }
__device__ __forceinline__ float wave_sum(float v) {
#pragma unroll
    for (int o = 1; o < 64; o <<= 1) v += __shfl_xor(v, o);
    return v;
}
__device__ __forceinline__ int seqrow_lat(int r) { const int b = r / S, t = r % S; return b * SL + CL + t; }
__device__ __forceinline__ int seqrow_ctx(int r) { const int b = r / CL, t = r % CL; return b * SL + t; }

constexpr size_t MiB = 1u << 20;
constexpr size_t WS_CTL = 0, CTL_ZERO_BYTES = 1 * MiB;
constexpr size_t WS_MOD = 1 * MiB;
constexpr size_t WS_GATES = 2 * MiB;
constexpr size_t WS_ROPE = 7 * MiB;
constexpr size_t WS_BT1 = 8 * MiB;
constexpr size_t WS_WAT = 18 * MiB;
constexpr size_t WS_WMT = 19 * MiB;
constexpr size_t WS_WOT = 20 * MiB;
constexpr size_t WS_WRT = 22 * MiB;
constexpr size_t WS_WSGU = 23 * MiB;
constexpr size_t WS_WSD = 24 * MiB;
constexpr size_t WS_RS1 = 25 * MiB;
constexpr size_t WS_RS2 = 29 * MiB;
constexpr size_t WS_TOPI = 33 * MiB;
constexpr size_t WS_TOPW = 35 * MiB;
constexpr size_t WS_LIST = 37 * MiB;
constexpr size_t WS_LISTW = 40 * MiB;
constexpr size_t WS_TILE = 43 * MiB;
constexpr size_t WS_RA = 44 * MiB;
constexpr size_t WS_RW = 188 * MiB;
constexpr size_t WS_GA = 572 * MiB;
constexpr size_t WS_GM = 700 * MiB;
constexpr size_t WS_Q = 828 * MiB;
constexpr size_t WS_MO = 892 * MiB;
constexpr size_t WS_H = 956 * MiB;
constexpr size_t WS_NEED = 1084 * MiB;
constexpr size_t DO_MQ = 0, DO_MK = 72 * MiB, DO_MV = 144 * MiB, DO_K = 216 * MiB, DO_V = 234 * MiB;
constexpr int CW_CNT = 0;
constexpr int CW_OFF = 256;
constexpr int CW_FILL = 1024;
constexpr int CW_BAR = 4096;
constexpr int RING_BYTES = 131072, LDSCTL_OFF = 143360  , LDS_BYTES = 147456;
constexpr int NWAVES = 8;
namespace eng {
constexpr int BM = 256, BK = 64, HALF = 128, HTB = HALF * BK * 2, STAGE_BYTES = 8 * HTB;
__host__ __device__ __forceinline__ int lds_byte(int r, int c) { const int st = (r >> 4) * 2 + (c >> 5), rr = r & 15, cc = c & 31, ob = rr * 64 + cc * 2; return st * 1024 + (ob ^ (((ob >> 9) & 1) << 5)); }
__host__ __device__ __forceinline__ void stage_rc(int b, int& R, int& C) { const int st = b / 1024, sb = b % 1024, swz = sb ^ (((sb >> 9) & 1) << 5); R = (st >> 1) * 16 + swz / 64; C = (st & 1) * 32 + (swz % 64) / 2; }
__host__ __device__ __forceinline__ int perm32(int rho) { const int n = rho >> 4, i = rho & 15; return 8 * (i >> 2) + 4 * n + (i & 3); }

struct UnitD { const char* A; const char* B; unsigned lda, ldb; int nt, type, r0, r1, r2, r3; };

typedef f32x4 Acc[2][2][4][2];

template <class Prog, int AUX_A>
__device__ __forceinline__ void gemm_stream(LAS unsigned char* lds, const Prog& P) {
    int tid = threadIdx.x; asm volatile("" : "+v"(tid));
    const int wid = __builtin_amdgcn_readfirstlane(tid >> 6), lane = tid & 63, wr = wid >> 2, wc = wid & 3, fr = lane & 15, fq = lane >> 4;
    int Rr[2], Cc[2], Rb[2];
#pragma unroll
    for (int i = 0; i < 2; ++i) { int R, C; stage_rc(tid * 16 + i * 8192, R, C); Rr[i] = R; Cc[i] = C * 2; Rb[i] = (R & ~31) + perm32(R & 31); }
    const size_t kstep = (size_t)(BK * 2);
    const unsigned ldsw = (unsigned)wid * 1024u;
    const int aoff = lds_byte(wr * 64 + fr, fq * 8), boff = lds_byte(wc * 32 + fr, fq * 8);
#define EG_SA(b, h) (((b) * 2 + (h)) * HTB)
#define EG_SB(b, h) ((4 + (b) * 2 + (h)) * HTB)
#define EG_STAGE_B(bufoff, gbase) do { _Pragma("unroll") for (int _i = 0; _i < 2; ++_i) \
        __builtin_amdgcn_global_load_lds((const unsigned*)((const char*)(gbase) + oB[_i]), (LAS unsigned*)(lds + (bufoff) + ldsw + _i * 8192), 16, 0, 0); } while (0)
#define EG_STAGE_A(bufoff, gbase, h) do { _Pragma("unroll") for (int _i = 0; _i < 2; ++_i) \
        __builtin_amdgcn_global_load_lds((const unsigned*)((const char*)(gbase) + oA[h][_i]), (LAS unsigned*)(lds + (bufoff) + ldsw + _i * 8192), 16, 0, AUX_A); } while (0)
#define EG_LDA(dst, b, h) do { _Pragma("unroll") for (int m = 0; m < 4; ++m) _Pragma("unroll") for (int k = 0; k < 2; ++k) dst[m][k] = *(const LAS bf16x8*)(lds + EG_SA(b, h) + aoff + m * 2048 + k * 1024); } while (0)
#define EG_LDB(dst, b, h) do { _Pragma("unroll") for (int n = 0; n < 2; ++n) _Pragma("unroll") for (int k = 0; k < 2; ++k) dst[n][k] = *(const LAS bf16x8*)(lds + EG_SB(b, h) + boff + n * 2048 + k * 1024); } while (0)
#define EG_MMA(ai, bj, At, Bt) do { __builtin_amdgcn_s_setprio(1); _Pragma("unroll") for (int m = 0; m < 4; ++m) _Pragma("unroll") for (int n = 0; n < 2; ++n) _Pragma("unroll") for (int k = 0; k < 2; ++k) \
        acc[ai][bj][m][n] = __builtin_amdgcn_mfma_f32_16x16x32_bf16(Bt[n][k], At[m][k], acc[ai][bj][m][n], 0, 0, 0); __builtin_amdgcn_s_setprio(0); } while (0)
#define EG_WAIT_V(n) asm volatile("s_waitcnt vmcnt(" #n ")" ::: "memory")
#define EG_WAIT_L(n) asm volatile("s_waitcnt lgkmcnt(" #n ")" ::: "memory")
#define EG_BAR __builtin_amdgcn_s_barrier()
#define EG_SCHED __builtin_amdgcn_sched_barrier(0)
    UnitD cur, nxt; int ui = 0;
    if (!P.next(0, cur, lds)) return;
    Acc acc;
#pragma unroll
    for (int a = 0; a < 2; ++a)
#pragma unroll
        for (int b = 0; b < 2; ++b)
#pragma unroll
            for (int m = 0; m < 4; ++m)
#pragma unroll
                for (int n = 0; n < 2; ++n) acc[a][b][m][n] = (f32x4){0.f, 0.f, 0.f, 0.f};
    bf16x8 At[4][2], B0[2][2], B1[2][2];
    unsigned oA[2][2], oB[2];
    P.first(cur, lds);
    P.offsets(cur, Rr, Cc, oA, lds);
#pragma unroll
    for (int i = 0; i < 2; ++i) oB[i] = (unsigned)Rb[i] * cur.ldb + (unsigned)Cc[i];
    const char* cA = cur.A; const char* cB = cur.B; size_t hB = (size_t)HALF * cur.ldb;
    EG_STAGE_B(EG_SB(0, 0), cB); EG_STAGE_B(EG_SB(0, 1), cB + hB); EG_STAGE_A(EG_SA(0, 0), cA, 0); EG_STAGE_A(EG_SA(0, 1), cA, 1);
    if (wr == 1) EG_BAR;
    EG_WAIT_V(2); EG_BAR;
    EG_STAGE_B(EG_SB(1, 0), cB + kstep); EG_STAGE_A(EG_SA(1, 0), cA + kstep, 0); EG_STAGE_B(EG_SB(1, 1), cB + hB + kstep);
    EG_WAIT_V(6); EG_BAR;
    for (;;) {
        const bool has_next = P.next(ui + 1, nxt, lds);
        if (has_next) P.prefetch(nxt, lds);
        const int nt = cur.nt;
        for (int t = 0; t < nt; t += 2) {
            const bool last = (t == nt - 2);
            EG_LDB(B0, 0, 0); EG_LDB(B1, 0, 1); EG_SCHED; EG_LDA(At, 0, 0); EG_STAGE_A(EG_SA(1, 1), cA + (size_t)(t + 1) * kstep, 1);
            EG_WAIT_V(8); EG_WAIT_L(0); EG_BAR; EG_MMA(0, 0, At, B0); EG_MMA(0, 1, At, B1); EG_BAR; EG_SCHED;
            const char *a2, *b2;
            if (last) {
                if (has_next) {
                    P.offsets(nxt, Rr, Cc, oA, lds);
#pragma unroll
                    for (int i = 0; i < 2; ++i) oB[i] = (unsigned)Rb[i] * nxt.ldb + (unsigned)Cc[i];
                    cA = nxt.A; cB = nxt.B; hB = (size_t)HALF * nxt.ldb;
                }
                a2 = cA; b2 = cB;
            } else { a2 = cA + (size_t)(t + 2) * kstep; b2 = cB + (size_t)(t + 2) * kstep; }
            const char* a3 = a2 + kstep; const char* b3 = b2 + kstep;
            EG_LDA(At, 0, 1); EG_STAGE_B(EG_SB(0, 0), b2); EG_STAGE_B(EG_SB(0, 1), b2 + hB); EG_STAGE_A(EG_SA(0, 0), a2, 0);
            EG_WAIT_V(8); EG_WAIT_L(0); EG_BAR; EG_MMA(1, 0, At, B0); EG_MMA(1, 1, At, B1); EG_BAR; EG_SCHED;
            EG_LDB(B0, 1, 0); EG_LDB(B1, 1, 1); EG_SCHED; EG_LDA(At, 1, 0); EG_STAGE_A(EG_SA(0, 1), a2, 1);
            EG_WAIT_V(8); EG_WAIT_L(0); EG_BAR; EG_MMA(0, 0, At, B0); EG_MMA(0, 1, At, B1); EG_BAR; EG_SCHED;
            EG_LDA(At, 1, 1); EG_STAGE_B(EG_SB(1, 0), b3); EG_STAGE_B(EG_SB(1, 1), b3 + hB); EG_STAGE_A(EG_SA(1, 0), a3, 0);
            EG_WAIT_V(8); EG_WAIT_L(0); EG_BAR; EG_MMA(1, 0, At, B0); EG_MMA(1, 1, At, B1); EG_BAR; EG_SCHED;
        }
        if (wr == 0) EG_BAR;
        P.epilogue(acc, cur, wr, wc, fr, fq, lds);
        if (!has_next) break;
#pragma unroll
        for (int a = 0; a < 2; ++a)
#pragma unroll
            for (int b = 0; b < 2; ++b)
#pragma unroll
                for (int m = 0; m < 4; ++m)
#pragma unroll
                    for (int n = 0; n < 2; ++n) acc[a][b][m][n] = (f32x4){0.f, 0.f, 0.f, 0.f};
        cur = nxt; ++ui;
        if (wr == 1) EG_BAR;
    }
    EG_WAIT_V(0);
    EG_BAR;
#undef EG_SA
#undef EG_SB
#undef EG_STAGE_A
#undef EG_STAGE_B
#undef EG_LDA
#undef EG_LDB
#undef EG_MMA
#undef EG_WAIT_V
#undef EG_WAIT_L
#undef EG_BAR
#undef EG_SCHED
}
template <int ACT  >
__device__ __forceinline__ void store_tile_bf16(const Acc& acc, bf16* dst, size_t ld) {
#pragma unroll
    for (int ai = 0; ai < 2; ++ai)
#pragma unroll
        for (int m = 0; m < 4; ++m) { bf16* rowp = dst + (size_t)(ai * HALF + m * 16) * ld;
#pragma unroll
            for (int bj = 0; bj < 2; ++bj) { f32x4 v0 = acc[ai][bj][m][0], v1 = acc[ai][bj][m][1];
                if (ACT == 1) {
#pragma unroll
                    for (int e = 0; e < 4; ++e) { v0[e] = sigmoidf_(v0[e]); v1[e] = sigmoidf_(v1[e]); } }
                u32x4 w; w.x = cvt_pk_bf16(v0[0], v0[1]); w.y = cvt_pk_bf16(v0[2], v0[3]); w.z = cvt_pk_bf16(v1[0], v1[1]); w.w = cvt_pk_bf16(v1[2], v1[3]);
                *(u32x4*)(rowp + bj * HALF) = w; } }
}
}
#define RLX_AGENT __ATOMIC_RELAXED, __HIP_MEMORY_SCOPE_AGENT
#define LDS_WAIT() asm volatile("s_waitcnt lgkmcnt(0)" ::: "memory")
#define VM_WAIT() asm volatile("s_waitcnt vmcnt(0)" ::: "memory")
#define XB_TMO      128
#define XB_XCNT(j)  (256  + 64 * (j))
#define XB_XSUB(j)  (1280 + 64 * (j))
#define XB_XGEN(j)  (2304 + 64 * (j))
#define XB_TOP      3328
#define XB_TOPGEN   3392
#define XCD_BAR_WORDS 3456
#define XB_SPIN_CAP (1u << 18)

__device__ __forceinline__ unsigned xb_ld(unsigned* p)              { return __hip_atomic_load(p, __ATOMIC_RELAXED, __HIP_MEMORY_SCOPE_AGENT); }
__device__ __forceinline__ unsigned xb_add(unsigned* p, unsigned v) { return __hip_atomic_fetch_add(p, v, __ATOMIC_RELAXED, __HIP_MEMORY_SCOPE_AGENT); }
__device__ __forceinline__ unsigned xb_xcc_id() { return (unsigned)__builtin_amdgcn_s_getreg((3 << 11) | 20) & 0xFu; }
#define XB_SPIN(cond, bar) do { unsigned _sp = 0; while (cond) { __builtin_amdgcn_s_sleep(1); \
    if ((++_sp & 255u) == 0u) { if (xb_ld(&(bar)[XB_TMO])) break; if (_sp > XB_SPIN_CAP) { atomicAdd(&(bar)[XB_TMO], 1u); break; } } } } while (0)

struct XcdBarrier {
    unsigned* bar; unsigned x;
    volatile LAS unsigned* st;
};

__device__ __forceinline__ XcdBarrier xcd_barrier_post(unsigned* bar, volatile LAS unsigned* st) {
    XcdBarrier b; b.bar = bar; b.x = xb_xcc_id(); b.st = st;
    if (threadIdx.x == 0) (void)xb_add(&bar[XB_XCNT(b.x)], 1u);
    return b;
}
__device__ __forceinline__ void xcd_barrier_complete(unsigned* bar, unsigned x, unsigned& nloc, unsigned& nx) {
    const unsigned G = gridDim.x * gridDim.y * gridDim.z;
    unsigned sum, cnt, mine, sp = 0u;
    for (;;) {
        sum = 0u; cnt = 0u; mine = 0u;
#pragma unroll
        for (unsigned j = 0; j < 16; ++j) { const unsigned c = xb_ld(&bar[XB_XCNT(j)]); sum += c; cnt += (c > 0u) ? 1u : 0u; mine = (j == x) ? c : mine; }
        if (sum == G) break;
        __builtin_amdgcn_s_sleep(1);
        if ((++sp & 255u) == 0u) { if (xb_ld(&bar[XB_TMO])) break; if (sp > XB_SPIN_CAP) { atomicAdd(&bar[XB_TMO], 1u); break; } }
    }
    nloc = mine > 0u ? mine : 1u; nx = cnt > 0u ? cnt : 1u;
}

__device__ __forceinline__ void xcd_barrier(const XcdBarrier& b) {
    asm volatile("s_waitcnt vmcnt(0)" ::: "memory");
    __syncthreads();
    if (threadIdx.x == 0) {
        unsigned* bar = b.bar;
        __builtin_amdgcn_s_waitcnt(0);
        unsigned nloc = b.st[0], nx = b.st[1];
        if (nloc == 0u) { xcd_barrier_complete(bar, b.x, nloc, nx); b.st[0] = nloc; b.st[1] = nx; }
        const unsigned old = xb_add(&bar[XB_XSUB(b.x)], 1u);
        const unsigned gen = old / nloc;
        if (old + 1u == (gen + 1u) * nloc) {
            __builtin_amdgcn_fence(__ATOMIC_RELEASE, "agent");
            asm volatile("s_waitcnt vmcnt(0)" ::: "memory");
            const unsigned og = xb_add(&bar[XB_TOP], 1u);
            const unsigned tg = og / nx;
            if (og + 1u == (tg + 1u) * nx) xb_add(&bar[XB_TOPGEN], 1u);
            else XB_SPIN(xb_ld(&bar[XB_TOPGEN]) == tg, bar);
            __builtin_amdgcn_fence(__ATOMIC_ACQUIRE, "agent");
            xb_add(&bar[XB_XGEN(b.x)], 1u);
            asm volatile("s_waitcnt vmcnt(0)" ::: "memory");
        } else {
            XB_SPIN(xb_ld(&bar[XB_XGEN(b.x)]) == gen, bar);
            __builtin_amdgcn_fence(__ATOMIC_ACQUIRE, "agent");
            asm volatile("s_waitcnt vmcnt(0)" ::: "memory");
        }
    }
    __syncthreads();
}

struct Args { const float* in[29]; float* out; unsigned char* ws; int ph_lo, ph_hi; };
struct Frame {
    LAS unsigned char* lds;
    int vcu, G;
    unsigned char* ws; unsigned char* dout;
};
__device__ __forceinline__ int sigma_in(int np) {
    if (np < 768) { const int p = np & 255, bj = p >> 7, wc = (p >> 5) & 3, j = p & 31;
        if (np < 512) return C_Q + (4 * (np >> 8) + wc) * 64 + (j >> 4) * 32 + bj * 16 + (j & 15);
        if (wc < 2) return C_K + wc * 64 + (j >> 4) * 32 + bj * 16 + (j & 15);
        return C_V + (wc - 2) * 64 + bj * 32 + j; }
    return np < 2816 ? np : np + 16;
}
__device__ __forceinline__ void transpose_item(const float* W, size_t ldw, int k0, int scol, bf16* WT, size_t ldt, int n0, LAS float* scr, int lane) {
#pragma unroll 8
    for (int i = 0; i < 32; ++i) { const int kk = 2 * i + (lane >> 5); scr[kk * 33 + (lane & 31)] = W[(size_t)(k0 + kk) * ldw + scol]; }
    LDS_WAIT(); asm volatile("" ::: "memory");
    const int c = lane & 7;
#pragma unroll
    for (int j = 0; j < 4; ++j) { const int n = (lane >> 3) + 8 * j; const LAS float* s = scr + (8 * c) * 33 + n;
        u32x4 o; o.x = cvt_pk_bf16(s[0 * 33], s[1 * 33]); o.y = cvt_pk_bf16(s[2 * 33], s[3 * 33]); o.z = cvt_pk_bf16(s[4 * 33], s[5 * 33]); o.w = cvt_pk_bf16(s[6 * 33], s[7 * 33]);
        *(u32x4*)(WT + (size_t)(n0 + n) * ldt + k0 + 8 * c) = o; }
    LDS_WAIT(); asm volatile("" ::: "memory");
}
__device__ __forceinline__ void transpose_job(const float* W, size_t ldw, int Kr, int Nd, int scol0, bf16* WT, size_t ldt, int drow0, LAS float* scr, int lane, int gw, int NGW) {
    const int nnb = Nd / 32, nit = (Kr / 64) * nnb;
    for (int it = gw; it < nit; it += NGW) { const int kb = it / nnb, nb = it % nnb; transpose_item(W, ldw, 64 * kb, scol0 + 32 * nb + (lane & 31), WT, ldt, drow0 + 32 * nb, scr, lane); }
}
__device__ __forceinline__ void p0_prologue(Frame& F, const Args& a) {
    int tid_ = threadIdx.x; asm volatile("" : "+v"(tid_)); const int lane_ = tid_ & 63, wave_ = __builtin_amdgcn_readfirstlane(tid_ >> 6);
    LAS float* scr = (LAS float*)(F.lds + wave_ * 16384);
    const int gw = F.vcu * NWAVES + wave_, NGW = F.G * NWAVES, lane = lane_;
    { const float* w_in = a.in[10]; bf16* BT1 = (bf16*)(F.ws + WS_BT1);
      constexpr int NIT = (D / 64) * (N1 / 32);
      for (int it = gw; it < NIT; it += NGW) { const int kb = it / (N1 / 32), nb = it % (N1 / 32); transpose_item(w_in, INW, 64 * kb, sigma_in(32 * nb + (lane & 31)), BT1, D, 32 * nb, scr, lane); } }
    transpose_job(a.in[18], D, 512, D, 0, (bf16*)(F.ws + WS_WAT), 512, 0, scr, lane, gw, NGW);
    transpose_job(a.in[19], D, 512, D, 0, (bf16*)(F.ws + WS_WMT), 512, 0, scr, lane, gw, NGW);
    transpose_job(a.in[20], D, D, D, 0, (bf16*)(F.ws + WS_WOT), D, 0, scr, lane, gw, NGW);
    transpose_job(a.in[21], NE, D, NE, 0, (bf16*)(F.ws + WS_WRT), D, 0, scr, lane, gw, NGW);
    for (int n = 0; n < 2; ++n) {
        transpose_job(a.in[26], EFF, D, 128, 128 * n, (bf16*)(F.ws + WS_WSGU), D, 256 * n, scr, lane, gw, NGW);
        transpose_job(a.in[27], EFF, D, 128, 128 * n, (bf16*)(F.ws + WS_WSGU), D, 256 * n + 128, scr, lane, gw, NGW); }
    transpose_job(a.in[28], D, EFF, D, 0, (bf16*)(F.ws + WS_WSD), EFF, 0, scr, lane, gw, NGW);
    { float* rc = (float*)(F.ws + WS_ROPE); float* rsn = rc + 1024;
      for (int i = F.vcu * 512 + tid_; i < 1024; i += F.G * 512) { const int pos = i >> 4, f = i & 15; const float inv = exp2f(-(float)f * (13.287712379549449f / 16.f)); const float ang = (float)pos * inv; rc[i] = cosf(ang); rsn[i] = sinf(ang); } }
    __syncthreads();
    { const float* c = a.in[1]; const float* c_ctx = a.in[3]; const float* w_ada = a.in[4]; const float* b_ada = a.in[5]; float* mod = (float*)(F.ws + WS_MOD);
      LAS float* sC = (LAS float*)F.lds;
      for (int i = tid_; i < 33 * 1024; i += 512) { const int r = i >> 10, k = i & 1023; const float v = r < NB ? c[i] : c_ctx[k]; sC[r * 1025 + k] = siluf_(v); }
      __syncthreads();
      for (int cb = F.vcu; cb < 256; cb += F.G)
          for (int o = tid_; o < 33 * 24; o += 512) { const int r = o / 24, col = cb * 24 + o % 24; float s = 0.f;
#pragma unroll 8
              for (int k = 0; k < 1024; ++k) s += sC[r * 1025 + k] * w_ada[(size_t)k * (NMOD * D) + col];
              mod[(size_t)r * (NMOD * D) + col] = s + b_ada[col]; }
      __syncthreads(); }
}
__device__ __forceinline__ void p1_norm_gates(Frame& F, const Args& a) {
    int tid_ = threadIdx.x; asm volatile("" : "+v"(tid_)); const int lane_ = tid_ & 63, wave_ = __builtin_amdgcn_readfirstlane(tid_ >> 6);
    const float* x = a.in[0]; const float* ctx = a.in[2]; const float* g = a.in[6]; const float* w_in = a.in[10]; const float* b_i = a.in[15]; const float* b_f = a.in[16];
    const float* mod = (const float*)(F.ws + WS_MOD); bf16* A1 = (bf16*)(F.ws + WS_RA); float* GATES = (float*)(F.ws + WS_GATES);
    LAS float* wT = (LAS float*)F.lds;
    for (int i = tid_; i < 16 * 1024; i += 512) { const int k = i >> 4, gi = i & 15; wT[gi * 1024 + k] = w_in[(size_t)k * INW + C_MI + gi]; }
    __syncthreads();
    const int gw = F.vcu * NWAVES + wave_, NGW = F.G * NWAVES, lane = lane_;
    const f32x4* g4 = (const f32x4*)g;
    for (int row = gw; row < TA; row += NGW) {
        const bool lat = row < T;
        const f32x4* xr = (const f32x4*)(lat ? x + (size_t)row * D : ctx + (size_t)(row - T) * D);
        const f32x4* mr = (const f32x4*)(mod + (size_t)(lat ? row / S : NB) * (NMOD * D));
        f32x4 v[4]; float ss = 0.f;
#pragma unroll
        for (int j = 0; j < 4; ++j) { v[j] = xr[64 * j + lane]; ss += (v[j][0] * v[j][0] + v[j][1] * v[j][1]) + (v[j][2] * v[j][2] + v[j][3] * v[j][3]); }
        const float rs = rsqrtf(wave_sum(ss) * (1.f / D) + EPS);
        u32x2* o8 = (u32x2*)(A1 + (size_t)row * D);
#pragma unroll
        for (int j = 0; j < 4; ++j) { const f32x4 gg = g4[64 * j + lane], sh = mr[64 * j + lane], sc = mr[256 + 64 * j + lane];
            v[j] = v[j] * rs * gg * (sc + 1.f) + sh;
            u32x2 w; w.x = cvt_pk_bf16(v[j][0], v[j][1]); w.y = cvt_pk_bf16(v[j][2], v[j][3]); o8[64 * j + lane] = w; }
        float p[16];
#pragma unroll
        for (int gi = 0; gi < 16; ++gi) { float s = 0.f;
#pragma unroll
            for (int j = 0; j < 4; ++j) { const f32x4 w = *(const LAS f32x4*)(wT + gi * 1024 + 256 * j + 4 * lane); s += (v[j][0] * w[0] + v[j][1] * w[1]) + (v[j][2] * w[2] + v[j][3] * w[3]); }
            p[gi] = wave_sum(s); }
        float mine = 0.f;
#pragma unroll
        for (int gi = 0; gi < 16; ++gi) mine = (lane == gi) ? p[gi] : mine;
        if (lane < 16) { const int sr = lat ? seqrow_lat(row) : seqrow_ctx(row - T); float r;
            if (lane < 8) r = mine + b_i[lane]; else { const float xx = mine + b_f[lane - 8]; r = fminf(xx, 0.f) - log1pf(__expf(-fabsf(xx))); }
            GATES[(size_t)sr * 16 + lane] = r; }
    }
    __syncthreads();
}
constexpr float QSCALE = 0.125f * 1.4426950408889634f;
struct ProgInProj {
    const char* A1; const char* BT1; int G, c;
    bf16 *Q, *K, *V, *MQ, *MO, *GA; const LAS float* tab;
    __device__ __forceinline__ bool next(int i, eng::UnitD& u, LAS unsigned char*) const {
        const long L = (long)i * G + c; if (L >= 5088) return false;
        int pm, pn;
        if (L < 4864) { int wgid = (int)L; { const int q = 4864 / 8, xcd = wgid % 8, off = wgid / 8; wgid = xcd * q + off; }
            const int nig = 8 * 19, gid = wgid / nig, fm = gid * 8; pm = fm + ((wgid % nig) % 8); pn = (wgid % nig) / 8; }
        else { const int j = (int)L - 4864; pm = 256 + (j & 31); pn = 2 + (j >> 5); }
        u.A = A1 + (size_t)pm * (256 * 2048); u.B = BT1 + (size_t)pn * (256 * 2048); u.lda = 2048; u.ldb = 2048; u.nt = 16; u.type = 0; u.r0 = pm; u.r1 = pn; u.r2 = 0; u.r3 = 0; return true;
    }
    __device__ __forceinline__ void first(const eng::UnitD&, LAS unsigned char*) const {}
    __device__ __forceinline__ void prefetch(const eng::UnitD&, LAS unsigned char*) const {}
    __device__ __forceinline__ void offsets(const eng::UnitD& u, const int (&Rr)[2], const int (&Cc)[2], unsigned (&oA)[2][2], LAS unsigned char*) const {
#pragma unroll
        for (int h = 0; h < 2; ++h)
#pragma unroll
            for (int i = 0; i < 2; ++i) oA[h][i] = (unsigned)(128 * h + Rr[i]) * u.lda + (unsigned)Cc[i];
    }
    template <bool ROPE>
    __device__ __forceinline__ void qk_epi(const eng::Acc& acc, bf16* dst  , size_t ld, const LAS float* gain, float scale, int pm, int wr, int fr, int fq) const {
        const LAS float* rope = tab;
        f32x4 gv[2][2];
#pragma unroll
        for (int bj = 0; bj < 2; ++bj)
#pragma unroll
            for (int n = 0; n < 2; ++n) gv[bj][n] = *(const LAS f32x4*)(gain + (fq >> 1) * 32 + bj * 16 + 8 * (fq & 1) + 4 * n);
#pragma unroll
        for (int ai = 0; ai < 2; ++ai)
#pragma unroll
            for (int m = 0; m < 4; ++m) {
                float ss = 0.f;
#pragma unroll
                for (int bj = 0; bj < 2; ++bj)
#pragma unroll
                    for (int n = 0; n < 2; ++n) { const f32x4 v = acc[ai][bj][m][n]; ss += (v[0] * v[0] + v[1] * v[1]) + (v[2] * v[2] + v[3] * v[3]); }
                ss += __shfl_xor(ss, 16); ss += __shfl_xor(ss, 32);
                const float rs = rsqrtf(ss * (1.f / HD) + EPS) * scale;
                f32x4 o1[2], o2[2];
#pragma unroll
                for (int n = 0; n < 2; ++n) { const f32x4 x1 = acc[ai][0][m][n] * rs * gv[0][n], x2 = acc[ai][1][m][n] * rs * gv[1][n];
                    if (ROPE) { const int pos = (fq >> 1) ? (16 * m + fr) : ((4 * pm + 2 * ai + wr) & 31);
                        const f32x4 cs = *(const LAS f32x4*)(rope + pos * 16 + 8 * (fq & 1) + 4 * n), sn = *(const LAS f32x4*)(rope + 1024 + pos * 16 + 8 * (fq & 1) + 4 * n);
                        o1[n] = x1 * cs - x2 * sn; o2[n] = x2 * cs + x1 * sn; }
                    else { o1[n] = x1; o2[n] = x2; } }
                bf16* rowp = dst + (size_t)(ai * 128 + m * 16) * ld;
                u32x4 w; w.x = cvt_pk_bf16(o1[0][0], o1[0][1]); w.y = cvt_pk_bf16(o1[0][2], o1[0][3]); w.z = cvt_pk_bf16(o1[1][0], o1[1][1]); w.w = cvt_pk_bf16(o1[1][2], o1[1][3]);
                *(u32x4*)(rowp) = w;
                w.x = cvt_pk_bf16(o2[0][0], o2[0][1]); w.y = cvt_pk_bf16(o2[0][2], o2[0][3]); w.z = cvt_pk_bf16(o2[1][0], o2[1][1]); w.w = cvt_pk_bf16(o2[1][2], o2[1][3]);
                *(u32x4*)(rowp + 32) = w;
            }
    }
    __device__ __forceinline__ void v_epi(const eng::Acc& acc, bf16* dst, size_t ld) const {
#pragma unroll
        for (int ai = 0; ai < 2; ++ai)
#pragma unroll
            for (int m = 0; m < 4; ++m) { bf16* rowp = dst + (size_t)(ai * 128 + m * 16) * ld;
#pragma unroll
                for (int bj = 0; bj < 2; ++bj) { const f32x4 v0 = acc[ai][bj][m][0], v1 = acc[ai][bj][m][1];
                    u32x4 w; w.x = cvt_pk_bf16(v0[0], v0[1]); w.y = cvt_pk_bf16(v0[2], v0[3]); w.z = cvt_pk_bf16(v1[0], v1[1]); w.w = cvt_pk_bf16(v1[2], v1[3]);
                    *(u32x4*)(rowp + bj * 32) = w; } }
    }
    __device__ __forceinline__ void epilogue(eng::Acc& acc, const eng::UnitD& u, int wr, int wc, int fr, int fq, LAS unsigned char*) const {
        const int pm = u.r0, pn = u.r1; const bool lat = pm < 256;
        const int lrow = wr * 64 + fr;
        const size_t r0 = (size_t)pm * 256;
        const size_t sr0 = lat ? r0 + (size_t)(pm / 8 + 1) * CL : (size_t)(pm - 256) * SL;
        if (pn < 2) { qk_epi<true>(acc, Q + (r0 + lrow) * AW + (4 * pn + wc) * 64 + 8 * fq, AW, tab + 2048, QSCALE, pm, wr, fr, fq); }
        else if (pn == 2) {
            if (wc < 2) { bf16* d = K + (sr0 + lrow) * KVW + wc * 64 + 8 * fq; if (lat) qk_epi<true>(acc, d, KVW, tab + 2112, 1.f, pm, wr, fr, fq); else qk_epi<false>(acc, d, KVW, tab + 2112, 1.f, pm, wr, fr, fq); }
            else v_epi(acc, V + (sr0 + lrow) * KVW + (wc - 2) * 64 + 8 * fq, KVW);
        }
        else if (pn < 9) { bf16* base = MQ + (size_t)((pn - 3) >> 1) * ((size_t)TA * MW); const int ct = ((pn - 3) & 1) * 256;
            eng::store_tile_bf16<0>(acc, base + (sr0 + lrow) * MW + ct + wc * 32 + 8 * fq, MW); }
        else if (pn < 11) eng::store_tile_bf16<0>(acc, MO + (r0 + lrow) * MW + (pn - 9) * 256 + wc * 32 + 8 * fq, MW);
        else { bf16* base = GA + (size_t)((pn - 11) >> 2) * ((size_t)T * D);
            eng::store_tile_bf16<1>(acc, base + (r0 + lrow) * D + ((pn - 11) & 3) * 256 + wc * 32 + 8 * fq, D); }
    }
};
#include <hip/hip_bf16.h>
#include <cmath>
namespace attn_body {
using bf16=__hip_bfloat16;
using bf16x8=__attribute__((ext_vector_type(8)))short;
using s16x4=__attribute__((ext_vector_type(4)))short;
using f32x16=__attribute__((ext_vector_type(16)))float;
using u32x4=__attribute__((ext_vector_type(4)))unsigned;
constexpr int BATCH=32,NHEAD=8,SEQ=2048,SKV=2304,D=64,QP=512,KP=128,OP=1024;
constexpr int NW=8,QBLK=32,QB=QBLK*NW,KVBLK=64,NQB=SEQ/QB;
constexpr int ATTN_UNIT_ROWS=QB;
__device__ __forceinline__ int crow(int r,int hi){return (r&3)+8*(r>>2)+4*hi;}
#define SBAR() __builtin_amdgcn_sched_barrier(0)
__device__ __forceinline__ void cmask(f32x16&p0,f32x16&p1,int jb,int qrel,int hi){
  const float NEG=-INFINITY; int kb=64*jb+4*hi;
  #pragma unroll
  for(int r=0;r<16;++r){int kv=kb+(r&3)+8*(r>>2); if(kv>qrel)p0[r]=NEG; if(kv+32>qrel)p1[r]=NEG;}
}

constexpr int NSLOT=3, SLOTB=8192;
constexpr int LDS_K=0, LDS_V=NSLOT*SLOTB, LDS_WS=2*NSLOT*SLOTB, LDS_OST=LDS_WS+NW*64*4, LDS_BYTES=LDS_OST+NW*4096;
constexpr float C2=0.125f*1.4426950408889634f;
__device__ __forceinline__ void glds16(const void*gsrc,unsigned lds_dst){unsigned keep;
  asm volatile("s_mov_b32 %0, m0\n\ts_mov_b32 m0, %2\n\ts_nop 0\n\tglobal_load_lds_dwordx4 %1, off\n\ts_mov_b32 m0, %0":"=&s"(keep):"v"(gsrc),"s"(lds_dst):"memory");}
__device__ __forceinline__ float max3f(float a,float b,float c){float r;asm("v_max3_f32 %0, %1, %2, %3":"=v"(r):"v"(a),"v"(b),"v"(c));return r;}
__device__ __forceinline__ float max2f(float a,float b){float r;asm("v_max_f32_e32 %0, %1, %2":"=v"(r):"v"(a),"v"(b));return r;}
__device__ __forceinline__ float fadd_s(float a,float b){float r;asm("v_add_f32_e32 %0, %1, %2":"=v"(r):"v"(a),"v"(b));return r;}
__device__ __forceinline__ float fsub_s(float a,float b){float r;asm("v_sub_f32_e32 %0, %1, %2":"=v"(r):"v"(a),"v"(b));return r;}
typedef float f32x2_t __attribute__((ext_vector_type(2))); typedef __bf16 bf16x2_t __attribute__((ext_vector_type(2)));
__device__ __forceinline__ unsigned cvtpk_s(float lo,float hi){f32x2_t v={lo,hi};bf16x2_t b=__builtin_convertvector(v,bf16x2_t);return __builtin_bit_cast(unsigned,b);}
#define WAIT_BAR(N) asm volatile("s_waitcnt vmcnt(" #N ") lgkmcnt(0)\n\ts_barrier":::"memory")

__device__ __forceinline__ void qkt(f32x16&p0,f32x16&p1,const char*Kslot,const bf16x8*qr,const f32x16&negm,int r32,int hi){
  const char*kb=Kslot+hi*1024+r32*16;
  #pragma unroll
  for(int d0=0;d0<4;++d0){
    const bf16x8 b0=*reinterpret_cast<const bf16x8*>(kb+d0*2048);
    const bf16x8 b1=*reinterpret_cast<const bf16x8*>(kb+d0*2048+512);
    if(d0==0){p0=__builtin_amdgcn_mfma_f32_32x32x16_bf16(b0,qr[0],negm,0,0,0);p1=__builtin_amdgcn_mfma_f32_32x32x16_bf16(b1,qr[0],negm,0,0,0);}
    else{p0=__builtin_amdgcn_mfma_f32_32x32x16_bf16(b0,qr[d0],p0,0,0,0);p1=__builtin_amdgcn_mfma_f32_32x32x16_bf16(b1,qr[d0],p1,0,0,0);}}
}
typedef __attribute__((address_space(3))) const char* lds_cptr;
typedef short v4i16_t __attribute__((ext_vector_type(4)));
__device__ __forceinline__ void kload8(bf16x8*kf,lds_cptr kp){
  kf[0]=*(const __attribute__((address_space(3))) bf16x8*)(kp);      kf[1]=*(const __attribute__((address_space(3))) bf16x8*)(kp+512);
  kf[2]=*(const __attribute__((address_space(3))) bf16x8*)(kp+2048); kf[3]=*(const __attribute__((address_space(3))) bf16x8*)(kp+2560);
  kf[4]=*(const __attribute__((address_space(3))) bf16x8*)(kp+4096); kf[5]=*(const __attribute__((address_space(3))) bf16x8*)(kp+4608);
  kf[6]=*(const __attribute__((address_space(3))) bf16x8*)(kp+6144); kf[7]=*(const __attribute__((address_space(3))) bf16x8*)(kp+6656);
}
__device__ __forceinline__ void kload2(bf16x8*kf,lds_cptr kp,int j){ kf[2*j]=*(const __attribute__((address_space(3))) bf16x8*)(kp+j*2048); kf[2*j+1]=*(const __attribute__((address_space(3))) bf16x8*)(kp+j*2048+512); }
__device__ __forceinline__ s16x4 vtr(lds_cptr p){ return __builtin_bit_cast(s16x4,__builtin_amdgcn_ds_read_tr16_b64_v4i16((__attribute__((address_space(3))) v4i16_t*)p)); }
__device__ __forceinline__ float rowmax(const f32x16&p0,const f32x16&p1){
  float a=max3f(p0[0],p0[1],p1[0]),b=max3f(p0[2],p0[3],p1[1]);a=max3f(a,p1[2],p1[3]);
  #pragma unroll
  for(int r=4;r<16;r+=4){a=max3f(a,p0[r],p0[r+1]);b=max3f(b,p0[r+2],p0[r+3]);a=max3f(a,p1[r],p1[r+1]);b=max3f(b,p1[r+2],p1[r+3]);}
  const float m=max2f(a,b);
  auto rr=__builtin_amdgcn_permlane32_swap(__float_as_uint(m),__float_as_uint(m),false,false);
  return max2f(__uint_as_float(rr[0]),__uint_as_float(rr[1]));
}
__device__ __forceinline__ void pv(f32x16*o,int vb,bf16x8 pa0,bf16x8 pa1,bf16x8 pa2,bf16x8 pa3){
  #pragma unroll
  for(int d0=0;d0<2;++d0){s16x4 lo[4],hi[4];
    #pragma unroll
    for(int ks=0;ks<4;++ks){
      asm volatile("ds_read_b64_tr_b16 %0,%1 offset:%c2":"=&v"(lo[ks]):"v"(vb),"i"(d0*4096+ks*1024):"memory");
      asm volatile("ds_read_b64_tr_b16 %0,%1 offset:%c2":"=&v"(hi[ks]):"v"(vb),"i"(d0*4096+ks*1024+512):"memory");}
    asm volatile("s_waitcnt lgkmcnt(0)":::"memory");SBAR();
    #define PK(k) (bf16x8){lo[k][0],lo[k][1],lo[k][2],lo[k][3],hi[k][0],hi[k][1],hi[k][2],hi[k][3]}
    o[d0]=__builtin_amdgcn_mfma_f32_32x32x16_bf16(pa0,PK(0),o[d0],0,0,0);
    o[d0]=__builtin_amdgcn_mfma_f32_32x32x16_bf16(pa1,PK(1),o[d0],0,0,0);
    o[d0]=__builtin_amdgcn_mfma_f32_32x32x16_bf16(pa2,PK(2),o[d0],0,0,0);
    o[d0]=__builtin_amdgcn_mfma_f32_32x32x16_bf16(pa3,PK(3),o[d0],0,0,0);
    #undef PK
  }
}

#ifndef ATTN_STORE16
#define ATTN_STORE16(p,v) (*(u32x4*)(p)=(v))
#endif
template<int THRL> __device__ __forceinline__ void attn_unit(int b,int h,int qb,const bf16*Q,const bf16*__restrict__ K,const bf16*__restrict__ V,bf16*O,char*shm){
  const int tid=threadIdx.x,lane=tid&63,r32=lane&31,hi=lane>>5; const int wid=__builtin_amdgcn_readfirstlane(tid>>6);
  const long rowbase=(long)b*SEQ, kvbase=(long)b*SKV; const int q0=qb*QB;
  const bf16*Qw=Q+(rowbase+q0+wid*QBLK)*QP+h*D;
  const bf16*Kh=K+kvbase*KP+(h>>2)*D,*Vh=V+kvbase*KP+(h>>2)*D;
  const unsigned lds0=(unsigned)(uintptr_t)shm;
  float*wsf=(float*)(shm+LDS_WS)+wid*64;
  const bf16*ksrc=Kh+(long)lane*KP+wid*8;
  const bf16*vsrc=Vh+(long)(16*(wid&3)+(lane>>2))*KP+(wid>>2)*32+(lane&3)*8;
  const unsigned kdst=lds0+LDS_K+wid*1024, vdst=lds0+LDS_V+wid*1024;
  #define DMA_K(t,slot) glds16(ksrc+(long)(t)*KVBLK*KP,(unsigned)__builtin_amdgcn_readfirstlane(kdst+(slot)))
  #define DMA_V(t,slot) glds16(vsrc+(long)(t)*KVBLK*KP,(unsigned)__builtin_amdgcn_readfirstlane(vdst+(slot)))
  const int vb0=(int)(lds0+LDS_V)+((lane>>4)&1)*32+(lane&3)*8+(4*hi+((lane&15)>>2))*64;
  const char*Kbase=shm+LDS_K; bf16x8 kf[8];
  const lds_cptr shm3=(lds_cptr)shm; const lds_cptr kp0=shm3+LDS_K+hi*1024+r32*16; const lds_cptr vp0=shm3+LDS_V+((lane>>4)&1)*32+(lane&3)*8+(4*hi+((lane&15)>>2))*64;
  const int NT=SKV/KVBLK;
  DMA_K(0,0);DMA_V(0,0);DMA_K(1,SLOTB);
  bf16x8 qr[4];
  #pragma unroll
  for(int d0=0;d0<4;++d0)qr[d0]=*reinterpret_cast<const bf16x8*>(&Qw[(long)r32*QP+d0*16+hi*8]);
  float mhat=0.f,l_reg=0.f;f32x16 o[2];o[0]=f32x16{};o[1]=f32x16{};f32x16 negm=f32x16{};asm volatile("":"+v"(negm));
  const int qrel=wid*QBLK+r32;
  #define CMASK(P0,P1,t) do{}while(0)
  bool resc=false;
  #define START(P0,P1) do{ const float rm=rowmax(P0,P1); resc=false; \
    { const float dl=rm; mhat=fadd_s(mhat,dl); \
      _Pragma("unroll") for(int r=0;r<16;++r){P0[r]=fsub_s(P0[r],dl);P1[r]=fsub_s(P1[r],dl);} \
      _Pragma("unroll") for(int r=0;r<16;++r)negm[r]=-mhat; asm volatile("":"+v"(negm)); } \
    _Pragma("unroll") for(int r=0;r<16;++r)P0[r]=__builtin_amdgcn_exp2f(P0[r]); }while(0)
  #define RESC() do{ if(resc){ asm volatile("s_waitcnt lgkmcnt(0)":::"memory"); \
      _Pragma("unroll") for(int d_=0;d_<2;++d_) _Pragma("unroll") for(int r=0;r<16;++r)o[d_][r]*=wsf[crow(r,hi)]; } }while(0)
  f32x16 pA0,pA1,pB0,pB1;
  int sl_prev=0,sl_cur=0,sl_next=SLOTB;
  #define ROT() do{sl_prev=sl_cur;sl_cur=sl_next;sl_next=(sl_next==(NSLOT-1)*SLOTB)?0:sl_next+SLOTB;}while(0)
  DMA_K(2,2*SLOTB);
  WAIT_BAR(3);
  qkt(pA0,pA1,Kbase,qr,negm,r32,hi);asm volatile("s_nop 15\n\ts_nop 7":"+v"(pA0),"+v"(pA1));CMASK(pA0,pA1,0);
  START(pA0,pA1);
  _Pragma("unroll") for(int r=0;r<16;++r)pA1[r]=__builtin_amdgcn_exp2f(pA1[r]);
  WAIT_BAR(0);
  DMA_K(3,0);DMA_V(1,SLOTB);
  ROT();
  kload8(kf,kp0+sl_cur);
  WAIT_BAR(2);
  s16x4 vlo[8],vhi[8]; u32x4 pw0,pw1,pw2,pw3;
  #define PKW(P,B) cvtpk_s(P[B],P[B+1])
  #define PAF(k) __builtin_bit_cast(bf16x8,pw##k)
  #define VFR(i) (bf16x8){vlo[i][0],vlo[i][1],vlo[i][2],vlo[i][3],vhi[i][0],vhi[i][1],vhi[i][2],vhi[i][3]}
  #define PIN(x) asm volatile("":"+v"(x))
  #define MX3(a,b,c) __builtin_fmaxf(__builtin_fmaxf((a),(b)),(c))
  #define GAPA(MF,A0,A1,A2,A3,W0,W1,PW) do{ MF; sacc+=A0; sacc+=A1; sacc+=A2; sacc+=A3; PIN(sacc); W0; W1; PIN(PW); SBAR(); }while(0)
  #define EX(v) __builtin_amdgcn_exp2f(v)
  #define GAPB(MF,X,B) do{ MF; X[B]=EX(X[B]); X[B+1]=EX(X[B+1]); X[B+2]=EX(X[B+2]); X[B+3]=EX(X[B+3]); PIN(X); SBAR(); }while(0)
  #define VRD(i) do{ vlo[i]=vtr(vp_+(((i)>>2)*4096+((i)&3)*1024)); vhi[i]=vtr(vp_+(((i)>>2)*4096+((i)&3)*1024+512)); }while(0)
  #define KRD(G,j) do{ if(G){ kload2(kf,kp0+sl_next,j); SBAR(); } }while(0)
  #define STEP(C0,C1,P0,P1,t,GK,GV,GL) do{ SBAR(); \
    const lds_cptr vp_=vp0+sl_prev; \
    VRD(0); SBAR(); float sacc=(P0[0]+P0[1]); \
    GAPA(C0=__builtin_amdgcn_mfma_f32_32x32x16_bf16(kf[0],qr[0],negm,0,0,0), P0[2],P0[3],P0[4],P0[5],     pw0[0]=PKW(P0,0), pw0[1]=PKW(P0,2), pw0); \
    VRD(4); SBAR(); GAPA(C1=__builtin_amdgcn_mfma_f32_32x32x16_bf16(kf[1],qr[0],negm,0,0,0), P0[6],P0[7],P0[8],P0[9],     pw0[2]=PKW(P0,4), pw0[3]=PKW(P0,6), pw0); \
    VRD(1); SBAR(); GAPA(C0=__builtin_amdgcn_mfma_f32_32x32x16_bf16(kf[2],qr[1],C0,0,0,0),   P0[10],P0[11],P0[12],P0[13], pw1[0]=PKW(P0,8), pw1[1]=PKW(P0,10), pw1); \
    VRD(5); SBAR(); GAPA(C1=__builtin_amdgcn_mfma_f32_32x32x16_bf16(kf[3],qr[1],C1,0,0,0),   P0[14],P0[15],P1[0],P1[1],   pw1[2]=PKW(P0,12),pw1[3]=PKW(P0,14), pw1); \
    VRD(2); SBAR(); GAPA(C0=__builtin_amdgcn_mfma_f32_32x32x16_bf16(kf[4],qr[2],C0,0,0,0),   P1[2],P1[3],P1[4],P1[5],     pw2[0]=PKW(P1,0), pw2[1]=PKW(P1,2), pw2); \
    VRD(6); SBAR(); GAPA(C1=__builtin_amdgcn_mfma_f32_32x32x16_bf16(kf[5],qr[2],C1,0,0,0),   P1[6],P1[7],P1[8],P1[9],     pw2[2]=PKW(P1,4), pw2[3]=PKW(P1,6), pw2); \
    VRD(3); SBAR(); GAPA(C0=__builtin_amdgcn_mfma_f32_32x32x16_bf16(kf[6],qr[3],C0,0,0,0),   P1[10],P1[11],P1[12],P1[13], pw3[0]=PKW(P1,8), pw3[1]=PKW(P1,10), pw3); \
    VRD(7); SBAR(); GAPA(C1=__builtin_amdgcn_mfma_f32_32x32x16_bf16(kf[7],qr[3],C1,0,0,0),   P1[14],P1[15],0.f,0.f,       pw3[2]=PKW(P1,12),pw3[3]=PKW(P1,14), pw3); \
    l_reg+=sacc; \
    if(GK){DMA_K((t)+3,sl_cur);} if(GV){DMA_V((t)+1,sl_next);} \
    CMASK(C0,C1,t); \
    { float a=MX3(C0[0],C0[1],C1[0]),b=MX3(C0[2],C0[3],C1[1]); a=MX3(a,C1[2],C1[3]); \
      _Pragma("unroll") for(int r=4;r<16;r+=4){a=MX3(a,C0[r],C0[r+1]);b=MX3(b,C0[r+2],C0[r+3]);a=MX3(a,C1[r],C1[r+1]);b=MX3(b,C1[r+2],C1[r+3]);} \
      float rm=__builtin_fmaxf(a,b); { auto rr=__builtin_amdgcn_permlane32_swap(__float_as_uint(rm),__float_as_uint(rm),false,false); rm=__builtin_fmaxf(__uint_as_float(rr[0]),__uint_as_float(rr[1])); } \
      resc=false; \
      if(__builtin_expect(__any(rm>(float)THRL),0)){ const float dl=__builtin_fmaxf(rm,0.f); mhat+=dl; \
        _Pragma("unroll") for(int r=0;r<16;++r){C0[r]-=dl;C1[r]-=dl;} \
        _Pragma("unroll") for(int r=0;r<16;++r)negm[r]=-mhat; asm volatile("":"+v"(negm)); \
        const float f=__builtin_amdgcn_exp2f(-dl); l_reg*=f; if(hi==0)wsf[r32]=f; resc=true; } } \
    SBAR(); \
    GAPB(o[0]=__builtin_amdgcn_mfma_f32_32x32x16_bf16(PAF(0),VFR(0),o[0],0,0,0), C0,0); \
    GAPB(o[1]=__builtin_amdgcn_mfma_f32_32x32x16_bf16(PAF(0),VFR(4),o[1],0,0,0), C0,4); \
    KRD(GL,0); GAPB(o[0]=__builtin_amdgcn_mfma_f32_32x32x16_bf16(PAF(1),VFR(1),o[0],0,0,0), C0,8); \
    KRD(GL,1); GAPB(o[1]=__builtin_amdgcn_mfma_f32_32x32x16_bf16(PAF(1),VFR(5),o[1],0,0,0), C0,12); \
    KRD(GL,2); GAPB(o[0]=__builtin_amdgcn_mfma_f32_32x32x16_bf16(PAF(2),VFR(2),o[0],0,0,0), C1,0); \
    KRD(GL,3); GAPB(o[1]=__builtin_amdgcn_mfma_f32_32x32x16_bf16(PAF(2),VFR(6),o[1],0,0,0), C1,4); \
    GAPB(o[0]=__builtin_amdgcn_mfma_f32_32x32x16_bf16(PAF(3),VFR(3),o[0],0,0,0), C1,8); \
    GAPB(o[1]=__builtin_amdgcn_mfma_f32_32x32x16_bf16(PAF(3),VFR(7),o[1],0,0,0), C1,12); \
    }while(0)
  int t=1;
  #undef CMASK
  #define CMASK(P0,P1,t) do{}while(0)
  for(;t+5<NT;t+=2){
    STEP(pB0,pB1,pA0,pA1,t,true,true,true);     WAIT_BAR(2); RESC(); ROT();
    STEP(pA0,pA1,pB0,pB1,t+1,true,true,true);   WAIT_BAR(2); RESC(); ROT();
  }
  #undef CMASK
  #define CMASK(P0,P1,t) do{}while(0)
  #define ENDW(tt) do{ if((tt)+3<NT){WAIT_BAR(2);} else if((tt)+2<NT){WAIT_BAR(1);} else {WAIT_BAR(0);} }while(0)
  for(;t+1<NT;t+=2){
    STEP(pB0,pB1,pA0,pA1,t,(t+3<NT),(t+1<NT),(t+1<NT));       ENDW(t);   RESC(); ROT();
    STEP(pA0,pA1,pB0,pB1,t+1,(t+4<NT),(t+2<NT),(t+2<NT));     ENDW(t+1); RESC(); ROT();
  }
  STEP(pB0,pB1,pA0,pA1,NT-1,false,false,false); RESC();
  { float sacc=pB0[0]+pB0[1]; _Pragma("unroll") for(int r=2;r<16;++r)sacc+=pB0[r]; _Pragma("unroll") for(int r=0;r<16;++r)sacc+=pB1[r]; l_reg+=sacc;
    pw0=(u32x4){PKW(pB0,0),PKW(pB0,2),PKW(pB0,4),PKW(pB0,6)};pw1=(u32x4){PKW(pB0,8),PKW(pB0,10),PKW(pB0,12),PKW(pB0,14)};pw2=(u32x4){PKW(pB1,0),PKW(pB1,2),PKW(pB1,4),PKW(pB1,6)};pw3=(u32x4){PKW(pB1,8),PKW(pB1,10),PKW(pB1,12),PKW(pB1,14)};
    SBAR(); pv(o,vb0+sl_cur,PAF(0),PAF(1),PAF(2),PAF(3)); }
  #undef PKW
  #undef PAF
  #undef VFR
  #undef PIN
  #undef MX3
  #undef GAPA
  #undef GAPB
  #undef EX
  #undef VRD
  #undef KRD
  #undef STEP
  #undef ENDW
  {auto rr=__builtin_amdgcn_permlane32_swap(__float_as_uint(l_reg),__float_as_uint(l_reg),false,false);l_reg=__uint_as_float(rr[0])+__uint_as_float(rr[1]);}
  if(hi==0)wsf[32+r32]=l_reg;asm volatile("s_waitcnt lgkmcnt(0)":::"memory");
  float rli[16];
  #pragma unroll
  for(int r=0;r<16;++r)rli[r]=__builtin_amdgcn_rcpf(wsf[32+crow(r,hi)]);
  bf16*Ow=O+(rowbase+q0+wid*QBLK)*OP+h*D;
  { bf16*stg=(bf16*)(shm+LDS_OST)+wid*2048;
    #pragma unroll
    for(int r=0;r<16;++r){const int orow=crow(r,hi);
      #pragma unroll
      for(int d0=0;d0<2;++d0)stg[orow*64+d0*32+r32]=__float2bfloat16(o[d0][r]*rli[r]);}
    asm volatile("s_waitcnt lgkmcnt(0)":::"memory");
    #pragma unroll
    for(int i=0;i<4;++i){const int row=i*8+(lane>>3),ch=lane&7; const u32x4 v=*(const u32x4*)(stg+row*64+ch*8); ATTN_STORE16(Ow+(long)row*OP+ch*8,v);} }
  asm volatile("s_waitcnt lgkmcnt(0)\n\ts_barrier":::"memory");
  #undef DMA_K
  #undef DMA_V
  #undef CMASK
  #undef START
  #undef RESC
  #undef ROT
}
constexpr int ATTN_LDS_BYTES=LDS_BYTES;
struct AttnTensors { const bf16* Q; const bf16* K; const bf16* V; bf16* O; };
struct AttnUnit { int b; int h; int qb; };
struct StaticOrder {
  int vcu, G;
  __device__ __forceinline__ StaticOrder(int grid,int v):vcu(v),G(grid){}
  __device__ __forceinline__ bool next(int i,AttnUnit&u)const{ const int L=(i>>3)*G+vcu; if(L>=256)return false; u.b=L>>3; u.qb=L&7; u.h=i&7; return true; }
};
template<class Sched,int THRL=8> __device__ __forceinline__ void attn_phase(char*lds,const AttnTensors&T,const Sched&S){
  AttnUnit u;
  for(int i=0;S.next(i,u);++i){ attn_unit<THRL>(u.b,u.h,u.qb,T.Q,T.K,T.V,T.O,lds); }
}
#undef SBAR
#undef WAIT_BAR
}
namespace ml {
constexpr int PQ = 272, PT = 144;
constexpr int O_Q = 0, O_K = O_Q + 64 * PQ, O_KTW = O_K + 64 * PQ, O_VT = O_KTW + 128 * PT, O_P = O_VT + 144 * PT, O_CB = O_P + 64 * PT, O_GT = O_CB + 144 * PQ, O_CW = O_GT + 2 * 1280, O_END = O_CW + 4096;
static_assert(O_END <= LDSCTL_OFF, "mlstm LDS map");
struct Raw { u32x4 q[3][2], k[3][2], v[2]; float li, lf; };
__device__ __forceinline__ float bflo(unsigned w) { return __uint_as_float(w << 16); }
__device__ __forceinline__ float bfhi(unsigned w) { return __uint_as_float(w & 0xffff0000u); }
__device__ __forceinline__ int chunk_pos(int c, int r, int dir) { return dir == 0 ? 64 * c + r : (c < 4 ? 255 - 64 * c - r : 2303 - 64 * (c - 4) - r); }
__device__ __forceinline__ void load_chunk(Raw& R, int c, int lane, int w, int b, int head, int dir, const bf16* MQ, const bf16* MK, const bf16* MV, const float* GATES) {
    const int pos = chunk_pos(c, lane, dir); const int lo = pos < CL ? 0 : CL, hi = pos < CL ? CL : SL;
    const size_t sr = (size_t)b * SL + pos; const size_t co = (size_t)head * MD + 16 * w;
    const u32x4 z = {0u, 0u, 0u, 0u};
#pragma unroll
    for (int j = 0; j < 3; ++j) { const int pp = pos + j - 1; const bool ok = pp >= lo && pp < hi; const size_t o = (sr + j - 1) * MW + co;
        R.q[j][0] = ok ? *(const u32x4*)(MQ + o) : z; R.q[j][1] = ok ? *(const u32x4*)(MQ + o + 8) : z;
        R.k[j][0] = ok ? *(const u32x4*)(MK + o) : z; R.k[j][1] = ok ? *(const u32x4*)(MK + o + 8) : z; }
    R.v[0] = *(const u32x4*)(MV + sr * MW + co); R.v[1] = *(const u32x4*)(MV + sr * MW + co + 8);
    R.li = GATES[sr * 16 + dir * 4 + head]; R.lf = GATES[sr * 16 + 8 + dir * 4 + head];
}
__device__ __forceinline__ void mlstm_phase(Frame& F, const Args& a) {
    int tid = threadIdx.x; asm volatile("" : "+v"(tid));
    const int lane = tid & 63, w = __builtin_amdgcn_readfirstlane(tid >> 6), l15 = lane & 15, l4 = lane >> 4;
    LAS unsigned char* L = F.lds;
    const bf16* MQ = (const bf16*)(F.dout + DO_MQ); const bf16* MK = (const bf16*)(F.dout + DO_MK); const bf16* MV = (const bf16*)(F.dout + DO_MV);
    const float* GATES = (const float*)(F.ws + WS_GATES); bf16* H = (bf16*)(F.ws + WS_H);
    const float* conv_w = a.in[13]; const float* conv_b = a.in[14];
    LAS float* CW = (LAS float*)(L + O_CW);
    for (int seq = F.vcu; seq < NB * MH * 2; seq += F.G) {
        const int b = seq >> 3, head = (seq >> 1) & 3, dir = seq & 1;
        __syncthreads();
        for (int i = tid; i < 1024; i += 512) { const int part = i >> 7, d = i & 127, kq = part >> 2, j = part & 3, ch = kq * 512 + head * MD + d; CW[i] = j < 3 ? conv_w[j * 1024 + ch] : conv_b[ch]; }
        for (int i = tid; i < 144 * PQ / 4; i += 512) ((LAS unsigned*)(L + O_CB))[i] = 0u;
        for (int i = tid; i < 16 * PT / 4; i += 512) ((LAS unsigned*)(L + O_VT + 128 * PT))[i] = (i < PT / 4) ? 0x3F803F80u : 0u;
        f32x4 accC[9];
#pragma unroll
        for (int i = 0; i < 9; ++i) accC[i] = (f32x4){0.f, 0.f, 0.f, 0.f};
        float m = 0.f;
        Raw R; load_chunk(R, 0, lane, w, b, head, dir, MQ, MK, MV, GATES);
        __syncthreads();
        for (int c = 0; c < SL / 64; ++c) {
            LAS float* GT = (LAS float*)(L + O_GT + (c & 1) * 1280);
            float bcs = R.lf;
#pragma unroll
            for (int o = 1; o < 64; o <<= 1) { const float t = __shfl_up(bcs, o); bcs += (lane >= o) ? t : 0.f; }
            const float u = R.li - bcs; float pm = u;
#pragma unroll
            for (int o = 1; o < 64; o <<= 1) { const float t = __shfl_up(pm, o); pm = (lane >= o) ? fmaxf(pm, t) : pm; }
            const float mq = fmaxf(bcs + m, bcs + pm);
            const float bL = __shfl(bcs, 63), umax = __shfl(pm, 63);
            const float m_new = fmaxf(bL + m, bL + umax), wsv = __expf(bL + u - m_new), w_old = __expf(bL + m - m_new);
            if (w == 0) { GT[lane] = bcs - mq; GT[64 + lane] = u; GT[128 + lane] = __expf(bcs + m - mq); GT[192 + lane] = __expf(-mq); }
            {
                float qv[16], kv[16];
#pragma unroll
                for (int g = 0; g < 4; ++g) {
                    f32x4 wq[4], wk[4];
#pragma unroll
                    for (int j = 0; j < 4; ++j) { wq[j] = *(const LAS f32x4*)(CW + j * 128 + 16 * w + 4 * g); wk[j] = *(const LAS f32x4*)(CW + 512 + j * 128 + 16 * w + 4 * g); }
#pragma unroll
                    for (int e = 0; e < 4; ++e) { const int i = 4 * g + e, hv = i >> 3, wd = (i & 7) >> 1;
                        float xq[3], xk[3];
#pragma unroll
                        for (int j = 0; j < 3; ++j) { const unsigned uq = R.q[j][hv][wd], uk = R.k[j][hv][wd]; xq[j] = (i & 1) ? bfhi(uq) : bflo(uq); xk[j] = (i & 1) ? bfhi(uk) : bflo(uk); }
                        qv[i] = siluf_(wq[0][e] * xq[0] + wq[1][e] * xq[1] + wq[2][e] * xq[2] + wq[3][e]) * 0.08838834764831845f;
                        kv[i] = siluf_(wk[0][e] * xk[0] + wk[1][e] * xk[1] + wk[2][e] * xk[2] + wk[3][e]); }
                }
                u32x4 p0, p1;
                p0.x = cvt_pk_bf16(qv[0], qv[1]); p0.y = cvt_pk_bf16(qv[2], qv[3]); p0.z = cvt_pk_bf16(qv[4], qv[5]); p0.w = cvt_pk_bf16(qv[6], qv[7]);
                p1.x = cvt_pk_bf16(qv[8], qv[9]); p1.y = cvt_pk_bf16(qv[10], qv[11]); p1.z = cvt_pk_bf16(qv[12], qv[13]); p1.w = cvt_pk_bf16(qv[14], qv[15]);
                *(LAS u32x4*)(L + O_Q + lane * PQ + w * 32) = p0; *(LAS u32x4*)(L + O_Q + lane * PQ + w * 32 + 16) = p1;
                p0.x = cvt_pk_bf16(kv[0], kv[1]); p0.y = cvt_pk_bf16(kv[2], kv[3]); p0.z = cvt_pk_bf16(kv[4], kv[5]); p0.w = cvt_pk_bf16(kv[6], kv[7]);
                p1.x = cvt_pk_bf16(kv[8], kv[9]); p1.y = cvt_pk_bf16(kv[10], kv[11]); p1.z = cvt_pk_bf16(kv[12], kv[13]); p1.w = cvt_pk_bf16(kv[14], kv[15]);
                *(LAS u32x4*)(L + O_K + lane * PQ + w * 32) = p0; *(LAS u32x4*)(L + O_K + lane * PQ + w * 32 + 16) = p1;
#pragma unroll
                for (int i = 0; i < 16; ++i) {
                    *(LAS bf16*)(L + O_KTW + (16 * w + i) * PT + lane * 2) = f2bf(kv[i] * wsv);
                    const unsigned uv = R.v[i >> 3][(i & 7) >> 1]; *(LAS bf16*)(L + O_VT + (16 * w + i) * PT + lane * 2) = (bf16)((i & 1) ? (uv >> 16) : (uv & 0xffffu)); }
            }
            if (c + 1 < SL / 64) load_chunk(R, c + 1, lane, w, b, head, dir, MQ, MK, MV, GATES);
            __syncthreads();
            const bool outp = c >= 4;
            const int nb = w & 3, mb0 = (w >> 2) * 4, nmb = 4 + (w >> 2);
            f32x4 nacc[5];
#pragma unroll
            for (int i = 0; i < 5; ++i) nacc[i] = (f32x4){0.f, 0.f, 0.f, 0.f};
            if (outp) {
                bf16x8 qf[4];
#pragma unroll
                for (int ks = 0; ks < 4; ++ks) qf[ks] = *(const LAS bf16x8*)(L + O_Q + (16 * nb + l15) * PQ + (32 * ks + 8 * l4) * 2);
                const float bmj = GT[16 * nb + l15];
#pragma unroll
                for (int mi = 0; mi < 2; ++mi) { const int mb = 2 * (w >> 2) + mi; f32x4 sacc = {0.f, 0.f, 0.f, 0.f};
#pragma unroll
                    for (int ks = 0; ks < 4; ++ks) { const bf16x8 kf = *(const LAS bf16x8*)(L + O_K + (16 * mb + l15) * PQ + (32 * ks + 8 * l4) * 2); sacc = __builtin_amdgcn_mfma_f32_16x16x32_bf16(kf, qf[ks], sacc, 0, 0, 0); }
                    const f32x4 uu = *(const LAS f32x4*)(GT + 64 + 16 * mb + 4 * l4); float pv[4];
#pragma unroll
                    for (int r = 0; r < 4; ++r) { const int s = 16 * mb + 4 * l4 + r, j = 16 * nb + l15; pv[r] = (s <= j) ? sacc[r] * __expf(bmj + uu[r]) : 0.f; }
                    u32x2 pk; pk.x = cvt_pk_bf16_s(pv[0], pv[1]); pk.y = cvt_pk_bf16_s(pv[2], pv[3]);
                    *(LAS u32x2*)(L + O_P + (16 * nb + l15) * PT + (16 * mb + 4 * l4) * 2) = pk; }
                const float wij = GT[128 + 16 * nb + l15];
#pragma unroll
                for (int i = 0; i < 5; ++i) if (i < nmb) { const int mb = mb0 + i;
#pragma unroll
                    for (int ks = 0; ks < 4; ++ks) { const bf16x8 cf = *(const LAS bf16x8*)(L + O_CB + (16 * mb + l15) * PQ + (32 * ks + 8 * l4) * 2); nacc[i] = __builtin_amdgcn_mfma_f32_16x16x32_bf16(cf, qf[ks], nacc[i], 0, 0, 0); }
                    nacc[i] = nacc[i] * wij; }
                __syncthreads();
                bf16x8 pf[2];
#pragma unroll
                for (int ks = 0; ks < 2; ++ks) pf[ks] = *(const LAS bf16x8*)(L + O_P + (16 * nb + l15) * PT + (32 * ks + 8 * l4) * 2);
#pragma unroll
                for (int i = 0; i < 5; ++i) if (i < nmb) { const int mb = mb0 + i;
#pragma unroll
                    for (int ks = 0; ks < 2; ++ks) { const bf16x8 vf = *(const LAS bf16x8*)(L + O_VT + (16 * mb + l15) * PT + (32 * ks + 8 * l4) * 2); nacc[i] = __builtin_amdgcn_mfma_f32_16x16x32_bf16(vf, pf[ks], nacc[i], 0, 0, 0); } }
                if (w >= 4 && l4 == 0) GT[256 + 16 * nb + l15] = nacc[4][0];
            }
            {
                bf16x8 kt[2];
#pragma unroll
                for (int ks = 0; ks < 2; ++ks) kt[ks] = *(const LAS bf16x8*)(L + O_KTW + (16 * w + l15) * PT + (32 * ks + 8 * l4) * 2);
#pragma unroll
                for (int n2 = 0; n2 < 9; ++n2) { accC[n2] = accC[n2] * w_old;
#pragma unroll
                    for (int ks = 0; ks < 2; ++ks) { const bf16x8 vf = *(const LAS bf16x8*)(L + O_VT + (16 * n2 + l15) * PT + (32 * ks + 8 * l4) * 2); accC[n2] = __builtin_amdgcn_mfma_f32_16x16x32_bf16(kt[ks], vf, accC[n2], 0, 0, 0); }
                    u32x2 pk; pk.x = cvt_pk_bf16_s(accC[n2][0], accC[n2][1]); pk.y = cvt_pk_bf16_s(accC[n2][2], accC[n2][3]);
                    *(LAS u32x2*)(L + O_CB + (16 * n2 + l15) * PQ + (16 * w + 4 * l4) * 2) = pk; }
            }
            __syncthreads();
            if (outp) {
                const int j = 16 * nb + l15; const float den = GT[256 + j], emq = GT[192 + j]; const float inv = 1.f / fmaxf(fabsf(den), emq);
                const int t = chunk_pos(c, j, dir) - CL;
                bf16* hp = H + ((size_t)dir * T + (size_t)b * S + t) * MW + head * MD + 4 * l4;
#pragma unroll
                for (int i = 0; i < 4; ++i) { const int mb = mb0 + i; const f32x4 hv = nacc[i] * inv;
                    u32x2 pk; pk.x = cvt_pk_bf16_s(hv[0], hv[1]); pk.y = cvt_pk_bf16_s(hv[2], hv[3]); *(u32x2*)(hp + 16 * mb) = pk; }
            }
            m = m_new;
        }
    }
    __syncthreads();
}
__device__ __forceinline__ void mlstm_combine(Frame& F, const Args& a) {
    int tid = threadIdx.x; asm volatile("" : "+v"(tid));
    const int lane = tid & 63, wv = __builtin_amdgcn_readfirstlane(tid >> 6);
    const bf16* H = (const bf16*)(F.ws + WS_H); const bf16* MO = (const bf16*)(F.ws + WS_MO); bf16* AM = (bf16*)(F.ws + WS_RA); const float* g = a.in[17];
    const f32x4 g0 = *(const f32x4*)(g + 8 * lane), g1 = *(const f32x4*)(g + 8 * lane + 4);
    const int gw = F.vcu * NWAVES + wv, NGW = F.G * NWAVES;
    for (int row = gw; row < T; row += NGW) {
        const u32x4 hf = *(const u32x4*)(H + (size_t)row * MW + 8 * lane), hb = *(const u32x4*)(H + ((size_t)T + row) * MW + 8 * lane), mo = *(const u32x4*)(MO + (size_t)row * MW + 8 * lane);
        float v[8], s[8]; float ss = 0.f;
#pragma unroll
        for (int q = 0; q < 4; ++q) { v[2 * q] = bflo(hf[q]) + bflo(hb[q]); v[2 * q + 1] = bfhi(hf[q]) + bfhi(hb[q]); s[2 * q] = sigmoidf_(bflo(mo[q])); s[2 * q + 1] = sigmoidf_(bfhi(mo[q])); ss += v[2 * q] * v[2 * q] + v[2 * q + 1] * v[2 * q + 1]; }
        ss += __shfl_xor(ss, 1); ss += __shfl_xor(ss, 2); ss += __shfl_xor(ss, 4); ss += __shfl_xor(ss, 8);
        const float rs = rsqrtf(ss * (1.f / MD) + EPS);
        u32x4 o; o.x = cvt_pk_bf16(v[0] * rs * g0[0] * s[0], v[1] * rs * g0[1] * s[1]); o.y = cvt_pk_bf16(v[2] * rs * g0[2] * s[2], v[3] * rs * g0[3] * s[3]);
        o.z = cvt_pk_bf16(v[4] * rs * g1[0] * s[4], v[5] * rs * g1[1] * s[5]); o.w = cvt_pk_bf16(v[6] * rs * g1[2] * s[6], v[7] * rs * g1[3] * s[7]);
        *(u32x4*)(AM + (size_t)row * D + AW + 8 * lane) = o;
    }
}
}
__device__ __forceinline__ void tile_of(int L, int nN, int& pm, int& pn) {
    const int nwg = 256 * nN, q = nwg / 8; int wgid = (L % 8) * q + L / 8;
    const int nig = 8 * nN, gid = wgid / nig, fm = gid * 8; pm = fm + ((wgid % nig) % 8); pn = (wgid % nig) / 8;
}
struct ProgMerge {
    const char* AM; const char* WAT; const char* WMT; bf16* Y; const bf16* GA; int G, c;
    __device__ __forceinline__ bool next(int i, eng::UnitD& u, LAS unsigned char*) const {
        const long L = (long)(i >> 1) * G + c; if (L >= 1024) return false;
        int pm, pn; tile_of((int)L, 4, pm, pn); const int part = i & 1;
        u.A = AM + (size_t)pm * (256 * 2048) + part * 1024; u.B = (part ? WMT : WAT) + (size_t)pn * (256 * 1024); u.lda = 2048; u.ldb = 1024; u.nt = 8; u.type = part; u.r0 = pm; u.r1 = pn; u.r2 = 0; u.r3 = 0; return true;
    }
    __device__ __forceinline__ void first(const eng::UnitD&, LAS unsigned char*) const {}
    __device__ __forceinline__ void prefetch(const eng::UnitD&, LAS unsigned char*) const {}
    __device__ __forceinline__ void offsets(const eng::UnitD& u, const int (&Rr)[2], const int (&Cc)[2], unsigned (&oA)[2][2], LAS unsigned char*) const {
#pragma unroll
        for (int h = 0; h < 2; ++h)
#pragma unroll
            for (int i = 0; i < 2; ++i) oA[h][i] = (unsigned)(128 * h + Rr[i]) * u.lda + (unsigned)Cc[i];
    }
    __device__ __forceinline__ void epilogue(eng::Acc& acc, const eng::UnitD& u, int wr, int wc, int fr, int fq, LAS unsigned char*) const {
        const size_t off0 = ((size_t)u.r0 * 256 + wr * 64 + fr) * D + u.r1 * 256 + wc * 32 + 8 * fq;
        if (u.type == 0) { eng::store_tile_bf16<0>(acc, Y + off0, D); return; }
        const bf16* GMp = GA + (size_t)T * D;
#pragma unroll
        for (int ai = 0; ai < 2; ++ai)
#pragma unroll
            for (int m = 0; m < 4; ++m) {
#pragma unroll
                for (int bj = 0; bj < 2; ++bj) { const size_t o = off0 + (size_t)(ai * 128 + m * 16) * D + bj * 128;
                    const u32x4 p1 = *(const u32x4*)(Y + o), ga = *(const u32x4*)(GA + o), gm = *(const u32x4*)(GMp + o);
                    u32x4 w;
#pragma unroll
                    for (int q = 0; q < 4; ++q) { const int n = q >> 1, e = (q & 1) * 2;
                        const float y0 = __uint_as_float(ga[q] << 16) * __uint_as_float(p1[q] << 16) + __uint_as_float(gm[q] << 16) * acc[ai][bj][m][n][e];
                        const float y1 = __uint_as_float(ga[q] & 0xffff0000u) * __uint_as_float(p1[q] & 0xffff0000u) + __uint_as_float(gm[q] & 0xffff0000u) * acc[ai][bj][m][n][e + 1];
                        w[q] = cvt_pk_bf16(y0, y1); }
                    *(u32x4*)(Y + o) = w; }
                asm volatile("" ::: "memory"); }
        __builtin_amdgcn_s_waitcnt(0x0F70);
    }
};
struct ProgOut {
    const char* Yb; const char* WOT; bf16* YO; float* RS1; int G, c;
    __device__ __forceinline__ bool next(int i, eng::UnitD& u, LAS unsigned char*) const {
        const long L = (long)i * G + c; if (L >= 1024) return false;
        int pm, pn; tile_of((int)L, 4, pm, pn);
        u.A = Yb + (size_t)pm * (256 * 2048); u.B = WOT + (size_t)pn * (256 * 2048); u.lda = 2048; u.ldb = 2048; u.nt = 16; u.type = 0; u.r0 = pm; u.r1 = pn; u.r2 = 0; u.r3 = 0; return true;
    }
    __device__ __forceinline__ void first(const eng::UnitD&, LAS unsigned char*) const {}
    __device__ __forceinline__ void prefetch(const eng::UnitD&, LAS unsigned char*) const {}
    __device__ __forceinline__ void offsets(const eng::UnitD& u, const int (&Rr)[2], const int (&Cc)[2], unsigned (&oA)[2][2], LAS unsigned char*) const {
#pragma unroll
        for (int h = 0; h < 2; ++h)
#pragma unroll
            for (int i = 0; i < 2; ++i) oA[h][i] = (unsigned)(128 * h + Rr[i]) * u.lda + (unsigned)Cc[i];
    }
    __device__ __forceinline__ void epilogue(eng::Acc& acc, const eng::UnitD& u, int wr, int wc, int fr, int fq, LAS unsigned char*) const {
        const size_t row0 = (size_t)u.r0 * 256 + wr * 64 + fr;
        eng::store_tile_bf16<0>(acc, YO + row0 * D + u.r1 * 256 + wc * 32 + 8 * fq, D);
#pragma unroll
        for (int ai = 0; ai < 2; ++ai)
#pragma unroll
            for (int m = 0; m < 4; ++m) { float ss = 0.f;
#pragma unroll
                for (int bj = 0; bj < 2; ++bj)
#pragma unroll
                    for (int n = 0; n < 2; ++n) { const f32x4 v = acc[ai][bj][m][n]; ss += (v[0] * v[0] + v[1] * v[1]) + (v[2] * v[2] + v[3] * v[3]); }
                ss += __shfl_xor(ss, 16); ss += __shfl_xor(ss, 32);
                if (fq == 0) RS1[(row0 + ai * 128 + m * 16) * 16 + u.r1 * 4 + wc] = ss; }
    }
};
template <bool WRITE_X1>
__device__ __forceinline__ void p6_rowpass(Frame& F, const Args& a) {
    int tid_ = threadIdx.x; asm volatile("" : "+v"(tid_)); const int lane_ = tid_ & 63, wave_ = __builtin_amdgcn_readfirstlane(tid_ >> 6);
    const float* x = a.in[0]; const f32x4* gpost = (const f32x4*)a.in[7]; const f32x4* gpre = (const f32x4*)a.in[8];
    const float* mod = (const float*)(F.ws + WS_MOD); const bf16* YO = (const bf16*)(F.ws + WS_RA); const float* RS1 = (const float*)(F.ws + WS_RS1); bf16* FIN = (bf16*)(F.ws + WS_GA);
    const int gw = F.vcu * NWAVES + wave_, NGW = F.G * NWAVES, lane = lane_;
    for (int row = gw; row < T; row += NGW) {
        const f32x4* mr = (const f32x4*)(mod + (size_t)(row / S) * (NMOD * D));
        const f32x4* xr = (const f32x4*)(x + (size_t)row * D); const u32x2* yr = (const u32x2*)(YO + (size_t)row * D);
        float s1 = (lane < 16) ? RS1[(size_t)row * 16 + lane] : 0.f;
        s1 += __shfl_xor(s1, 1); s1 += __shfl_xor(s1, 2); s1 += __shfl_xor(s1, 4); s1 += __shfl_xor(s1, 8);
        s1 = __shfl(s1, 0);
        const float rs1 = rsqrtf(s1 * (1.f / D) + EPS);
        f32x4 v[4]; float ss = 0.f;
#pragma unroll
        for (int j = 0; j < 4; ++j) { const int i4 = 64 * j + lane; const u32x2 yb = yr[i4]; const f32x4 xv = xr[i4], g1 = mr[512 + i4], gp = gpost[i4];
            f32x4 y; y[0] = __uint_as_float(yb.x << 16); y[1] = __uint_as_float(yb.x & 0xffff0000u); y[2] = __uint_as_float(yb.y << 16); y[3] = __uint_as_float(yb.y & 0xffff0000u);
            v[j] = xv + g1 * (y * rs1 * gp); ss += (v[j][0] * v[j][0] + v[j][1] * v[j][1]) + (v[j][2] * v[j][2] + v[j][3] * v[j][3]); }
        const float rs2 = rsqrtf(wave_sum(ss) * (1.f / D) + EPS);
        u32x2* o8 = (u32x2*)(FIN + (size_t)row * D);
#pragma unroll
        for (int j = 0; j < 4; ++j) { const int i4 = 64 * j + lane; const f32x4 sh = mr[768 + i4], sc = mr[1024 + i4], gg = gpre[i4];
            if (WRITE_X1) ((f32x4*)(a.out + (size_t)row * D))[i4] = v[j];
            const f32x4 o = v[j] * rs2 * gg * (sc + 1.f) + sh;
            u32x2 w; w.x = cvt_pk_bf16(o[0], o[1]); w.y = cvt_pk_bf16(o[2], o[3]); o8[i4] = w; }
    }
}
constexpr int NCH = 2, TCH = T / NCH;
constexpr size_t WS_SCORE = WS_GM;
constexpr size_t WS_WGU = WS_RW, WS_WD = WS_RW + 256 * MiB;
constexpr size_t WS_HIDS = WS_H, WS_HIDSH = WS_H + 64 * MiB;
constexpr size_t WS_EOHI = WS_GM;
constexpr int CW_CNT2 = 2048, CW_FILL2 = 2560;
constexpr int LIST_CAP = 327680;
constexpr int LDS_TOFF = RING_BYTES;
constexpr int LDS_IDX = RING_BYTES + 4096;
__device__ __forceinline__ bf16* eo_block(unsigned char* dout, unsigned char* ws, int k) { return (bf16*)((k < 4 ? dout : ws + WS_EOHI) + (size_t)(k & 3) * (64 * MiB)); }

__device__ __forceinline__ void p0_expert_weights(Frame& F, const Args& a) {
    int tid_ = threadIdx.x; asm volatile("" : "+v"(tid_)); const int lane_ = tid_ & 63, wave_ = __builtin_amdgcn_readfirstlane(tid_ >> 6);
    LAS float* scr = (LAS float*)(F.lds + wave_ * 16384);
    const int gw = F.vcu * NWAVES + wave_, NGW = F.G * NWAVES, lane = lane_;
    const float* w_eg = a.in[23]; const float* w_eu = a.in[24]; const float* w_ed = a.in[25];
    bf16* WGU = (bf16*)(F.ws + WS_WGU); bf16* WD = (bf16*)(F.ws + WS_WD);
    for (int it = gw; it < NE * 384; it += NGW) {
        const int e = it / 384, r = it % 384;
        if (r < 256) { const int job = r >> 6, q = r & 63, kb = q >> 2, nb = q & 3, n = job >> 1, up = job & 1;
            transpose_item((up ? w_eu : w_eg) + (size_t)e * D * EFF, EFF, 64 * kb, 128 * n + 32 * nb + (lane & 31), WGU + (size_t)e * 512 * D, D, 256 * n + 128 * up + 32 * nb, scr, lane); }
        else { const int q = r - 256, kb = q >> 5, nb = q & 31;
            transpose_item(w_ed + (size_t)e * EFF * D, D, 64 * kb, 32 * nb + (lane & 31), WD + (size_t)e * D * EFF, EFF, 32 * nb, scr, lane); }
    }
}
struct ProgRouter {
    const char* FINb; const char* WRT; float* SCORE; int G, c;
    __device__ __forceinline__ bool next(int i, eng::UnitD& u, LAS unsigned char*) const {
        const long L = (long)i * G + c; if (L >= 256) return false;
        u.A = FINb + (size_t)L * (256 * 2048); u.B = WRT; u.lda = 2048; u.ldb = 2048; u.nt = 16; u.type = 0; u.r0 = (int)L; u.r1 = 0; u.r2 = 0; u.r3 = 0; return true;
    }
    __device__ __forceinline__ void first(const eng::UnitD&, LAS unsigned char*) const {}
    __device__ __forceinline__ void prefetch(const eng::UnitD&, LAS unsigned char*) const {}
    __device__ __forceinline__ void offsets(const eng::UnitD& u, const int (&Rr)[2], const int (&Cc)[2], unsigned (&oA)[2][2], LAS unsigned char*) const {
#pragma unroll
        for (int h = 0; h < 2; ++h)
#pragma unroll
            for (int i = 0; i < 2; ++i) oA[h][i] = (unsigned)(128 * h + Rr[i]) * u.lda + (unsigned)Cc[i];
    }
    __device__ __forceinline__ void epilogue(eng::Acc& acc, const eng::UnitD& u, int wr, int wc, int fr, int fq, LAS unsigned char*) const {
        float* dst = SCORE + ((size_t)u.r0 * 256 + wr * 64 + fr) * NE + wc * 32 + 8 * fq;
#pragma unroll
        for (int ai = 0; ai < 2; ++ai)
#pragma unroll
            for (int m = 0; m < 4; ++m)
#pragma unroll
                for (int bj = 0; bj < 2; ++bj)
#pragma unroll
                    for (int n = 0; n < 2; ++n) *(f32x4*)(dst + (size_t)(ai * 128 + m * 16) * NE + bj * 128 + 4 * n) = acc[ai][bj][m][n];
    }
};
__device__ __forceinline__ void p_topk(Frame& F, const Args& a) {
    int tid_ = threadIdx.x; asm volatile("" : "+v"(tid_)); const int lane_ = tid_ & 63, wave_ = __builtin_amdgcn_readfirstlane(tid_ >> 6);
    const float* SCORE = (const float*)(F.ws + WS_SCORE); const float* e_bias = a.in[22];
    int* TOPI = (int*)(F.ws + WS_TOPI); float* TOPW = (float*)(F.ws + WS_TOPW); int* cnt = (int*)(F.ws + WS_CTL) + CW_CNT2;
    LAS float* sb = (LAS float*)F.lds;
    for (int i = tid_; i < NE; i += 512) sb[i] = e_bias[i];
    __syncthreads();
    for (int tok = F.vcu * 512 + tid_; tok < T; tok += F.G * 512) {
        const float* sr = SCORE + (size_t)tok * NE;
        float gv4[TKG]; int gi4[TKG];
#pragma unroll
        for (int q = 0; q < TKG; ++q) { gv4[q] = -INFINITY; gi4[q] = 0; }
        for (int g = 0; g < NG; ++g) { float m1 = -INFINITY, m2 = -INFINITY;
            for (int j = 0; j < 32; j += 4) { const f32x4 v = *(const f32x4*)(sr + g * 32 + j);
#pragma unroll
                for (int q = 0; q < 4; ++q) { const float s = sigmoidf_(v[q]) + sb[g * 32 + j + q]; if (s > m1) { m2 = m1; m1 = s; } else if (s > m2) m2 = s; } }
            float s = m1 + m2; int id = g; bool placed = false;
#pragma unroll
            for (int p = 0; p < TKG; ++p) { const bool sw = placed || (s > gv4[p]); const float t1 = gv4[p]; const int t2 = gi4[p]; gv4[p] = sw ? s : t1; gi4[p] = sw ? id : t2; s = sw ? t1 : s; id = sw ? t2 : id; placed = sw; } }
        unsigned gmask = 0;
#pragma unroll
        for (int q = 0; q < TKG; ++q) gmask |= 1u << gi4[q];
        float tv[TOPK]; int ti[TOPK];
#pragma unroll
        for (int q = 0; q < TOPK; ++q) { tv[q] = -INFINITY; ti[q] = 0; }
        for (int g = 0; g < NG; ++g) { if (!((gmask >> g) & 1u)) continue;
            for (int j = 0; j < 32; j += 4) { const f32x4 v = *(const f32x4*)(sr + g * 32 + j);
#pragma unroll
                for (int q = 0; q < 4; ++q) { const int e = g * 32 + j + q; float s = sigmoidf_(v[q]) + sb[e]; int id = e;
                    if (s > tv[TOPK - 1]) { bool placed = false;
#pragma unroll
                        for (int p = 0; p < TOPK; ++p) { const bool sw = placed || (s > tv[p]); const float t1 = tv[p]; const int t2 = ti[p]; tv[p] = sw ? s : t1; ti[p] = sw ? id : t2; s = sw ? t1 : s; id = sw ? t2 : id; placed = sw; } } } } }
        float w[TOPK]; float wsum = 0.f;
#pragma unroll
        for (int q = 0; q < TOPK; ++q) { w[q] = sigmoidf_(sr[ti[q]]); wsum += w[q]; }
        const float inv = RSCALE / wsum; const int ch = tok / TCH;
#pragma unroll
        for (int q = 0; q < TOPK; ++q) { TOPI[tok * TOPK + q] = ti[q]; TOPW[tok * TOPK + q] = w[q] * inv; atomicAdd(&cnt[ch * NE + ti[q]], 1); }
    }
    __syncthreads();
}
__device__ __forceinline__ void moe_tile_offsets(Frame& F) {
    int tid_ = threadIdx.x; asm volatile("" : "+v"(tid_)); const int lane_ = tid_ & 63, wave_ = __builtin_amdgcn_readfirstlane(tid_ >> 6);
    const int* cnt = (const int*)(F.ws + WS_CTL) + CW_CNT2; LAS int* toff = (LAS int*)(F.lds + LDS_TOFF);
    if (tid_ < NCH) { int s = 0; for (int e = 0; e < NE; ++e) { toff[tid_ * 257 + e] = s; s += (cnt[tid_ * NE + e] + 255) >> 8; } toff[tid_ * 257 + NE] = s; }
    __syncthreads();
}
__device__ __forceinline__ void p_scatter(Frame& F) {
    int tid_ = threadIdx.x; asm volatile("" : "+v"(tid_)); const int lane_ = tid_ & 63, wave_ = __builtin_amdgcn_readfirstlane(tid_ >> 6);
    moe_tile_offsets(F);
    const LAS int* toff = (const LAS int*)(F.lds + LDS_TOFF); int* ctl = (int*)(F.ws + WS_CTL);
    const int* TOPI = (const int*)(F.ws + WS_TOPI); const float* TOPW = (const float*)(F.ws + WS_TOPW); int* LIST = (int*)(F.ws + WS_LIST); float* LISTW = (float*)(F.ws + WS_LISTW);
    for (int ce = F.vcu; ce < NCH * NE; ce += F.G) { const int c = ce >> 8, e = ce & 255, n = ctl[CW_CNT2 + ce], base = toff[c * 257 + e] * 256, cap = ((n + 255) >> 8) << 8;
        for (int p = n + tid_; p < cap; p += 512) { LIST[c * LIST_CAP + base + p] = -1; LISTW[c * LIST_CAP + base + p] = 0.f; } }
    for (int asg = F.vcu * 512 + tid_; asg < T * TOPK; asg += F.G * 512) { const int e = TOPI[asg], c = (asg >> 3) / TCH;
        const int p = atomicAdd(&ctl[CW_FILL2 + c * NE + e], 1); const int slot = c * LIST_CAP + toff[c * 257 + e] * 256 + p;
        LIST[slot] = asg; LISTW[slot] = TOPW[asg]; }
    __syncthreads();
}
struct ProgMoE {
    unsigned char* dout; unsigned char* ws; const char* FINb; const char* WGU; const char* WD; char* HID;
    const int* LIST; const float* LISTW; int chunk, ntiles, vcu, G, ns, drain;
    __device__ __forceinline__ int expert_of(int j, LAS unsigned char* lds) const {
        const LAS int* toff = (const LAS int*)(lds + LDS_TOFF) + chunk * 257; int lo = 0, hi = NE;
#pragma unroll
        for (int it = 0; it < 8; ++it) { const int mid = (lo + hi) >> 1; const bool ge = j >= toff[mid]; lo = ge ? mid : lo; hi = ge ? hi : mid; }
        return __builtin_amdgcn_readfirstlane(lo);
    }
    __device__ __forceinline__ bool next(int i, eng::UnitD& u, LAS unsigned char* lds) const {
        int s, kind, n;
        if (drain) { if (i >= 4 || ns == 0) return false; s = ns - 1; kind = 1; n = i; }
        else { if (i < 2) { s = 0; kind = 0; n = i; } else { const int ii = i - 2; s = 1 + ii / 6; const int r = ii % 6; if (r < 2) { kind = 0; n = r; } else { kind = 1; n = r - 2; s -= 1; } }
               if (kind == 0 ? (s >= ns) : (s + 1 >= ns)) return false; }
        const int j = s * G + vcu;
        const int e = expert_of(j, lds);
        u.type = kind; u.r0 = s; u.r1 = n; u.r2 = j; u.r3 = e;
        if (kind == 0) { u.A = FINb; u.lda = 2048; u.B = WGU + (size_t)e * (512 * 2048) + (size_t)n * (256 * 2048); u.ldb = 2048; u.nt = 16; }
        else { u.A = HID + (size_t)(s & 1) * (256 * 512); u.lda = 512; u.B = WD + (size_t)e * (1024 * 512) + (size_t)n * (256 * 512); u.ldb = 512; u.nt = 4; }
        return true;
    }
    __device__ __forceinline__ void idx_dma(const eng::UnitD& u, LAS unsigned char* lds) const {
        if (threadIdx.x < 64) { const size_t base = (size_t)chunk * LIST_CAP + (size_t)u.r2 * 256 + threadIdx.x * 4; LAS unsigned char* dst = lds + LDS_IDX + (u.r0 % 3) * 2048;
            __builtin_amdgcn_global_load_lds((const unsigned*)(LIST + base), (LAS unsigned*)dst, 16, 0, 0);
            __builtin_amdgcn_global_load_lds((const unsigned*)(LISTW + base), (LAS unsigned*)(dst + 1024), 16, 0, 0); }
    }
    __device__ __forceinline__ void first(const eng::UnitD& u, LAS unsigned char* lds) const {
        if (!drain) { idx_dma(u, lds); asm volatile("s_waitcnt vmcnt(0)" ::: "memory"); __builtin_amdgcn_s_barrier(); asm volatile("" ::: "memory"); }
    }
    __device__ __forceinline__ void prefetch(const eng::UnitD& nxt, LAS unsigned char* lds) const { if (nxt.type == 0 && nxt.r1 == 0) idx_dma(nxt, lds); }
    __device__ __forceinline__ void offsets(const eng::UnitD& u, const int (&Rr)[2], const int (&Cc)[2], unsigned (&oA)[2][2], LAS unsigned char* lds) const {
        if (u.type == 0) { const LAS int* idx = (const LAS int*)(lds + LDS_IDX + (u.r0 % 3) * 2048);
#pragma unroll
            for (int h = 0; h < 2; ++h)
#pragma unroll
                for (int i = 0; i < 2; ++i) { const int v = idx[128 * h + Rr[i]]; oA[h][i] = (unsigned)((v < 0 ? 0 : v) >> 3) * 2048u + (unsigned)Cc[i]; } }
        else {
#pragma unroll
            for (int h = 0; h < 2; ++h)
#pragma unroll
                for (int i = 0; i < 2; ++i) oA[h][i] = (unsigned)(128 * h + Rr[i]) * 512u + (unsigned)Cc[i]; }
    }
    __device__ __forceinline__ void epilogue(eng::Acc& acc, const eng::UnitD& u, int wr, int wc, int fr, int fq, LAS unsigned char* lds) const {
        if (u.type == 0) {
            bf16* dst = (bf16*)(HID + (size_t)(u.r0 & 1) * (256 * 512)) + (size_t)(wr * 64 + fr) * 256 + u.r1 * 128 + wc * 32 + 8 * fq;
#pragma unroll
            for (int ai = 0; ai < 2; ++ai)
#pragma unroll
                for (int m = 0; m < 4; ++m) { f32x4 h0, h1;
#pragma unroll
                    for (int e = 0; e < 4; ++e) { h0[e] = siluf_(acc[ai][0][m][0][e]) * acc[ai][1][m][0][e]; h1[e] = siluf_(acc[ai][0][m][1][e]) * acc[ai][1][m][1][e]; }
                    u32x4 w; w.x = cvt_pk_bf16(h0[0], h0[1]); w.y = cvt_pk_bf16(h0[2], h0[3]); w.z = cvt_pk_bf16(h1[0], h1[1]); w.w = cvt_pk_bf16(h1[2], h1[3]);
                    *(u32x4*)(dst + (size_t)(ai * 128 + m * 16) * 256) = w; }
        } else {
            const LAS int* idx = (const LAS int*)(lds + LDS_IDX + (u.r0 % 3) * 2048); const LAS float* wgt = (const LAS float*)(idx + 256);
            const int col = u.r1 * 256 + wc * 32 + 8 * fq;
#pragma unroll
            for (int ai = 0; ai < 2; ++ai)
#pragma unroll
                for (int m = 0; m < 4; ++m) { const int r = ai * 128 + wr * 64 + m * 16 + fr; const int asg = idx[r]; const float w = wgt[r];
                    if (asg >= 0) { bf16* rowp = eo_block(dout, ws, asg & 7) + (size_t)((asg >> 3) - chunk * TCH) * D + col;
#pragma unroll
                        for (int bj = 0; bj < 2; ++bj) { const f32x4 v0 = acc[ai][bj][m][0] * w, v1 = acc[ai][bj][m][1] * w;
                            u32x4 o; o.x = cvt_pk_bf16(v0[0], v0[1]); o.y = cvt_pk_bf16(v0[2], v0[3]); o.z = cvt_pk_bf16(v1[0], v1[1]); o.w = cvt_pk_bf16(v1[2], v1[3]);
                            *(u32x4*)(rowp + bj * 128) = o; } } }
        }
    }
};
struct ProgSharedG1 {
    const char* FINb; const char* WSGU; bf16* HIDSH; int G, c;
    __device__ __forceinline__ bool next(int i, eng::UnitD& u, LAS unsigned char*) const {
        const long L = (long)i * G + c; if (L >= 512) return false;
        const int pm = (int)(L >> 1), n = (int)(L & 1);
        u.A = FINb + (size_t)pm * (256 * 2048); u.B = WSGU + (size_t)n * (256 * 2048); u.lda = 2048; u.ldb = 2048; u.nt = 16; u.type = 0; u.r0 = pm; u.r1 = n; u.r2 = 0; u.r3 = 0; return true;
    }
    __device__ __forceinline__ void first(const eng::UnitD&, LAS unsigned char*) const {}
    __device__ __forceinline__ void prefetch(const eng::UnitD&, LAS unsigned char*) const {}
    __device__ __forceinline__ void offsets(const eng::UnitD& u, const int (&Rr)[2], const int (&Cc)[2], unsigned (&oA)[2][2], LAS unsigned char*) const {
#pragma unroll
        for (int h = 0; h < 2; ++h)
#pragma unroll
            for (int i = 0; i < 2; ++i) oA[h][i] = (unsigned)(128 * h + Rr[i]) * u.lda + (unsigned)Cc[i];
    }
    __device__ __forceinline__ void epilogue(eng::Acc& acc, const eng::UnitD& u, int wr, int wc, int fr, int fq, LAS unsigned char*) const {
        bf16* dst = HIDSH + ((size_t)u.r0 * 256 + wr * 64 + fr) * 256 + u.r1 * 128 + wc * 32 + 8 * fq;
#pragma unroll
        for (int ai = 0; ai < 2; ++ai)
#pragma unroll
            for (int m = 0; m < 4; ++m) { f32x4 h0, h1;
#pragma unroll
                for (int e = 0; e < 4; ++e) { h0[e] = siluf_(acc[ai][0][m][0][e]) * acc[ai][1][m][0][e]; h1[e] = siluf_(acc[ai][0][m][1][e]) * acc[ai][1][m][1][e]; }
                u32x4 w; w.x = cvt_pk_bf16(h0[0], h0[1]); w.y = cvt_pk_bf16(h0[2], h0[3]); w.z = cvt_pk_bf16(h1[0], h1[1]); w.w = cvt_pk_bf16(h1[2], h1[3]);
                *(u32x4*)(dst + (size_t)(ai * 128 + m * 16) * 256) = w; }
    }
};
struct ProgCombine {
    unsigned char* dout; unsigned char* ws; const char* HIDSHb; const char* WSD; bf16* FX; float* RS2; int chunk, G, c;
    __device__ __forceinline__ bool next(int i, eng::UnitD& u, LAS unsigned char*) const {
        const long L = (long)i * G + c; if (L >= (TCH / 256) * 4) return false;
        const int pm = chunk * (TCH / 256) + (int)(L >> 2), n = (int)(L & 3);
        u.A = HIDSHb + (size_t)pm * (256 * 512); u.B = WSD + (size_t)n * (256 * 512); u.lda = 512; u.ldb = 512; u.nt = 4; u.type = 0; u.r0 = pm; u.r1 = n; u.r2 = 0; u.r3 = 0; return true;
    }
    __device__ __forceinline__ void first(const eng::UnitD&, LAS unsigned char*) const {}
    __device__ __forceinline__ void prefetch(const eng::UnitD&, LAS unsigned char*) const {}
    __device__ __forceinline__ void offsets(const eng::UnitD& u, const int (&Rr)[2], const int (&Cc)[2], unsigned (&oA)[2][2], LAS unsigned char*) const {
#pragma unroll
        for (int h = 0; h < 2; ++h)
#pragma unroll
            for (int i = 0; i < 2; ++i) oA[h][i] = (unsigned)(128 * h + Rr[i]) * u.lda + (unsigned)Cc[i];
    }
    __device__ __forceinline__ void epilogue(eng::Acc& acc, const eng::UnitD& u, int wr, int wc, int fr, int fq, LAS unsigned char*) const {
        const size_t row0 = (size_t)u.r0 * 256 + wr * 64 + fr; const size_t lrow0 = row0 - (size_t)chunk * TCH; const int col = u.r1 * 256 + wc * 32 + 8 * fq;
        const bf16* elo = (const bf16*)dout; const bf16* ehi = (const bf16*)(ws + WS_EOHI);
#pragma unroll
        for (int ai = 0; ai < 2; ++ai)
#pragma unroll
            for (int m = 0; m < 4; ++m) { const size_t ro = (lrow0 + ai * 128 + m * 16) * D + col; float ss = 0.f;
#pragma unroll
                for (int bj = 0; bj < 2; ++bj) { f32x4 v0 = acc[ai][bj][m][0], v1 = acc[ai][bj][m][1];
#pragma unroll
                    for (int k = 0; k < TOPK; ++k) { const u32x4 p = *(const u32x4*)((k < 4 ? elo : ehi) + (size_t)(k & 3) * (32 * MiB) + ro + bj * 128);
                        v0[0] += __uint_as_float(p.x << 16); v0[1] += __uint_as_float(p.x & 0xffff0000u); v0[2] += __uint_as_float(p.y << 16); v0[3] += __uint_as_float(p.y & 0xffff0000u);
                        v1[0] += __uint_as_float(p.z << 16); v1[1] += __uint_as_float(p.z & 0xffff0000u); v1[2] += __uint_as_float(p.w << 16); v1[3] += __uint_as_float(p.w & 0xffff0000u); }
                    ss += (v0[0] * v0[0] + v0[1] * v0[1]) + (v0[2] * v0[2] + v0[3] * v0[3]) + (v1[0] * v1[0] + v1[1] * v1[1]) + (v1[2] * v1[2] + v1[3] * v1[3]);
                    u32x4 o; o.x = cvt_pk_bf16(v0[0], v0[1]); o.y = cvt_pk_bf16(v0[2], v0[3]); o.z = cvt_pk_bf16(v1[0], v1[1]); o.w = cvt_pk_bf16(v1[2], v1[3]);
                    *(u32x4*)(FX + (row0 + ai * 128 + m * 16) * D + col + bj * 128) = o; }
                ss += __shfl_xor(ss, 16); ss += __shfl_xor(ss, 32);
                if (fq == 0) RS2[(row0 + ai * 128 + m * 16) * 16 + u.r1 * 4 + wc] = ss;
                asm volatile("" ::: "memory"); }
        __builtin_amdgcn_s_waitcnt(0x0F70);
    }
};
__device__ __forceinline__ void p_final(Frame& F, const Args& a) {
    int tid_ = threadIdx.x; asm volatile("" : "+v"(tid_)); const int lane_ = tid_ & 63, wave_ = __builtin_amdgcn_readfirstlane(tid_ >> 6);
    const float* x = a.in[0]; const f32x4* gpost = (const f32x4*)a.in[7]; const f32x4* gpf = (const f32x4*)a.in[9];
    const float* mod = (const float*)(F.ws + WS_MOD); const bf16* YO = (const bf16*)(F.ws + WS_RA); const bf16* FX = (const bf16*)(F.ws + WS_GA);
    const float* RS1 = (const float*)(F.ws + WS_RS1); const float* RS2 = (const float*)(F.ws + WS_RS2);
    const int gw = F.vcu * NWAVES + wave_, NGW = F.G * NWAVES, lane = lane_;
    for (int row = gw; row < T; row += NGW) {
        const f32x4* mr = (const f32x4*)(mod + (size_t)(row / S) * (NMOD * D));
        const f32x4* xr = (const f32x4*)(x + (size_t)row * D); const u32x2* yr = (const u32x2*)(YO + (size_t)row * D); const u32x2* fr_ = (const u32x2*)(FX + (size_t)row * D);
        float s1 = (lane < 16) ? RS1[(size_t)row * 16 + lane] : ((lane < 32) ? RS2[(size_t)row * 16 + lane - 16] : 0.f);
        s1 += __shfl_xor(s1, 1); s1 += __shfl_xor(s1, 2); s1 += __shfl_xor(s1, 4); s1 += __shfl_xor(s1, 8);
        const float rs1 = rsqrtf(__shfl(s1, 0) * (1.f / D) + EPS), rs2 = rsqrtf(__shfl(s1, 16) * (1.f / D) + EPS);
        f32x4* orow = (f32x4*)(a.out + (size_t)row * D);
#pragma unroll
        for (int j = 0; j < 4; ++j) { const int i4 = 64 * j + lane; const u32x2 yb = yr[i4], fb = fr_[i4]; const f32x4 xv = xr[i4], g1 = mr[512 + i4], g2 = mr[1280 + i4], gp = gpost[i4], gf = gpf[i4];
            f32x4 y, f; y[0] = __uint_as_float(yb.x << 16); y[1] = __uint_as_float(yb.x & 0xffff0000u); y[2] = __uint_as_float(yb.y << 16); y[3] = __uint_as_float(yb.y & 0xffff0000u);
            f[0] = __uint_as_float(fb.x << 16); f[1] = __uint_as_float(fb.x & 0xffff0000u); f[2] = __uint_as_float(fb.y << 16); f[3] = __uint_as_float(fb.y & 0xffff0000u);
            orow[i4] = xv + g1 * (y * rs1 * gp) + g2 * (f * rs2 * gf); }
    }
}
__global__ void __launch_bounds__(NWAVES * 64, 2) mk_fwd(Args args) {
    extern __shared__ __attribute__((aligned(16))) unsigned char lds_raw[];
    Frame F;
    F.lds = (LAS unsigned char*)lds_raw;
    F.G = gridDim.x; { const int bx = blockIdx.x; F.vcu = (F.G % 8 == 0) ? (bx % 8) * (F.G / 8) + bx / 8 : bx; }
    F.ws = args.ws; F.dout = (unsigned char*)args.out;
    volatile LAS unsigned* MISC = (volatile LAS unsigned*)(F.lds + LDSCTL_OFF);
    for (int u = threadIdx.x; u < (LDS_BYTES - LDSCTL_OFF) / 4; u += NWAVES * 64) ((LAS unsigned*)(F.lds + LDSCTL_OFF))[u] = 0u;
    __syncthreads();
    XcdBarrier bar = xcd_barrier_post((unsigned*)(F.ws + WS_CTL) + CW_BAR, MISC + 8);
    const int lo = args.ph_lo, hi = args.ph_hi;
#define IN(k) (lo <= (k) && (k) < hi)
#define BOTH(k) (IN(k) && IN((k) + 1))
    if (IN(0)) { p0_prologue(F, args); if (BOTH(0)) xcd_barrier(bar); }
    if (IN(1)) { p1_norm_gates(F, args); if (BOTH(1)) xcd_barrier(bar); }
    if (IN(2)) {
        ProgInProj P; P.A1 = (const char*)(F.ws + WS_RA); P.BT1 = (const char*)(F.ws + WS_BT1); P.G = F.G; P.c = (int)blockIdx.x;
        P.Q = (bf16*)(F.ws + WS_Q); P.K = (bf16*)(F.dout + DO_K); P.V = (bf16*)(F.dout + DO_V); P.MQ = (bf16*)(F.dout + DO_MQ);
        P.MO = (bf16*)(F.ws + WS_MO); P.GA = (bf16*)(F.ws + WS_GA); { LAS float* tab = (LAS float*)(F.lds + RING_BYTES); const float* rp = (const float*)(F.ws + WS_ROPE);
          int tq = threadIdx.x; asm volatile("" : "+v"(tq));
          for (int i = tq; i < 2048; i += 512) tab[i] = rp[i];
          if (tq < 64) tab[2048 + tq] = args.in[11][tq]; else if (tq < 128) tab[2048 + tq] = args.in[12][tq - 64];
          __syncthreads(); P.tab = tab; }
        eng::gemm_stream<ProgInProj, 0>(F.lds, P);
        if (BOTH(2)) xcd_barrier(bar);
    }
    if (IN(3)) {
        const attn_body::AttnTensors AT{(const attn_body::bf16*)(F.ws + WS_Q), (const attn_body::bf16*)(F.dout + DO_K), (const attn_body::bf16*)(F.dout + DO_V), (attn_body::bf16*)(F.ws + WS_RA)};
        const attn_body::StaticOrder SO(F.G, F.vcu);
        attn_body::attn_phase<attn_body::StaticOrder>((char*)lds_raw, AT, SO);
#if !defined(EXP_BASE_MLSTM) && !defined(EXP_SPLIT_MLSTM)
        ml::mlstm_phase(F, args);
#endif
        if (BOTH(3)) xcd_barrier(bar);
    }
#ifdef EXP_SPLIT_MLSTM
    if (IN(16)) ml::mlstm_phase(F, args);
#endif
    if (IN(4)) {
#ifndef EXP_BASE_MLSTM
        ml::mlstm_combine(F, args);
#endif
        p0_expert_weights(F, args); if (BOTH(4)) xcd_barrier(bar); }
    if (IN(5)) {
        ProgMerge P; P.AM = (const char*)(F.ws + WS_RA); P.WAT = (const char*)(F.ws + WS_WAT); P.WMT = (const char*)(F.ws + WS_WMT); P.Y = (bf16*)(F.dout); P.GA = (const bf16*)(F.ws + WS_GA); P.G = F.G; P.c = (int)blockIdx.x;
        eng::gemm_stream<ProgMerge, 0>(F.lds, P);
        if (BOTH(5)) xcd_barrier(bar);
    }
    if (IN(6)) {
        ProgOut P; P.Yb = (const char*)(F.dout); P.WOT = (const char*)(F.ws + WS_WOT); P.YO = (bf16*)(F.ws + WS_RA); P.RS1 = (float*)(F.ws + WS_RS1); P.G = F.G; P.c = (int)blockIdx.x;
        eng::gemm_stream<ProgOut, 0>(F.lds, P);
        if (BOTH(6)) xcd_barrier(bar);
    }
    if (IN(7)) { p6_rowpass<false>(F, args); if (BOTH(7)) xcd_barrier(bar); }
    if (IN(8)) {
        ProgRouter P; P.FINb = (const char*)(F.ws + WS_GA); P.WRT = (const char*)(F.ws + WS_WRT); P.SCORE = (float*)(F.ws + WS_SCORE); P.G = F.G; P.c = F.vcu;
        eng::gemm_stream<ProgRouter, 0>(F.lds, P);
        if (BOTH(8)) xcd_barrier(bar);
    }
    if (IN(9)) { p_topk(F, args); if (BOTH(9)) xcd_barrier(bar); }
    if (IN(10)) { p_scatter(F); if (BOTH(10)) xcd_barrier(bar); }

        if (IN(11)) {
            moe_tile_offsets(F);
            ProgMoE P; P.dout = F.dout; P.ws = F.ws; P.FINb = (const char*)(F.ws + WS_GA); P.WGU = (const char*)(F.ws + WS_WGU); P.WD = (const char*)(F.ws + WS_WD); P.HID = (char*)(F.ws + WS_HIDS) + (size_t)F.vcu * (2 * 256 * 512);
            P.LIST = (const int*)(F.ws + WS_LIST); P.LISTW = (const float*)(F.ws + WS_LISTW); P.chunk = 0; P.vcu = F.vcu; P.G = F.G;
            P.ntiles = __builtin_amdgcn_readfirstlane(((const LAS int*)(F.lds + LDS_TOFF))[0 * 257 + NE]);
            P.ns = P.ntiles > F.vcu ? (P.ntiles - F.vcu + F.G - 1) / F.G : 0;
            P.drain = 0; eng::gemm_stream<ProgMoE, 16>(F.lds, P);
            P.drain = 1; eng::gemm_stream<ProgMoE, 16>(F.lds, P);
            { ProgSharedG1 Q1; Q1.FINb = (const char*)(F.ws + WS_GA); Q1.WSGU = (const char*)(F.ws + WS_WSGU); Q1.HIDSH = (bf16*)(F.ws + WS_HIDSH); Q1.G = F.G; Q1.c = F.vcu;
                eng::gemm_stream<ProgSharedG1, 0>(F.lds, Q1); }
            if (BOTH(11)) xcd_barrier(bar);
        }
        if (IN(12)) {
            ProgCombine P; P.dout = F.dout; P.ws = F.ws; P.HIDSHb = (const char*)(F.ws + WS_HIDSH); P.WSD = (const char*)(F.ws + WS_WSD); P.FX = (bf16*)(F.ws + WS_GA); P.RS2 = (float*)(F.ws + WS_RS2); P.chunk = 0; P.G = F.G; P.c = F.vcu;
            eng::gemm_stream<ProgCombine, 0>(F.lds, P);
            if (BOTH(12)) xcd_barrier(bar);
        }

        if (IN(13)) {
            moe_tile_offsets(F);
            ProgMoE P; P.dout = F.dout; P.ws = F.ws; P.FINb = (const char*)(F.ws + WS_GA); P.WGU = (const char*)(F.ws + WS_WGU); P.WD = (const char*)(F.ws + WS_WD); P.HID = (char*)(F.ws + WS_HIDS) + (size_t)F.vcu * (2 * 256 * 512);
            P.LIST = (const int*)(F.ws + WS_LIST); P.LISTW = (const float*)(F.ws + WS_LISTW); P.chunk = 1; P.vcu = F.vcu; P.G = F.G;
            P.ntiles = __builtin_amdgcn_readfirstlane(((const LAS int*)(F.lds + LDS_TOFF))[1 * 257 + NE]);
            P.ns = P.ntiles > F.vcu ? (P.ntiles - F.vcu + F.G - 1) / F.G : 0;
            P.drain = 0; eng::gemm_stream<ProgMoE, 16>(F.lds, P);
            P.drain = 1; eng::gemm_stream<ProgMoE, 16>(F.lds, P);
            if (BOTH(13)) xcd_barrier(bar);
        }
        if (IN(14)) {
            ProgCombine P; P.dout = F.dout; P.ws = F.ws; P.HIDSHb = (const char*)(F.ws + WS_HIDSH); P.WSD = (const char*)(F.ws + WS_WSD); P.FX = (bf16*)(F.ws + WS_GA); P.RS2 = (float*)(F.ws + WS_RS2); P.chunk = 1; P.G = F.G; P.c = F.vcu;
            eng::gemm_stream<ProgCombine, 0>(F.lds, P);
            if (BOTH(14)) xcd_barrier(bar);
        }
        if (IN(15)) p_final(F, args);
#undef IN
#undef BOTH
}

static void launch_mk(hipStream_t st, const Args& a0, int grid, int lo, int hi) {
    Args a = a0; a.ph_lo = lo; a.ph_hi = hi;
    hipLaunchKernelGGL(mk_fwd, dim3(grid), dim3(NWAVES * 64), LDS_BYTES, st, a);
}
extern "C" void kernel_launch(void* const* d_in, const int* in_sizes, int n_in, void* d_out, int out_size, void* d_ws, size_t ws_size, hipStream_t st) {
    static int grid = 0;
    if (grid == 0) {
        if (n_in != 29 || ws_size < WS_NEED) { fprintf(stderr, "kernel_launch: unexpected n_in %d / ws_size %zu\n", n_in, ws_size); grid = -1; return; }
        int dev = 0, cus = 0;
        if (hipGetDevice(&dev) != hipSuccess || hipDeviceGetAttribute(&cus, hipDeviceAttributeMultiprocessorCount, dev) != hipSuccess) { grid = -1; return; }
        if (hipFuncSetAttribute((const void*)mk_fwd, hipFuncAttributeMaxDynamicSharedMemorySize, LDS_BYTES) != hipSuccess) { fprintf(stderr, "kernel_launch: hipFuncSetAttribute failed\n"); grid = -1; return; }
        int per_cu = 0;
        if (hipOccupancyMaxActiveBlocksPerMultiprocessor(&per_cu, (const void*)mk_fwd, NWAVES * 64, LDS_BYTES) != hipSuccess || per_cu < 1) fprintf(stderr, "kernel_launch: occupancy query says %d\n", per_cu);
        (void)hipGetLastError();
        grid = cus;
    }
    if (grid < 0) return;
    float* out = (float*)d_out; unsigned char* ws = (unsigned char*)d_ws; unsigned char* dob = (unsigned char*)d_out;
    (void)hipMemsetAsync(ws + WS_CTL, 0, CTL_ZERO_BYTES, st);
    Args a; memset(&a, 0, sizeof(a));
    for (int i = 0; i < 29; ++i) a.in[i] = (const float*)d_in[i];
    a.out = out; a.ws = ws;
#if defined(EXP_SPLIT_MLSTM)
    for (int ph = 0; ph < 4; ++ph) launch_mk(st, a, grid, ph, ph + 1);
    launch_mk(st, a, grid, 16, 17);
    for (int ph = 4; ph < 16; ++ph) launch_mk(st, a, grid, ph, ph + 1);
#elif defined(EXP_PER_PHASE)
    for (int ph = 0; ph < 16; ++ph) launch_mk(st, a, grid, ph, ph + 1);
#else
    launch_mk(st, a, grid, 0, 16);
#endif
}
```

```cpp
#include <hip/hip_runtime.h>
#include <cstdio>
#include <cstdint>
#include <cstring>

constexpr int D = 1024, NB = 32, S = 2048, CL = 256, T = NB * S, TC = NB * CL, TA = T + TC, SL = S + CL;
constexpr int NMOD = 6, INW = 4880;
constexpr int AH = 8, AKV = 2, HD = 64, AW = 512, KVW = 128;
constexpr int MH = 4, MD = 128, MW = 512, MCH = 64;
constexpr int NE = 256, TOPK = 8, NG = 8, TKG = 4, EFF = 256;
constexpr float EPS = 1e-6f, RSCALE = 2.5f;
constexpr int C_Q = 0, C_K = 512, C_V = 640, C_MQ = 768, C_MK = 1280, C_MV = 1792, C_MO = 2304, C_MI = 2816, C_MF = 2824, C_GA = 2832, C_GM = 3856;
constexpr int N1 = 4864;

typedef unsigned short bf16;
typedef short bf16x8 __attribute__((ext_vector_type(8)));
typedef float f32x4 __attribute__((ext_vector_type(4)));
typedef float f32x2 __attribute__((ext_vector_type(2)));
typedef unsigned u32x4 __attribute__((ext_vector_type(4)));
typedef unsigned u32x2 __attribute__((ext_vector_type(2)));
#define LAS __attribute__((address_space(3)))
#define GAS __attribute__((address_space(1)))
__device__ __forceinline__ float bf2f(bf16 b) { return __uint_as_float(((unsigned)b) << 16); }
__device__ __forceinline__ bf16 f2bf(float f) { unsigned u = __float_as_uint(f); u += 0x7fffu + ((u >> 16) & 1u); return (bf16)(u >> 16); }
typedef __bf16 bf16x2_t __attribute__((ext_vector_type(2)));
__device__ __forceinline__ unsigned cvt_pk_bf16(float lo, float hi) { unsigned r; asm volatile("s_nop 0\n\tv_cvt_pk_bf16_f32 %0, %1, %2" : "=v"(r) : "v"(lo), "v"(hi)); return r; }
__device__ __forceinline__ unsigned cvt_pk_bf16_s(float lo, float hi) { const f32x2 v = {lo, hi}; return __builtin_bit_cast(unsigned, __builtin_convertvector(v, bf16x2_t)); }
__device__ __forceinline__ float ldf(const float* p) { return *p; }
__device__ __forceinline__ float ldf(const bf16* p) { return bf2f(*p); }
__device__ __forceinline__ float sigmoidf_(float x) { return __builtin_amdgcn_rcpf(1.f + __expf(-x)); }
__device__ __forceinline__ float siluf_(float x) { return x * __builtin_amdgcn_rcpf(1.f + __expf(-x)); }
__device__ __forceinline__ float wave_sum(float v) {
#pragma unroll
    for (int o = 1; o < 64; o <<= 1) v += __shfl_xor(v, o);
    return v;
}
__device__ __forceinline__ int seqrow_lat(int r) { const int b = r / S, t = r % S; return b * SL + CL + t; }
__device__ __forceinline__ int seqrow_ctx(int r) { const int b = r / CL, t = r % CL; return b * SL + t; }

constexpr size_t MiB = 1u << 20;
constexpr size_t WS_CTL = 0, CTL_ZERO_BYTES = 1 * MiB;
constexpr size_t WS_MOD = 1 * MiB;
constexpr size_t WS_GATES = 2 * MiB;
constexpr size_t WS_ROPE = 7 * MiB;
constexpr size_t WS_BT1 = 8 * MiB;
constexpr size_t WS_WAT = 18 * MiB;
constexpr size_t WS_WMT = 19 * MiB;
constexpr size_t WS_WOT = 20 * MiB;
constexpr size_t WS_WRT = 22 * MiB;
constexpr size_t WS_WSGU = 23 * MiB;
constexpr size_t WS_WSD = 24 * MiB;
constexpr size_t WS_RS1 = 25 * MiB;
constexpr size_t WS_RS2 = 29 * MiB;
constexpr size_t WS_TOPI = 33 * MiB;
constexpr size_t WS_TOPW = 35 * MiB;
constexpr size_t WS_LIST = 37 * MiB;
constexpr size_t WS_LISTW = 40 * MiB;
constexpr size_t WS_TILE = 43 * MiB;
constexpr size_t WS_RA = 44 * MiB;
constexpr size_t WS_RW = 188 * MiB;
constexpr size_t WS_GA = 572 * MiB;
constexpr size_t WS_GM = 700 * MiB;
constexpr size_t WS_Q = 828 * MiB;
constexpr size_t WS_MO = 892 * MiB;
constexpr size_t WS_H = 956 * MiB;
constexpr size_t WS_NEED = 1084 * MiB;
constexpr size_t DO_MQ = 0, DO_MK = 72 * MiB, DO_MV = 144 * MiB, DO_K = 216 * MiB, DO_V = 234 * MiB;
constexpr int CW_CNT = 0;
constexpr int CW_OFF = 256;
constexpr int CW_FILL = 1024;
constexpr int CW_BAR = 4096;
constexpr int RING_BYTES = 131072, LDSCTL_OFF = 143360  , LDS_BYTES = 147456;
constexpr int NWAVES = 8;
namespace eng {
constexpr int BM = 256, BK = 64, HALF = 128, HTB = HALF * BK * 2, STAGE_BYTES = 8 * HTB;
__host__ __device__ __forceinline__ int lds_byte(int r, int c) { const int st = (r >> 4) * 2 + (c >> 5), rr = r & 15, cc = c & 31, ob = rr * 64 + cc * 2; return st * 1024 + (ob ^ (((ob >> 9) & 1) << 5)); }
__host__ __device__ __forceinline__ void stage_rc(int b, int& R, int& C) { const int st = b / 1024, sb = b % 1024, swz = sb ^ (((sb >> 9) & 1) << 5); R = (st >> 1) * 16 + swz / 64; C = (st & 1) * 32 + (swz % 64) / 2; }
__host__ __device__ __forceinline__ int perm32(int rho) { const int n = rho >> 4, i = rho & 15; return 8 * (i >> 2) + 4 * n + (i & 3); }

struct UnitD { const char* A; const char* B; unsigned lda, ldb; int nt, type, r0, r1, r2, r3; };

typedef f32x4 Acc[2][2][4][2];

#ifndef PROBE_ENG
#define PROBE_ENG 0
#endif
#define EGT(k, WHICH) if (PROBE_ENG == (k) && egacc) { const unsigned long long _t = wall_clock64(); if (WHICH) *egacc += _t - egt0; else egt0 = _t; }
template <class Prog, int AUX_A>
__device__ __forceinline__ void gemm_stream(LAS unsigned char* lds, const Prog& P, unsigned long long* egacc = nullptr) {
    unsigned long long egt0 = 0;
    int tid = threadIdx.x; asm volatile("" : "+v"(tid));
    const int wid = __builtin_amdgcn_readfirstlane(tid >> 6), lane = tid & 63, wr = wid >> 2, wc = wid & 3, fr = lane & 15, fq = lane >> 4;
    int Rr[2], Cc[2], Rb[2];
#pragma unroll
    for (int i = 0; i < 2; ++i) { int R, C; stage_rc(tid * 16 + i * 8192, R, C); Rr[i] = R; Cc[i] = C * 2; Rb[i] = (R & ~31) + perm32(R & 31); }
    const size_t kstep = (size_t)(BK * 2);
    const unsigned ldsw = (unsigned)wid * 1024u;
    const int aoff = lds_byte(wr * 64 + fr, fq * 8), boff = lds_byte(wc * 32 + fr, fq * 8);
#define EG_SA(b, h) (((b) * 2 + (h)) * HTB)
#define EG_SB(b, h) ((4 + (b) * 2 + (h)) * HTB)
#define EG_STAGE_B(bufoff, gbase) do { _Pragma("unroll") for (int _i = 0; _i < 2; ++_i) \
        __builtin_amdgcn_global_load_lds((const unsigned*)((const char*)(gbase) + oB[_i]), (LAS unsigned*)(lds + (bufoff) + ldsw + _i * 8192), 16, 0, 0); } while (0)
#define EG_STAGE_A(bufoff, gbase, h) do { _Pragma("unroll") for (int _i = 0; _i < 2; ++_i) \
        __builtin_amdgcn_global_load_lds((const unsigned*)((const char*)(gbase) + oA[h][_i]), (LAS unsigned*)(lds + (bufoff) + ldsw + _i * 8192), 16, 0, AUX_A); } while (0)
#define EG_LDA(dst, b, h) do { _Pragma("unroll") for (int m = 0; m < 4; ++m) _Pragma("unroll") for (int k = 0; k < 2; ++k) dst[m][k] = *(const LAS bf16x8*)(lds + EG_SA(b, h) + aoff + m * 2048 + k * 1024); } while (0)
#define EG_LDB(dst, b, h) do { _Pragma("unroll") for (int n = 0; n < 2; ++n) _Pragma("unroll") for (int k = 0; k < 2; ++k) dst[n][k] = *(const LAS bf16x8*)(lds + EG_SB(b, h) + boff + n * 2048 + k * 1024); } while (0)
#define EG_MMA(ai, bj, At, Bt) do { __builtin_amdgcn_s_setprio(1); _Pragma("unroll") for (int m = 0; m < 4; ++m) _Pragma("unroll") for (int n = 0; n < 2; ++n) _Pragma("unroll") for (int k = 0; k < 2; ++k) \
        acc[ai][bj][m][n] = __builtin_amdgcn_mfma_f32_16x16x32_bf16(Bt[n][k], At[m][k], acc[ai][bj][m][n], 0, 0, 0); __builtin_amdgcn_s_setprio(0); } while (0)
#define EG_WAIT_V(n) asm volatile("s_waitcnt vmcnt(" #n ")" ::: "memory")
#define EG_WAIT_L(n) asm volatile("s_waitcnt lgkmcnt(" #n ")" ::: "memory")
#define EG_BAR __builtin_amdgcn_s_barrier()
#define EG_SCHED __builtin_amdgcn_sched_barrier(0)
    UnitD cur, nxt; int ui = 0;
    if (!P.next(0, cur, lds)) return;
#ifdef ENG_STAGGER
    { const unsigned long long t0s = wall_clock64(), dl = (unsigned long long)(blockIdx.x & 3) * ENG_STAGGER; while (wall_clock64() - t0s < dl) __builtin_amdgcn_s_sleep(4); }
#endif
    Acc acc;
#pragma unroll
    for (int a = 0; a < 2; ++a)
#pragma unroll
        for (int b = 0; b < 2; ++b)
#pragma unroll
            for (int m = 0; m < 4; ++m)
#pragma unroll
                for (int n = 0; n < 2; ++n) acc[a][b][m][n] = (f32x4){0.f, 0.f, 0.f, 0.f};
    bf16x8 At[4][2], B0[2][2], B1[2][2];
    unsigned oA[2][2], oB[2];
    P.first(cur, lds);
    P.offsets(cur, Rr, Cc, oA, lds);
#pragma unroll
    for (int i = 0; i < 2; ++i) oB[i] = (unsigned)Rb[i] * cur.ldb + (unsigned)Cc[i];
    const char* cA = cur.A; const char* cB = cur.B; size_t hB = (size_t)HALF * cur.ldb;
    EG_STAGE_B(EG_SB(0, 0), cB); EG_STAGE_B(EG_SB(0, 1), cB + hB); EG_STAGE_A(EG_SA(0, 0), cA, 0); EG_STAGE_A(EG_SA(0, 1), cA, 1);
    if (wr == 1) EG_BAR;
    EG_WAIT_V(2); EG_BAR;
    EG_STAGE_B(EG_SB(1, 0), cB + kstep); EG_STAGE_A(EG_SA(1, 0), cA + kstep, 0); EG_STAGE_B(EG_SB(1, 1), cB + hB + kstep);
    EG_WAIT_V(6); EG_BAR;
    for (;;) {
        const bool has_next = P.next(ui + 1, nxt, lds);
        if (has_next) P.prefetch(nxt, lds);
        const int nt = cur.nt;
        EGT(1, 0)
        for (int t = 0; t < nt; t += 2) {
            const bool last = (t == nt - 2);
            EG_LDB(B0, 0, 0); EG_LDB(B1, 0, 1); EG_SCHED; EG_LDA(At, 0, 0); EG_STAGE_A(EG_SA(1, 1), cA + (size_t)(t + 1) * kstep, 1);
            EG_WAIT_V(8); EG_WAIT_L(0); EG_BAR; EG_MMA(0, 0, At, B0); EG_MMA(0, 1, At, B1); EG_BAR; EG_SCHED;
            const char *a2, *b2;
            if (last) {
                if (has_next) {
                    P.offsets(nxt, Rr, Cc, oA, lds);
#pragma unroll
                    for (int i = 0; i < 2; ++i) oB[i] = (unsigned)Rb[i] * nxt.ldb + (unsigned)Cc[i];
                    cA = nxt.A; cB = nxt.B; hB = (size_t)HALF * nxt.ldb;
                }
                a2 = cA; b2 = cB;
            } else { a2 = cA + (size_t)(t + 2) * kstep; b2 = cB + (size_t)(t + 2) * kstep; }
            const char* a3 = a2 + kstep; const char* b3 = b2 + kstep;
            EG_LDA(At, 0, 1); EG_STAGE_B(EG_SB(0, 0), b2); EG_STAGE_B(EG_SB(0, 1), b2 + hB); EG_STAGE_A(EG_SA(0, 0), a2, 0);
            EG_WAIT_V(8); EG_WAIT_L(0); EG_BAR; EG_MMA(1, 0, At, B0); EG_MMA(1, 1, At, B1); EG_BAR; EG_SCHED;
            EG_LDB(B0, 1, 0); EG_LDB(B1, 1, 1); EG_SCHED; EG_LDA(At, 1, 0); EG_STAGE_A(EG_SA(0, 1), a2, 1);
            EG_WAIT_V(8); EG_WAIT_L(0); EG_BAR; EG_MMA(0, 0, At, B0); EG_MMA(0, 1, At, B1); EG_BAR; EG_SCHED;
            EG_LDA(At, 1, 1); EG_STAGE_B(EG_SB(1, 0), b3); EG_STAGE_B(EG_SB(1, 1), b3 + hB); EG_STAGE_A(EG_SA(1, 0), a3, 0);
            EG_WAIT_V(8); EG_WAIT_L(0); EG_BAR; EG_MMA(1, 0, At, B0); EG_MMA(1, 1, At, B1); EG_BAR; EG_SCHED;
        }
        EGT(1, 1) EGT(2, 0)
#ifndef ENG_NOALIGN
        if (wr == 0) EG_BAR;
#endif
        P.epilogue(acc, cur, wr, wc, fr, fq, lds);
        EGT(2, 1)
        if (!has_next) break;
#pragma unroll
        for (int a = 0; a < 2; ++a)
#pragma unroll
            for (int b = 0; b < 2; ++b)
#pragma unroll
                for (int m = 0; m < 4; ++m)
#pragma unroll
                    for (int n = 0; n < 2; ++n) acc[a][b][m][n] = (f32x4){0.f, 0.f, 0.f, 0.f};
        cur = nxt; ++ui;
#ifndef ENG_NOALIGN
        if (wr == 1) EG_BAR;
#endif
    }
    EG_WAIT_V(0);
#ifdef ENG_NOALIGN
    if (wr == 0) EG_BAR;
#endif
    EG_BAR;
#undef EG_SA
#undef EG_SB
#undef EG_STAGE_A
#undef EG_STAGE_B
#undef EG_LDA
#undef EG_LDB
#undef EG_MMA
#undef EG_WAIT_V
#undef EG_WAIT_L
#undef EG_BAR
#undef EG_SCHED
}
template <int ACT  >
__device__ __forceinline__ void store_tile_bf16(const Acc& acc, bf16* dst, size_t ld) {
#pragma unroll
    for (int ai = 0; ai < 2; ++ai)
#pragma unroll
        for (int m = 0; m < 4; ++m) { bf16* rowp = dst + (size_t)(ai * HALF + m * 16) * ld;
#pragma unroll
            for (int bj = 0; bj < 2; ++bj) { f32x4 v0 = acc[ai][bj][m][0], v1 = acc[ai][bj][m][1];
                if (ACT == 1) {
#pragma unroll
                    for (int e = 0; e < 4; ++e) { v0[e] = sigmoidf_(v0[e]); v1[e] = sigmoidf_(v1[e]); } }
                u32x4 w; w.x = cvt_pk_bf16(v0[0], v0[1]); w.y = cvt_pk_bf16(v0[2], v0[3]); w.z = cvt_pk_bf16(v1[0], v1[1]); w.w = cvt_pk_bf16(v1[2], v1[3]);
                *(u32x4*)(rowp + bj * HALF) = w; } }
}
}
#define RLX_AGENT __ATOMIC_RELAXED, __HIP_MEMORY_SCOPE_AGENT
#define LDS_WAIT() asm volatile("s_waitcnt lgkmcnt(0)" ::: "memory")
#define VM_WAIT() asm volatile("s_waitcnt vmcnt(0)" ::: "memory")
#define XB_TMO      128
#define XB_XCNT(j)  (256  + 64 * (j))
#define XB_XSUB(j)  (1280 + 64 * (j))
#define XB_XGEN(j)  (2304 + 64 * (j))
#define XB_TOP      3328
#define XB_TOPGEN   3392
#define XCD_BAR_WORDS 3456
#define XB_SPIN_CAP (1u << 18)

__device__ __forceinline__ unsigned xb_ld(unsigned* p)              { return __hip_atomic_load(p, __ATOMIC_RELAXED, __HIP_MEMORY_SCOPE_AGENT); }
__device__ __forceinline__ unsigned xb_add(unsigned* p, unsigned v) { return __hip_atomic_fetch_add(p, v, __ATOMIC_RELAXED, __HIP_MEMORY_SCOPE_AGENT); }
__device__ __forceinline__ unsigned xb_xcc_id() { return (unsigned)__builtin_amdgcn_s_getreg((3 << 11) | 20) & 0xFu; }
#define XB_SPIN(cond, bar) do { unsigned _sp = 0; while (cond) { __builtin_amdgcn_s_sleep(1); \
    if ((++_sp & 255u) == 0u) { if (xb_ld(&(bar)[XB_TMO])) break; if (_sp > XB_SPIN_CAP) { atomicAdd(&(bar)[XB_TMO], 1u); break; } } } } while (0)

struct XcdBarrier {
    unsigned* bar; unsigned x;
    volatile LAS unsigned* st;
};

__device__ __forceinline__ XcdBarrier xcd_barrier_post(unsigned* bar, volatile LAS unsigned* st) {
    XcdBarrier b; b.bar = bar; b.x = xb_xcc_id(); b.st = st;
    if (threadIdx.x == 0) (void)xb_add(&bar[XB_XCNT(b.x)], 1u);
    return b;
}
__device__ __forceinline__ void xcd_barrier_complete(unsigned* bar, unsigned x, unsigned& nloc, unsigned& nx) {
    const unsigned G = gridDim.x * gridDim.y * gridDim.z;
    unsigned sum, cnt, mine, sp = 0u;
    for (;;) {
        sum = 0u; cnt = 0u; mine = 0u;
#pragma unroll
        for (unsigned j = 0; j < 16; ++j) { const unsigned c = xb_ld(&bar[XB_XCNT(j)]); sum += c; cnt += (c > 0u) ? 1u : 0u; mine = (j == x) ? c : mine; }
        if (sum == G) break;
        __builtin_amdgcn_s_sleep(1);
        if ((++sp & 255u) == 0u) { if (xb_ld(&bar[XB_TMO])) break; if (sp > XB_SPIN_CAP) { atomicAdd(&bar[XB_TMO], 1u); break; } }
    }
    nloc = mine > 0u ? mine : 1u; nx = cnt > 0u ? cnt : 1u;
}

__device__ __forceinline__ void xcd_barrier(const XcdBarrier& b) {
    asm volatile("s_waitcnt vmcnt(0)" ::: "memory");
    __syncthreads();
    if (threadIdx.x == 0) {
        unsigned* bar = b.bar;
        __builtin_amdgcn_s_waitcnt(0);
        unsigned nloc = b.st[0], nx = b.st[1];
        if (nloc == 0u) { xcd_barrier_complete(bar, b.x, nloc, nx); b.st[0] = nloc; b.st[1] = nx; }
        const unsigned old = xb_add(&bar[XB_XSUB(b.x)], 1u);
        const unsigned gen = old / nloc;
        if (old + 1u == (gen + 1u) * nloc) {
            __builtin_amdgcn_fence(__ATOMIC_RELEASE, "agent");
            asm volatile("s_waitcnt vmcnt(0)" ::: "memory");
            const unsigned og = xb_add(&bar[XB_TOP], 1u);
            const unsigned tg = og / nx;
            if (og + 1u == (tg + 1u) * nx) xb_add(&bar[XB_TOPGEN], 1u);
            else XB_SPIN(xb_ld(&bar[XB_TOPGEN]) == tg, bar);
            __builtin_amdgcn_fence(__ATOMIC_ACQUIRE, "agent");
            xb_add(&bar[XB_XGEN(b.x)], 1u);
            asm volatile("s_waitcnt vmcnt(0)" ::: "memory");
        } else {
            XB_SPIN(xb_ld(&bar[XB_XGEN(b.x)]) == gen, bar);
            __builtin_amdgcn_fence(__ATOMIC_ACQUIRE, "agent");
            asm volatile("s_waitcnt vmcnt(0)" ::: "memory");
        }
    }
    __syncthreads();
}

struct Args { const float* in[29]; float* out; unsigned char* ws; int ph_lo, ph_hi; };
struct Frame {
    LAS unsigned char* lds; unsigned char* ldsg;
    int vcu, G;
    unsigned char* ws; unsigned char* dout; unsigned long long* egacc;
};
__device__ __forceinline__ int sigma_in(int np) {
    if (np < 768) { const int p = np & 255, bj = p >> 7, wc = (p >> 5) & 3, j = p & 31;
        if (np < 512) return C_Q + (4 * (np >> 8) + wc) * 64 + (j >> 4) * 32 + bj * 16 + (j & 15);
        if (wc < 2) return C_K + wc * 64 + (j >> 4) * 32 + bj * 16 + (j & 15);
        return C_V + (wc - 2) * 64 + bj * 32 + j; }
    if (np >= N1) return C_MI + ((np - N1) & 15);
    return np < 2816 ? np : np + 16;
}
__device__ __forceinline__ void transpose_item(const float* W, size_t ldw, int k0, int scol, bf16* WT, size_t ldt, int n0, LAS float* scr, int lane) {
#pragma unroll 8
    for (int i = 0; i < 32; ++i) { const int kk = 2 * i + (lane >> 5); scr[kk * 33 + (lane & 31)] = W[(size_t)(k0 + kk) * ldw + scol]; }
    LDS_WAIT(); asm volatile("" ::: "memory");
    const int c = lane & 7;
#pragma unroll
    for (int j = 0; j < 4; ++j) { const int n = (lane >> 3) + 8 * j; const LAS float* s = scr + (8 * c) * 33 + n;
        u32x4 o; o.x = cvt_pk_bf16(s[0 * 33], s[1 * 33]); o.y = cvt_pk_bf16(s[2 * 33], s[3 * 33]); o.z = cvt_pk_bf16(s[4 * 33], s[5 * 33]); o.w = cvt_pk_bf16(s[6 * 33], s[7 * 33]);
        *(u32x4*)(WT + (size_t)(n0 + n) * ldt + k0 + 8 * c) = o; }
    LDS_WAIT(); asm volatile("" ::: "memory");
}
__device__ __forceinline__ void transpose_job(const float* W, size_t ldw, int Kr, int Nd, int scol0, bf16* WT, size_t ldt, int drow0, LAS float* scr, int lane, int gw, int NGW, int& start) {
    const int nnb = Nd / 32, nit = (Kr / 64) * nnb;
    const int first = (gw - start % NGW + NGW) % NGW; start += nit;
    for (int it = first; it < nit; it += NGW) { const int kb = it / nnb, nb = it % nnb; transpose_item(W, ldw, 64 * kb, scol0 + 32 * nb + (lane & 31), WT, ldt, drow0 + 32 * nb, scr, lane); }
}
__device__ __forceinline__ void p0_prologue(Frame& F, const Args& a) {
    int tid_ = threadIdx.x; asm volatile("" : "+v"(tid_)); const int lane_ = tid_ & 63, wave_ = __builtin_amdgcn_readfirstlane(tid_ >> 6);
    LAS float* scr = (LAS float*)(F.lds + wave_ * 16384);
    const int gw = F.vcu * NWAVES + wave_, NGW = F.G * NWAVES, lane = lane_;
    { const float* w_in = a.in[10]; bf16* BT1 = (bf16*)(F.ws + WS_BT1);
      constexpr int NR = N1 + 32, NIT = (D / 64) * (NR / 32);
      for (int i = F.vcu * 512 + tid_; i < 224 * D / 8; i += F.G * 512) ((u32x4*)(BT1 + (size_t)NR * D))[i] = (u32x4){0u, 0u, 0u, 0u};
      for (int it = gw; it < NIT; it += NGW) { const int kb = it / (NR / 32), nb = it % (NR / 32); transpose_item(w_in, INW, 64 * kb, sigma_in(32 * nb + (lane & 31)), BT1, D, 32 * nb, scr, lane); } }
    int jstart = (D / 64) * ((N1 + 32) / 32);
    transpose_job(a.in[18], D, 512, D, 0, (bf16*)(F.ws + WS_WAT), 512, 0, scr, lane, gw, NGW, jstart);
    transpose_job(a.in[19], D, 512, D, 0, (bf16*)(F.ws + WS_WMT), 512, 0, scr, lane, gw, NGW, jstart);
    transpose_job(a.in[20], D, D, D, 0, (bf16*)(F.ws + WS_WOT), D, 0, scr, lane, gw, NGW, jstart);
    transpose_job(a.in[21], NE, D, NE, 0, (bf16*)(F.ws + WS_WRT), D, 0, scr, lane, gw, NGW, jstart);
    for (int n = 0; n < 2; ++n) {
        transpose_job(a.in[26], EFF, D, 128, 128 * n, (bf16*)(F.ws + WS_WSGU), D, 256 * n, scr, lane, gw, NGW, jstart);
        transpose_job(a.in[27], EFF, D, 128, 128 * n, (bf16*)(F.ws + WS_WSGU), D, 256 * n + 128, scr, lane, gw, NGW, jstart); }
    transpose_job(a.in[28], D, EFF, D, 0, (bf16*)(F.ws + WS_WSD), EFF, 0, scr, lane, gw, NGW, jstart);
    { float* rc = (float*)(F.ws + WS_ROPE); float* rsn = rc + 1024;
      for (int i = F.vcu * 512 + tid_; i < 1024; i += F.G * 512) { const int pos = i >> 4, f = i & 15; const float inv = exp2f(-(float)f * (13.287712379549449f / 16.f)); const float ang = (float)pos * inv; rc[i] = cosf(ang); rsn[i] = sinf(ang); } }
    __syncthreads();
    { const float* c = a.in[1]; const float* c_ctx = a.in[3]; const float* w_ada = a.in[4]; const float* b_ada = a.in[5]; float* mod = (float*)(F.ws + WS_MOD);
      LAS float* sC = (LAS float*)F.lds;
      for (int i = tid_; i < 33 * 1024; i += 512) { const int r = i >> 10, k = i & 1023; const float v = r < NB ? c[i] : c_ctx[k]; sC[r * 1028 + k] = siluf_(v); }
      __syncthreads();
      for (int cb = F.vcu; cb < (NMOD * D) / 32; cb += F.G) {
          const int col = cb * 32 + (tid_ & 31), ks = tid_ >> 5;
          float acc[33];
#pragma unroll
          for (int r = 0; r < 33; ++r) acc[r] = 0.f;
          for (int k4 = 0; k4 < 16; ++k4) { const int k = ks * 64 + 4 * k4; float w[4];
#pragma unroll
              for (int i = 0; i < 4; ++i) w[i] = w_ada[(size_t)(k + i) * (NMOD * D) + col];
#pragma unroll
              for (int r = 0; r < 33; ++r) { const f32x4 s4 = *(const LAS f32x4*)(sC + r * 1028 + k); acc[r] += (s4[0] * w[0] + s4[1] * w[1]) + (s4[2] * w[2] + s4[3] * w[3]); } }
          __syncthreads();
          LAS float* red = (LAS float*)F.lds;
#pragma unroll
          for (int r = 0; r < 33; ++r) red[(ks * 33 + r) * 32 + (tid_ & 31)] = acc[r];
          __syncthreads();
          for (int o = tid_; o < 33 * 32; o += 512) { const int r = o >> 5, cc = o & 31; float s = 0.f;
#pragma unroll
              for (int q = 0; q < 16; ++q) s += red[(q * 33 + r) * 32 + cc];
              mod[(size_t)r * (NMOD * D) + cb * 32 + cc] = s + b_ada[cb * 32 + cc]; }
          __syncthreads();
          if (cb + F.G < (NMOD * D) / 32) { for (int i = tid_; i < 33 * 1024; i += 512) { const int r = i >> 10, k = i & 1023; const float v = r < NB ? c[i] : c_ctx[k]; sC[r * 1028 + k] = siluf_(v); } __syncthreads(); }
      }
      __syncthreads(); }
}
__device__ __forceinline__ void p1_norm_gates(Frame& F, const Args& a) {
    int tid_ = threadIdx.x; asm volatile("" : "+v"(tid_)); const int lane = tid_ & 63, wave_ = __builtin_amdgcn_readfirstlane(tid_ >> 6);
    const float* x = a.in[0]; const float* ctx = a.in[2]; const f32x4* g4 = (const f32x4*)a.in[6];
    const float* mod = (const float*)(F.ws + WS_MOD); bf16* A1 = (bf16*)(F.ws + WS_RA);
    const int NGW = F.G * NWAVES;
#pragma unroll 1
    for (int part = 0; part < 2; ++part) {
        const int NR = part ? TC : T, SEG = part ? CL : S, RPW = part ? 4 : 32;
        for (int gw = F.vcu * NWAVES + wave_; gw * RPW < NR; gw += NGW) {
            const int row0 = gw * RPW; const f32x4* mr = (const f32x4*)(mod + (size_t)(part ? NB : row0 / SEG) * (NMOD * D));
            f32x4 cs[4], ch[4];
#pragma unroll
            for (int j = 0; j < 4; ++j) { const int i4 = 64 * j + lane; cs[j] = g4[i4] * (mr[256 + i4] + 1.f); ch[j] = mr[i4]; }
            for (int row = row0; row < row0 + RPW && row < NR; ++row) {
                const f32x4* xr = (const f32x4*)((part ? ctx : x) + (size_t)row * D);
                f32x4 v[4]; float ss = 0.f;
#pragma unroll
                for (int j = 0; j < 4; ++j) { v[j] = __builtin_nontemporal_load(xr + 64 * j + lane); ss += (v[j][0] * v[j][0] + v[j][1] * v[j][1]) + (v[j][2] * v[j][2] + v[j][3] * v[j][3]); }
                const float rs = rsqrtf(wave_sum(ss) * (1.f / D) + EPS);
                u32x2* o8 = (u32x2*)(A1 + (size_t)(part ? T + row : row) * D);
#pragma unroll
                for (int j = 0; j < 4; ++j) { const f32x4 o = v[j] * rs * cs[j] + ch[j]; u32x2 w; w.x = cvt_pk_bf16(o[0], o[1]); w.y = cvt_pk_bf16(o[2], o[3]); o8[64 * j + lane] = w; }
            }
        }
    }
    __syncthreads();
}
#ifndef WGM2
#define WGM2 4
#endif
constexpr float QSCALE = 0.125f * 1.4426950408889634f;
struct ProgInProj {
    const char* A1; const char* BT1; int G, c;
    bf16 *Q, *K, *V, *MQ, *MO, *GA; float* GATES; const LAS float* tab;
    __device__ __forceinline__ bool next(int i, eng::UnitD& u, LAS unsigned char*) const {
        const long L = (long)i * G + c; if (L >= 5376) return false;
        int pm, pn;
        if (L < 5120) { int wgid = (int)L; { const int q = 5120 / 8, xcd = wgid % 8, off = wgid / 8; wgid = xcd * q + off; }
            const int nig = WGM2 * 20, gid = wgid / nig, fm = gid * WGM2; pm = fm + ((wgid % nig) % WGM2); pn = (wgid % nig) / WGM2; }
        else { const int j = (int)L - 5120; pm = 256 + (j & 31); pn = 2 + (j >> 5); if (pn == 9) pn = 19; }
        u.A = A1 + (size_t)pm * (256 * 2048); u.B = BT1 + (size_t)pn * (256 * 2048); u.lda = 2048; u.ldb = 2048; u.nt = 16; u.type = 0; u.r0 = pm; u.r1 = pn; u.r2 = 0; u.r3 = 0; return true;
    }
    __device__ __forceinline__ void first(const eng::UnitD&, LAS unsigned char*) const {}
    __device__ __forceinline__ void prefetch(const eng::UnitD&, LAS unsigned char*) const {}
    __device__ __forceinline__ void offsets(const eng::UnitD& u, const int (&Rr)[2], const int (&Cc)[2], unsigned (&oA)[2][2], LAS unsigned char*) const {
#pragma unroll
        for (int h = 0; h < 2; ++h)
#pragma unroll
            for (int i = 0; i < 2; ++i) oA[h][i] = (unsigned)(128 * h + Rr[i]) * u.lda + (unsigned)Cc[i];
    }
    template <bool ROPE>
    __device__ __forceinline__ void qk_epi(const eng::Acc& acc, bf16* dst  , size_t ld, const LAS float* gain, float scale, int pm, int wr, int fr, int fq) const {
        const LAS float* rope = tab;
        f32x4 gv[2][2];
#pragma unroll
        for (int bj = 0; bj < 2; ++bj)
#pragma unroll
            for (int n = 0; n < 2; ++n) gv[bj][n] = *(const LAS f32x4*)(gain + (fq >> 1) * 32 + bj * 16 + 8 * (fq & 1) + 4 * n);
#pragma unroll
        for (int ai = 0; ai < 2; ++ai)
#pragma unroll
            for (int m = 0; m < 4; ++m) {
                float ss = 0.f;
#pragma unroll
                for (int bj = 0; bj < 2; ++bj)
#pragma unroll
                    for (int n = 0; n < 2; ++n) { const f32x4 v = acc[ai][bj][m][n]; ss += (v[0] * v[0] + v[1] * v[1]) + (v[2] * v[2] + v[3] * v[3]); }
                ss += __shfl_xor(ss, 16); ss += __shfl_xor(ss, 32);
                const float rs = rsqrtf(ss * (1.f / HD) + EPS) * scale;
                f32x4 o1[2], o2[2];
#pragma unroll
                for (int n = 0; n < 2; ++n) { const f32x4 x1 = acc[ai][0][m][n] * rs * gv[0][n], x2 = acc[ai][1][m][n] * rs * gv[1][n];
                    if (ROPE) { const int pos = (fq >> 1) ? (16 * m + fr) : ((4 * pm + 2 * ai + wr) & 31);
                        const f32x4 cs = *(const LAS f32x4*)(rope + pos * 16 + 8 * (fq & 1) + 4 * n), sn = *(const LAS f32x4*)(rope + 1024 + pos * 16 + 8 * (fq & 1) + 4 * n);
                        o1[n] = x1 * cs - x2 * sn; o2[n] = x2 * cs + x1 * sn; }
                    else { o1[n] = x1; o2[n] = x2; } }
                bf16* rowp = dst + (size_t)(ai * 128 + m * 16) * ld;
                u32x4 w; w.x = cvt_pk_bf16(o1[0][0], o1[0][1]); w.y = cvt_pk_bf16(o1[0][2], o1[0][3]); w.z = cvt_pk_bf16(o1[1][0], o1[1][1]); w.w = cvt_pk_bf16(o1[1][2], o1[1][3]);
                *(u32x4*)(rowp) = w;
                w.x = cvt_pk_bf16(o2[0][0], o2[0][1]); w.y = cvt_pk_bf16(o2[0][2], o2[0][3]); w.z = cvt_pk_bf16(o2[1][0], o2[1][1]); w.w = cvt_pk_bf16(o2[1][2], o2[1][3]);
                *(u32x4*)(rowp + 32) = w;
            }
    }
    __device__ __forceinline__ void v_epi(const eng::Acc& acc, bf16* dst, size_t ld) const {
#pragma unroll
        for (int ai = 0; ai < 2; ++ai)
#pragma unroll
            for (int m = 0; m < 4; ++m) { bf16* rowp = dst + (size_t)(ai * 128 + m * 16) * ld;
#pragma unroll
                for (int bj = 0; bj < 2; ++bj) { const f32x4 v0 = acc[ai][bj][m][0], v1 = acc[ai][bj][m][1];
                    u32x4 w; w.x = cvt_pk_bf16(v0[0], v0[1]); w.y = cvt_pk_bf16(v0[2], v0[3]); w.z = cvt_pk_bf16(v1[0], v1[1]); w.w = cvt_pk_bf16(v1[2], v1[3]);
                    *(u32x4*)(rowp + bj * 32) = w; } }
    }
    __device__ __forceinline__ void epilogue(eng::Acc& acc, const eng::UnitD& u, int wr, int wc, int fr, int fq, LAS unsigned char*) const {
        const int pm = u.r0, pn = u.r1; const bool lat = pm < 256;
        const int lrow = wr * 64 + fr;
        const size_t r0 = (size_t)pm * 256;
        const size_t sr0 = lat ? r0 + (size_t)(pm / 8 + 1) * CL : (size_t)(pm - 256) * SL;
        if (pn < 2) { qk_epi<true>(acc, Q + (r0 + lrow) * AW + (4 * pn + wc) * 64 + 8 * fq, AW, tab + 2048, QSCALE, pm, wr, fr, fq); }
        else if (pn == 2) {
            if (wc < 2) { bf16* d = K + (sr0 + lrow) * KVW + wc * 64 + 8 * fq; if (lat) qk_epi<true>(acc, d, KVW, tab + 2112, 1.f, pm, wr, fr, fq); else qk_epi<false>(acc, d, KVW, tab + 2112, 1.f, pm, wr, fr, fq); }
            else v_epi(acc, V + (sr0 + lrow) * KVW + (wc - 2) * 64 + 8 * fq, KVW);
        }
        else if (pn < 9) { bf16* base = MQ + (size_t)((pn - 3) >> 1) * ((size_t)TA * MW); const int ct = ((pn - 3) & 1) * 256;
            eng::store_tile_bf16<0>(acc, base + (sr0 + lrow) * MW + ct + wc * 32 + 8 * fq, MW); }
        else if (pn < 11) eng::store_tile_bf16<0>(acc, MO + (r0 + lrow) * MW + (pn - 9) * 256 + wc * 32 + 8 * fq, MW);
        else if (pn == 19) {
            if (wc == 0 && fq < 2) { const f32x4 b0 = *(const LAS f32x4*)(tab + 2176 + 8 * fq), b1 = *(const LAS f32x4*)(tab + 2176 + 8 * fq + 4);
#pragma unroll
                for (int ai = 0; ai < 2; ++ai)
#pragma unroll
                    for (int m = 0; m < 4; ++m) { f32x4 v0 = acc[ai][0][m][0] + b0, v1 = acc[ai][0][m][1] + b1;
                        if (fq == 1) {
#pragma unroll
                            for (int e = 0; e < 4; ++e) { v0[e] = fminf(v0[e], 0.f) - log1pf(__expf(-fabsf(v0[e]))); v1[e] = fminf(v1[e], 0.f) - log1pf(__expf(-fabsf(v1[e]))); } }
                        float* gp = GATES + (sr0 + lrow + ai * 128 + m * 16) * 16 + 8 * fq; *(f32x4*)gp = v0; *(f32x4*)(gp + 4) = v1; } } }
        else { bf16* base = GA + (size_t)((pn - 11) >> 2) * ((size_t)T * D);
            eng::store_tile_bf16<1>(acc, base + (r0 + lrow) * D + ((pn - 11) & 3) * 256 + wc * 32 + 8 * fq, D); }
    }
};
#include <hip/hip_bf16.h>
#include <cmath>
namespace attn_body {
using bf16=__hip_bfloat16;
using bf16x8=__attribute__((ext_vector_type(8)))short;
using s16x4=__attribute__((ext_vector_type(4)))short;
using f32x16=__attribute__((ext_vector_type(16)))float;
using u32x4=__attribute__((ext_vector_type(4)))unsigned;
constexpr int BATCH=32,NHEAD=8,SEQ=2048,SKV=2304,D=64,QP=512,KP=128,OP=1024;
constexpr int NW=8,QBLK=32,QB=QBLK*NW,KVBLK=64,NQB=SEQ/QB;
constexpr int ATTN_UNIT_ROWS=QB;
__device__ __forceinline__ int crow(int r,int hi){return (r&3)+8*(r>>2)+4*hi;}
#define SBAR() __builtin_amdgcn_sched_barrier(0)
__device__ __forceinline__ void cmask(f32x16&p0,f32x16&p1,int jb,int qrel,int hi){
  const float NEG=-INFINITY; int kb=64*jb+4*hi;
  #pragma unroll
  for(int r=0;r<16;++r){int kv=kb+(r&3)+8*(r>>2); if(kv>qrel)p0[r]=NEG; if(kv+32>qrel)p1[r]=NEG;}
}

constexpr int NSLOT=3, SLOTB=8192;
constexpr int LDS_K=0, LDS_V=NSLOT*SLOTB, LDS_WS=2*NSLOT*SLOTB, LDS_OST=LDS_WS+NW*64*4, LDS_BYTES=LDS_OST+NW*4096;
constexpr float C2=0.125f*1.4426950408889634f;
__device__ __forceinline__ void glds16(const void*gsrc,unsigned lds_dst){unsigned keep;
  asm volatile("s_mov_b32 %0, m0\n\ts_mov_b32 m0, %2\n\ts_nop 0\n\tglobal_load_lds_dwordx4 %1, off\n\ts_mov_b32 m0, %0":"=&s"(keep):"v"(gsrc),"s"(lds_dst):"memory");}
__device__ __forceinline__ float max3f(float a,float b,float c){float r;asm("v_max3_f32 %0, %1, %2, %3":"=v"(r):"v"(a),"v"(b),"v"(c));return r;}
__device__ __forceinline__ float max2f(float a,float b){float r;asm("v_max_f32_e32 %0, %1, %2":"=v"(r):"v"(a),"v"(b));return r;}
__device__ __forceinline__ float fadd_s(float a,float b){float r;asm("v_add_f32_e32 %0, %1, %2":"=v"(r):"v"(a),"v"(b));return r;}
__device__ __forceinline__ float fsub_s(float a,float b){float r;asm("v_sub_f32_e32 %0, %1, %2":"=v"(r):"v"(a),"v"(b));return r;}
typedef float f32x2_t __attribute__((ext_vector_type(2))); typedef __bf16 bf16x2_t __attribute__((ext_vector_type(2)));
__device__ __forceinline__ unsigned cvtpk_s(float lo,float hi){f32x2_t v={lo,hi};bf16x2_t b=__builtin_convertvector(v,bf16x2_t);return __builtin_bit_cast(unsigned,b);}
#define WAIT_BAR(N) asm volatile("s_waitcnt vmcnt(" #N ") lgkmcnt(0)\n\ts_barrier":::"memory")

__device__ __forceinline__ void qkt(f32x16&p0,f32x16&p1,const char*Kslot,const bf16x8*qr,const f32x16&negm,int r32,int hi){
  const char*kb=Kslot+hi*1024+r32*16;
  #pragma unroll
  for(int d0=0;d0<4;++d0){
    const bf16x8 b0=*reinterpret_cast<const bf16x8*>(kb+d0*2048);
    const bf16x8 b1=*reinterpret_cast<const bf16x8*>(kb+d0*2048+512);
    if(d0==0){p0=__builtin_amdgcn_mfma_f32_32x32x16_bf16(b0,qr[0],negm,0,0,0);p1=__builtin_amdgcn_mfma_f32_32x32x16_bf16(b1,qr[0],negm,0,0,0);}
    else{p0=__builtin_amdgcn_mfma_f32_32x32x16_bf16(b0,qr[d0],p0,0,0,0);p1=__builtin_amdgcn_mfma_f32_32x32x16_bf16(b1,qr[d0],p1,0,0,0);}}
}
typedef __attribute__((address_space(3))) const char* lds_cptr;
typedef short v4i16_t __attribute__((ext_vector_type(4)));
__device__ __forceinline__ void kload8(bf16x8*kf,lds_cptr kp){
  kf[0]=*(const __attribute__((address_space(3))) bf16x8*)(kp);      kf[1]=*(const __attribute__((address_space(3))) bf16x8*)(kp+512);
  kf[2]=*(const __attribute__((address_space(3))) bf16x8*)(kp+2048); kf[3]=*(const __attribute__((address_space(3))) bf16x8*)(kp+2560);
  kf[4]=*(const __attribute__((address_space(3))) bf16x8*)(kp+4096); kf[5]=*(const __attribute__((address_space(3))) bf16x8*)(kp+4608);
  kf[6]=*(const __attribute__((address_space(3))) bf16x8*)(kp+6144); kf[7]=*(const __attribute__((address_space(3))) bf16x8*)(kp+6656);
}
__device__ __forceinline__ void kload2(bf16x8*kf,lds_cptr kp,int j){ kf[2*j]=*(const __attribute__((address_space(3))) bf16x8*)(kp+j*2048); kf[2*j+1]=*(const __attribute__((address_space(3))) bf16x8*)(kp+j*2048+512); }
__device__ __forceinline__ s16x4 vtr(lds_cptr p){ return __builtin_bit_cast(s16x4,__builtin_amdgcn_ds_read_tr16_b64_v4i16((__attribute__((address_space(3))) v4i16_t*)p)); }
__device__ __forceinline__ float rowmax(const f32x16&p0,const f32x16&p1){
  float a=max3f(p0[0],p0[1],p1[0]),b=max3f(p0[2],p0[3],p1[1]);a=max3f(a,p1[2],p1[3]);
  #pragma unroll
  for(int r=4;r<16;r+=4){a=max3f(a,p0[r],p0[r+1]);b=max3f(b,p0[r+2],p0[r+3]);a=max3f(a,p1[r],p1[r+1]);b=max3f(b,p1[r+2],p1[r+3]);}
  const float m=max2f(a,b);
  auto rr=__builtin_amdgcn_permlane32_swap(__float_as_uint(m),__float_as_uint(m),false,false);
  return max2f(__uint_as_float(rr[0]),__uint_as_float(rr[1]));
}
__device__ __forceinline__ void pv(f32x16*o,int vb,bf16x8 pa0,bf16x8 pa1,bf16x8 pa2,bf16x8 pa3){
  #pragma unroll
  for(int d0=0;d0<2;++d0){s16x4 lo[4],hi[4];
    #pragma unroll
    for(int ks=0;ks<4;++ks){
      asm volatile("ds_read_b64_tr_b16 %0,%1 offset:%c2":"=&v"(lo[ks]):"v"(vb),"i"(d0*4096+ks*1024):"memory");
      asm volatile("ds_read_b64_tr_b16 %0,%1 offset:%c2":"=&v"(hi[ks]):"v"(vb),"i"(d0*4096+ks*1024+512):"memory");}
    asm volatile("s_waitcnt lgkmcnt(0)":::"memory");SBAR();
    #define PK(k) (bf16x8){lo[k][0],lo[k][1],lo[k][2],lo[k][3],hi[k][0],hi[k][1],hi[k][2],hi[k][3]}
    o[d0]=__builtin_amdgcn_mfma_f32_32x32x16_bf16(pa0,PK(0),o[d0],0,0,0);
    o[d0]=__builtin_amdgcn_mfma_f32_32x32x16_bf16(pa1,PK(1),o[d0],0,0,0);
    o[d0]=__builtin_amdgcn_mfma_f32_32x32x16_bf16(pa2,PK(2),o[d0],0,0,0);
    o[d0]=__builtin_amdgcn_mfma_f32_32x32x16_bf16(pa3,PK(3),o[d0],0,0,0);
    #undef PK
  }
}

#ifndef ATTN_STORE16
#define ATTN_STORE16(p,v) (*(u32x4*)(p)=(v))
#endif
template<int THRL> __device__ __forceinline__ void attn_unit(int b,int h,int qb,const bf16*Q,const bf16*__restrict__ K,const bf16*__restrict__ V,bf16*O,char*shm){
  const int tid=threadIdx.x,lane=tid&63,r32=lane&31,hi=lane>>5; const int wid=__builtin_amdgcn_readfirstlane(tid>>6);
  const long rowbase=(long)b*SEQ, kvbase=(long)b*SKV; const int q0=qb*QB;
  const bf16*Qw=Q+(rowbase+q0+wid*QBLK)*QP+h*D;
  const bf16*Kh=K+kvbase*KP+(h>>2)*D,*Vh=V+kvbase*KP+(h>>2)*D;
  const unsigned lds0=(unsigned)(uintptr_t)shm;
  float*wsf=(float*)(shm+LDS_WS)+wid*64;
  const bf16*ksrc=Kh+(long)lane*KP+wid*8;
  const bf16*vsrc=Vh+(long)(16*(wid&3)+(lane>>2))*KP+(wid>>2)*32+(lane&3)*8;
  const unsigned kdst=lds0+LDS_K+wid*1024, vdst=lds0+LDS_V+wid*1024;
  #define DMA_K(t,slot) glds16(ksrc+(long)(t)*KVBLK*KP,(unsigned)__builtin_amdgcn_readfirstlane(kdst+(slot)))
  #define DMA_V(t,slot) glds16(vsrc+(long)(t)*KVBLK*KP,(unsigned)__builtin_amdgcn_readfirstlane(vdst+(slot)))
  const int vb0=(int)(lds0+LDS_V)+((lane>>4)&1)*32+(lane&3)*8+(4*hi+((lane&15)>>2))*64;
  const char*Kbase=shm+LDS_K; bf16x8 kf[8];
  const lds_cptr shm3=(lds_cptr)shm; const lds_cptr kp0=shm3+LDS_K+hi*1024+r32*16; const lds_cptr vp0=shm3+LDS_V+((lane>>4)&1)*32+(lane&3)*8+(4*hi+((lane&15)>>2))*64;
  const int NT=SKV/KVBLK;
  DMA_K(0,0);DMA_V(0,0);DMA_K(1,SLOTB);
  bf16x8 qr[4];
  #pragma unroll
  for(int d0=0;d0<4;++d0)qr[d0]=*reinterpret_cast<const bf16x8*>(&Qw[(long)r32*QP+d0*16+hi*8]);
  float mhat=0.f,l_reg=0.f;f32x16 o[2];o[0]=f32x16{};o[1]=f32x16{};f32x16 negm=f32x16{};asm volatile("":"+v"(negm));
  const int qrel=wid*QBLK+r32;
  #define CMASK(P0,P1,t) do{}while(0)
  bool resc=false;
  #define START(P0,P1) do{ const float rm=rowmax(P0,P1); resc=false; \
    { const float dl=rm; mhat=fadd_s(mhat,dl); \
      _Pragma("unroll") for(int r=0;r<16;++r){P0[r]=fsub_s(P0[r],dl);P1[r]=fsub_s(P1[r],dl);} \
      _Pragma("unroll") for(int r=0;r<16;++r)negm[r]=-mhat; asm volatile("":"+v"(negm)); } \
    _Pragma("unroll") for(int r=0;r<16;++r)P0[r]=__builtin_amdgcn_exp2f(P0[r]); }while(0)
  #define RESC() do{ if(resc){ asm volatile("s_waitcnt lgkmcnt(0)":::"memory"); \
      _Pragma("unroll") for(int d_=0;d_<2;++d_) _Pragma("unroll") for(int r=0;r<16;++r)o[d_][r]*=wsf[crow(r,hi)]; } }while(0)
  f32x16 pA0,pA1,pB0,pB1;
  int sl_prev=0,sl_cur=0,sl_next=SLOTB;
  #define ROT() do{sl_prev=sl_cur;sl_cur=sl_next;sl_next=(sl_next==(NSLOT-1)*SLOTB)?0:sl_next+SLOTB;}while(0)
  DMA_K(2,2*SLOTB);
  WAIT_BAR(3);
  qkt(pA0,pA1,Kbase,qr,negm,r32,hi);asm volatile("s_nop 15\n\ts_nop 7":"+v"(pA0),"+v"(pA1));CMASK(pA0,pA1,0);
  START(pA0,pA1);
  _Pragma("unroll") for(int r=0;r<16;++r)pA1[r]=__builtin_amdgcn_exp2f(pA1[r]);
  WAIT_BAR(0);
  DMA_K(3,0);DMA_V(1,SLOTB);
  ROT();
  kload8(kf,kp0+sl_cur);
  WAIT_BAR(2);
  s16x4 vlo[8],vhi[8]; u32x4 pw0,pw1,pw2,pw3;
  #define PKW(P,B) cvtpk_s(P[B],P[B+1])
  #define PAF(k) __builtin_bit_cast(bf16x8,pw##k)
  #define VFR(i) (bf16x8){vlo[i][0],vlo[i][1],vlo[i][2],vlo[i][3],vhi[i][0],vhi[i][1],vhi[i][2],vhi[i][3]}
  #define PIN(x) asm volatile("":"+v"(x))
  #define MX3(a,b,c) __builtin_fmaxf(__builtin_fmaxf((a),(b)),(c))
  #define GAPA(MF,A0,A1,A2,A3,W0,W1,PW) do{ MF; sacc+=A0; sacc+=A1; sacc+=A2; sacc+=A3; PIN(sacc); W0; W1; PIN(PW); SBAR(); }while(0)
  #define EX(v) __builtin_amdgcn_exp2f(v)
  #define GAPB(MF,X,B) do{ MF; X[B]=EX(X[B]); X[B+1]=EX(X[B+1]); X[B+2]=EX(X[B+2]); X[B+3]=EX(X[B+3]); PIN(X); SBAR(); }while(0)
  #define VRD(i) do{ vlo[i]=vtr(vp_+(((i)>>2)*4096+((i)&3)*1024)); vhi[i]=vtr(vp_+(((i)>>2)*4096+((i)&3)*1024+512)); }while(0)
  #define KRD(G,j) do{ if(G){ kload2(kf,kp0+sl_next,j); SBAR(); } }while(0)
  #define STEP(C0,C1,P0,P1,t,GK,GV,GL) do{ SBAR(); \
    const lds_cptr vp_=vp0+sl_prev; \
    VRD(0); SBAR(); float sacc=(P0[0]+P0[1]); \
    GAPA(C0=__builtin_amdgcn_mfma_f32_32x32x16_bf16(kf[0],qr[0],negm,0,0,0), P0[2],P0[3],P0[4],P0[5],     pw0[0]=PKW(P0,0), pw0[1]=PKW(P0,2), pw0); \
    VRD(4); SBAR(); GAPA(C1=__builtin_amdgcn_mfma_f32_32x32x16_bf16(kf[1],qr[0],negm,0,0,0), P0[6],P0[7],P0[8],P0[9],     pw0[2]=PKW(P0,4), pw0[3]=PKW(P0,6), pw0); \
    VRD(1); SBAR(); GAPA(C0=__builtin_amdgcn_mfma_f32_32x32x16_bf16(kf[2],qr[1],C0,0,0,0),   P0[10],P0[11],P0[12],P0[13], pw1[0]=PKW(P0,8), pw1[1]=PKW(P0,10), pw1); \
    VRD(5); SBAR(); GAPA(C1=__builtin_amdgcn_mfma_f32_32x32x16_bf16(kf[3],qr[1],C1,0,0,0),   P0[14],P0[15],P1[0],P1[1],   pw1[2]=PKW(P0,12),pw1[3]=PKW(P0,14), pw1); \
    VRD(2); SBAR(); GAPA(C0=__builtin_amdgcn_mfma_f32_32x32x16_bf16(kf[4],qr[2],C0,0,0,0),   P1[2],P1[3],P1[4],P1[5],     pw2[0]=PKW(P1,0), pw2[1]=PKW(P1,2), pw2); \
    VRD(6); SBAR(); GAPA(C1=__builtin_amdgcn_mfma_f32_32x32x16_bf16(kf[5],qr[2],C1,0,0,0),   P1[6],P1[7],P1[8],P1[9],     pw2[2]=PKW(P1,4), pw2[3]=PKW(P1,6), pw2); \
    VRD(3); SBAR(); GAPA(C0=__builtin_amdgcn_mfma_f32_32x32x16_bf16(kf[6],qr[3],C0,0,0,0),   P1[10],P1[11],P1[12],P1[13], pw3[0]=PKW(P1,8), pw3[1]=PKW(P1,10), pw3); \
    VRD(7); SBAR(); GAPA(C1=__builtin_amdgcn_mfma_f32_32x32x16_bf16(kf[7],qr[3],C1,0,0,0),   P1[14],P1[15],0.f,0.f,       pw3[2]=PKW(P1,12),pw3[3]=PKW(P1,14), pw3); \
    l_reg+=sacc; \
    if(GK){DMA_K((t)+3,sl_cur);} if(GV){DMA_V((t)+1,sl_next);} \
    CMASK(C0,C1,t); \
    { float a=MX3(C0[0],C0[1],C1[0]),b=MX3(C0[2],C0[3],C1[1]); a=MX3(a,C1[2],C1[3]); \
      _Pragma("unroll") for(int r=4;r<16;r+=4){a=MX3(a,C0[r],C0[r+1]);b=MX3(b,C0[r+2],C0[r+3]);a=MX3(a,C1[r],C1[r+1]);b=MX3(b,C1[r+2],C1[r+3]);} \
      float rm=__builtin_fmaxf(a,b); { auto rr=__builtin_amdgcn_permlane32_swap(__float_as_uint(rm),__float_as_uint(rm),false,false); rm=__builtin_fmaxf(__uint_as_float(rr[0]),__uint_as_float(rr[1])); } \
      resc=false; \
      if(__builtin_expect(__any(rm>(float)THRL),0)){ const float dl=__builtin_fmaxf(rm,0.f); mhat+=dl; \
        _Pragma("unroll") for(int r=0;r<16;++r){C0[r]-=dl;C1[r]-=dl;} \
        _Pragma("unroll") for(int r=0;r<16;++r)negm[r]=-mhat; asm volatile("":"+v"(negm)); \
        const float f=__builtin_amdgcn_exp2f(-dl); l_reg*=f; if(hi==0)wsf[r32]=f; resc=true; } } \
    SBAR(); \
    GAPB(o[0]=__builtin_amdgcn_mfma_f32_32x32x16_bf16(PAF(0),VFR(0),o[0],0,0,0), C0,0); \
    GAPB(o[1]=__builtin_amdgcn_mfma_f32_32x32x16_bf16(PAF(0),VFR(4),o[1],0,0,0), C0,4); \
    KRD(GL,0); GAPB(o[0]=__builtin_amdgcn_mfma_f32_32x32x16_bf16(PAF(1),VFR(1),o[0],0,0,0), C0,8); \
    KRD(GL,1); GAPB(o[1]=__builtin_amdgcn_mfma_f32_32x32x16_bf16(PAF(1),VFR(5),o[1],0,0,0), C0,12); \
    KRD(GL,2); GAPB(o[0]=__builtin_amdgcn_mfma_f32_32x32x16_bf16(PAF(2),VFR(2),o[0],0,0,0), C1,0); \
    KRD(GL,3); GAPB(o[1]=__builtin_amdgcn_mfma_f32_32x32x16_bf16(PAF(2),VFR(6),o[1],0,0,0), C1,4); \
    GAPB(o[0]=__builtin_amdgcn_mfma_f32_32x32x16_bf16(PAF(3),VFR(3),o[0],0,0,0), C1,8); \
    GAPB(o[1]=__builtin_amdgcn_mfma_f32_32x32x16_bf16(PAF(3),VFR(7),o[1],0,0,0), C1,12); \
    }while(0)
  int t=1;
  #undef CMASK
  #define CMASK(P0,P1,t) do{}while(0)
  for(;t+5<NT;t+=2){
    STEP(pB0,pB1,pA0,pA1,t,true,true,true);     WAIT_BAR(2); RESC(); ROT();
    STEP(pA0,pA1,pB0,pB1,t+1,true,true,true);   WAIT_BAR(2); RESC(); ROT();
  }
  #undef CMASK
  #define CMASK(P0,P1,t) do{}while(0)
  #define ENDW(tt) do{ if((tt)+3<NT){WAIT_BAR(2);} else if((tt)+2<NT){WAIT_BAR(1);} else {WAIT_BAR(0);} }while(0)
  for(;t+1<NT;t+=2){
    STEP(pB0,pB1,pA0,pA1,t,(t+3<NT),(t+1<NT),(t+1<NT));       ENDW(t);   RESC(); ROT();
    STEP(pA0,pA1,pB0,pB1,t+1,(t+4<NT),(t+2<NT),(t+2<NT));     ENDW(t+1); RESC(); ROT();
  }
  STEP(pB0,pB1,pA0,pA1,NT-1,false,false,false); RESC();
  { float sacc=pB0[0]+pB0[1]; _Pragma("unroll") for(int r=2;r<16;++r)sacc+=pB0[r]; _Pragma("unroll") for(int r=0;r<16;++r)sacc+=pB1[r]; l_reg+=sacc;
    pw0=(u32x4){PKW(pB0,0),PKW(pB0,2),PKW(pB0,4),PKW(pB0,6)};pw1=(u32x4){PKW(pB0,8),PKW(pB0,10),PKW(pB0,12),PKW(pB0,14)};pw2=(u32x4){PKW(pB1,0),PKW(pB1,2),PKW(pB1,4),PKW(pB1,6)};pw3=(u32x4){PKW(pB1,8),PKW(pB1,10),PKW(pB1,12),PKW(pB1,14)};
    SBAR(); pv(o,vb0+sl_cur,PAF(0),PAF(1),PAF(2),PAF(3)); }
  #undef PKW
  #undef PAF
  #undef VFR
  #undef PIN
  #undef MX3
  #undef GAPA
  #undef GAPB
  #undef EX
  #undef VRD
  #undef KRD
  #undef STEP
  #undef ENDW
  {auto rr=__builtin_amdgcn_permlane32_swap(__float_as_uint(l_reg),__float_as_uint(l_reg),false,false);l_reg=__uint_as_float(rr[0])+__uint_as_float(rr[1]);}
  if(hi==0)wsf[32+r32]=l_reg;asm volatile("s_waitcnt lgkmcnt(0)":::"memory");
  float rli[16];
  #pragma unroll
  for(int r=0;r<16;++r)rli[r]=__builtin_amdgcn_rcpf(wsf[32+crow(r,hi)]);
  bf16*Ow=O+(rowbase+q0+wid*QBLK)*OP+h*D;
  { bf16*stg=(bf16*)(shm+LDS_OST)+wid*2048;
    #pragma unroll
    for(int r=0;r<16;++r){const int orow=crow(r,hi);
      #pragma unroll
      for(int d0=0;d0<2;++d0)stg[orow*64+d0*32+r32]=__float2bfloat16(o[d0][r]*rli[r]);}
    asm volatile("s_waitcnt lgkmcnt(0)":::"memory");
    #pragma unroll
    for(int i=0;i<4;++i){const int row=i*8+(lane>>3),ch=lane&7; const u32x4 v=*(const u32x4*)(stg+row*64+ch*8); ATTN_STORE16(Ow+(long)row*OP+ch*8,v);} }
  asm volatile("s_waitcnt lgkmcnt(0)\n\ts_barrier":::"memory");
  #undef DMA_K
  #undef DMA_V
  #undef CMASK
  #undef START
  #undef RESC
  #undef ROT
}
constexpr int ATTN_LDS_BYTES=LDS_BYTES;
struct AttnTensors { const bf16* Q; const bf16* K; const bf16* V; bf16* O; };
struct AttnUnit { int b; int h; int qb; };
struct StaticOrder {
  int vcu, G;
  __device__ __forceinline__ StaticOrder(int grid,int v):vcu(v),G(grid){}
  __device__ __forceinline__ bool next(int i,AttnUnit&u)const{ const int L=(i>>3)*G+vcu; if(L>=256)return false; u.b=L>>3; u.qb=L&7; u.h=i&7; return true; }
};
template<class Sched,int THRL=8> __device__ __forceinline__ void attn_phase(char*lds,const AttnTensors&T,const Sched&S){
  AttnUnit u;
  for(int i=0;S.next(i,u);++i){ attn_unit<THRL>(u.b,u.h,u.qb,T.Q,T.K,T.V,T.O,lds); }
}
#undef SBAR
#undef WAIT_BAR
}
#ifndef PROBE_ML
#define PROBE_ML 0
#endif
namespace ml {
#define MLT(k, WHICH) if (PROBE_ML == (k)) { const unsigned long long _t = wall_clock64(); if (WHICH) mlacc += _t - mlt0; else mlt0 = _t; }
#define MLBAR() asm volatile("s_waitcnt lgkmcnt(0)\n\ts_barrier" ::: "memory")
constexpr int PQ = 272, PT = 144;
constexpr int O_Q = 0, O_K = O_Q + 64 * PQ, O_KTW = O_K + 64 * PQ, O_VT = O_KTW + 128 * PT, O_P = O_VT + 144 * PT, O_CB = O_P + 64 * PT, O_GT = O_CB + 144 * PQ, O_CW = O_GT + 2 * 1280, O_END = O_CW + 4096;
static_assert(O_END <= LDSCTL_OFF, "mlstm LDS map");
struct Raw { u32x4 q[3][2], k[3][2], v[2]; float li, lf; };
template <int CTRL> __device__ __forceinline__ float dpp_or(float v, float ident) { return __uint_as_float((unsigned)__builtin_amdgcn_update_dpp((int)__float_as_uint(ident), (int)__float_as_uint(v), CTRL, 0xF, 0xF, false)); }
template <int CTRL, int ROWMASK> __device__ __forceinline__ float dpp_bc(float v, float ident) { return __uint_as_float((unsigned)__builtin_amdgcn_update_dpp((int)__float_as_uint(ident), (int)__float_as_uint(v), CTRL, ROWMASK, 0xF, false)); }
__device__ __forceinline__ float bflo(unsigned w) { return __uint_as_float(w << 16); }
__device__ __forceinline__ float bfhi(unsigned w) { return __uint_as_float(w & 0xffff0000u); }
__device__ __forceinline__ int chunk_pos(int c, int r, int dir) { return dir == 0 ? 64 * c + r : (c < 4 ? 255 - 64 * c - r : 2303 - 64 * (c - 4) - r); }
__device__ __forceinline__ void load_chunk(Raw& R, int c, int lane, int w, int b, int head, int dir, const bf16* MQ, const bf16* MK, const bf16* MV, const float* GATES) {
    const int pos = chunk_pos(c, 8 * w + (lane >> 3), dir); const int lo = pos < CL ? 0 : CL, hi = pos < CL ? CL : SL;
    const size_t sr = (size_t)b * SL + pos; const size_t co = (size_t)head * MD + 16 * (lane & 7);
    const u32x4 z = {0u, 0u, 0u, 0u};
#pragma unroll
    for (int j = 0; j < 3; ++j) { const int pp = pos + j - 1; const bool ok = pp >= lo && pp < hi; const size_t o = (sr + j - 1) * MW + co;
        R.q[j][0] = ok ? *(const u32x4*)(MQ + o) : z; R.q[j][1] = ok ? *(const u32x4*)(MQ + o + 8) : z;
        R.k[j][0] = ok ? *(const u32x4*)(MK + o) : z; R.k[j][1] = ok ? *(const u32x4*)(MK + o + 8) : z; }
    R.v[0] = *(const u32x4*)(MV + sr * MW + co); R.v[1] = *(const u32x4*)(MV + sr * MW + co + 8);
    const size_t srg = (size_t)b * SL + chunk_pos(c, lane, dir);
    R.li = GATES[srg * 16 + dir * 4 + head]; R.lf = GATES[srg * 16 + 8 + dir * 4 + head];
}
constexpr int CV_K = 32, CVA_PER_E = 8 * (D / CV_K), CVA_ITEMS = NE * CVA_PER_E, CVB_PER_E = 16 * (EFF / CV_K), CVB_ITEMS = NE * CVB_PER_E;
struct CvItem { const float* src; bf16* dst; unsigned sld; };
__device__ __forceinline__ CvItem cv_decode_gu(int it, int lane, const float* w_eg, const float* w_eu, bf16* WGU) {
    const int e = it / CVA_PER_E, r = it % CVA_PER_E; CvItem c;
    const int rb = r / (D / CV_K), kb = r % (D / CV_K), p0 = (64 * rb) & 255, up = p0 >> 7, col0 = 128 * (rb >> 2) + (p0 & 127);
    c.src = (up ? w_eu : w_eg) + (size_t)e * D * EFF + (size_t)(CV_K * kb) * EFF + col0 + lane; c.sld = EFF;
    c.dst = WGU + (size_t)e * 512 * D + (size_t)(64 * rb + lane) * D + CV_K * kb;
    return c;
}
__device__ __forceinline__ CvItem cv_decode_dn(int it, int lane, const float* w_ed, bf16* WD) {
    const int e = it / CVB_PER_E, q = it % CVB_PER_E, rb = q / (EFF / CV_K), kb = q % (EFF / CV_K); CvItem c;
    const int cs = 64 * rb + lane, drow = (cs & ~255) + 128 * ((cs >> 3) & 1) + 32 * ((cs >> 6) & 3) + 8 * ((cs >> 4) & 3) + (cs & 7);
    c.src = w_ed + (size_t)e * EFF * D + (size_t)(CV_K * kb) * D + cs; c.sld = D;
    c.dst = WD + (size_t)e * D * EFF + (size_t)drow * EFF + CV_K * kb;
    return c;
}
__device__ __forceinline__ void cv_load(float (&v)[CV_K], const CvItem& c) {
#pragma unroll
    for (int i = 0; i < CV_K; ++i) v[i] = c.src[(size_t)i * c.sld];
}
__device__ __forceinline__ void cv_store(const float (&v)[CV_K], const CvItem& c) {
#pragma unroll
    for (int g = 0; g < CV_K / 8; ++g) { u32x4 o; o.x = cvt_pk_bf16_s(v[8 * g], v[8 * g + 1]); o.y = cvt_pk_bf16_s(v[8 * g + 2], v[8 * g + 3]); o.z = cvt_pk_bf16_s(v[8 * g + 4], v[8 * g + 5]); o.w = cvt_pk_bf16_s(v[8 * g + 6], v[8 * g + 7]);
        *(u32x4*)(c.dst + 8 * g) = o; }
}
__device__ __forceinline__ void mlstm_phase(Frame& F, const Args& a, unsigned long long& mlacc) {
    unsigned long long mlt0 = 0;
    int tid = threadIdx.x; asm volatile("" : "+v"(tid));
    const int lane = tid & 63, w = __builtin_amdgcn_readfirstlane(tid >> 6), l15 = lane & 15, l4 = lane >> 4;
    LAS unsigned char* L = F.lds;
    const bf16* MQ = (const bf16*)(F.dout + DO_MQ); const bf16* MK = (const bf16*)(F.dout + DO_MK); const bf16* MV = (const bf16*)(F.dout + DO_MV);
    const float* GATES = (const float*)(F.ws + WS_GATES); bf16* H = (bf16*)(F.ws + WS_H);
    const float* conv_w = a.in[13]; const float* conv_b = a.in[14];
    LAS float* CW = (LAS float*)(L + O_CW);
    const float* w_eg = a.in[23]; const float* w_eu = a.in[24]; const float* w_ed = a.in[25]; bf16* WGU = (bf16*)(F.ws + WS_RW); bf16* WD = (bf16*)(F.ws + WS_RW + 256 * MiB);
    int cv_it = F.vcu * NWAVES + w; const int cv_stride = F.G * NWAVES;
    for (int seq = F.vcu; seq < NB * MH * 2; seq += F.G) {
        const int b = seq >> 3, head = (seq >> 1) & 3, dir = seq & 1;
        __syncthreads();
        for (int i = tid; i < 1024; i += 512) { const int part = i >> 7, d = i & 127, kq = part >> 2, j = part & 3, ch = kq * 512 + head * MD + d; CW[i] = j < 3 ? conv_w[j * 1024 + ch] : conv_b[ch]; }
        for (int i = tid; i < 144 * PQ / 4; i += 512) ((LAS unsigned*)(L + O_CB))[i] = 0u;
        for (int i = tid; i < 16 * PT / 4; i += 512) ((LAS unsigned*)(L + O_VT + 128 * PT))[i] = (i < PT / 4) ? 0x3F803F80u : 0u;
        f32x4 accC[9];
#pragma unroll
        for (int i = 0; i < 9; ++i) accC[i] = (f32x4){0.f, 0.f, 0.f, 0.f};
        float m = 0.f;
        Raw R; load_chunk(R, 0, lane, w, b, head, dir, MQ, MK, MV, GATES);
        __syncthreads();
        for (int c = 0; c < SL / 64; ++c) {
            LAS float* GT = (LAS float*)(L + O_GT + (c & 1) * 1280);
            MLT(1, 0) MLT(5, 0)
            float bcs = R.lf;
            bcs += dpp_or<0x111>(bcs, 0.f); bcs += dpp_or<0x112>(bcs, 0.f); bcs += dpp_or<0x114>(bcs, 0.f); bcs += dpp_or<0x118>(bcs, 0.f);
            bcs += dpp_bc<0x142, 0xA>(bcs, 0.f); bcs += dpp_bc<0x143, 0xC>(bcs, 0.f);
            const float u = R.li - bcs; float pm = u;
            pm = fmaxf(pm, dpp_or<0x111>(pm, -INFINITY)); pm = fmaxf(pm, dpp_or<0x112>(pm, -INFINITY)); pm = fmaxf(pm, dpp_or<0x114>(pm, -INFINITY)); pm = fmaxf(pm, dpp_or<0x118>(pm, -INFINITY));
            pm = fmaxf(pm, dpp_bc<0x142, 0xA>(pm, -INFINITY)); pm = fmaxf(pm, dpp_bc<0x143, 0xC>(pm, -INFINITY));
            const float mq = fmaxf(bcs + m, bcs + pm);
            const float bL = __shfl(bcs, 63), umax = __shfl(pm, 63);
            const float m_new = fmaxf(bL + m, bL + umax), wsv = __expf(bL + u - m_new), w_old = __expf(bL + m - m_new);
            if (w == 0) { GT[lane] = bcs - mq; GT[64 + lane] = u; GT[128 + lane] = __expf(bcs + m - mq); GT[192 + lane] = __expf(-mq); }
            {
                const int rr = lane >> 3, dc = lane & 7, rowl = 8 * w + rr; const float wsr = __shfl(wsv, rowl);
                { float qv[16];
#pragma unroll
                  for (int g = 0; g < 4; ++g) { f32x4 wq[4];
#pragma unroll
                      for (int j = 0; j < 4; ++j) wq[j] = *(const LAS f32x4*)(CW + j * 128 + 16 * dc + 4 * g);
#pragma unroll
                      for (int e = 0; e < 4; ++e) { const int i = 4 * g + e, hv = i >> 3, wd = (i & 7) >> 1; float xq[3];
#pragma unroll
                          for (int j = 0; j < 3; ++j) { const unsigned uq = R.q[j][hv][wd]; xq[j] = (i & 1) ? bfhi(uq) : bflo(uq); }
                          qv[i] = siluf_(wq[0][e] * xq[0] + wq[1][e] * xq[1] + wq[2][e] * xq[2] + wq[3][e]) * 0.08838834764831845f; } }
                  u32x4 p0, p1;
                  p0.x = cvt_pk_bf16(qv[0], qv[1]); p0.y = cvt_pk_bf16(qv[2], qv[3]); p0.z = cvt_pk_bf16(qv[4], qv[5]); p0.w = cvt_pk_bf16(qv[6], qv[7]);
                  p1.x = cvt_pk_bf16(qv[8], qv[9]); p1.y = cvt_pk_bf16(qv[10], qv[11]); p1.z = cvt_pk_bf16(qv[12], qv[13]); p1.w = cvt_pk_bf16(qv[14], qv[15]);
                  *(LAS u32x4*)(L + O_Q + rowl * PQ + dc * 32) = p0; *(LAS u32x4*)(L + O_Q + rowl * PQ + dc * 32 + 16) = p1; }
                { float kv[16];
#pragma unroll
                  for (int g = 0; g < 4; ++g) { f32x4 wk[4];
#pragma unroll
                      for (int j = 0; j < 4; ++j) wk[j] = *(const LAS f32x4*)(CW + 512 + j * 128 + 16 * dc + 4 * g);
#pragma unroll
                      for (int e = 0; e < 4; ++e) { const int i = 4 * g + e, hv = i >> 3, wd = (i & 7) >> 1; float xk[3];
#pragma unroll
                          for (int j = 0; j < 3; ++j) { const unsigned uk = R.k[j][hv][wd]; xk[j] = (i & 1) ? bfhi(uk) : bflo(uk); }
                          kv[i] = siluf_(wk[0][e] * xk[0] + wk[1][e] * xk[1] + wk[2][e] * xk[2] + wk[3][e]); } }
                  u32x4 p0, p1;
                  p0.x = cvt_pk_bf16(kv[0], kv[1]); p0.y = cvt_pk_bf16(kv[2], kv[3]); p0.z = cvt_pk_bf16(kv[4], kv[5]); p0.w = cvt_pk_bf16(kv[6], kv[7]);
                  p1.x = cvt_pk_bf16(kv[8], kv[9]); p1.y = cvt_pk_bf16(kv[10], kv[11]); p1.z = cvt_pk_bf16(kv[12], kv[13]); p1.w = cvt_pk_bf16(kv[14], kv[15]);
                  *(LAS u32x4*)(L + O_K + rowl * PQ + dc * 32) = p0; *(LAS u32x4*)(L + O_K + rowl * PQ + dc * 32 + 16) = p1;
#pragma unroll
                  for (int i = 0; i < 16; ++i) {
                      *(LAS bf16*)(L + O_KTW + (16 * dc + i) * PT + ((w ^ dc) * 16) + rr * 2) = f2bf(kv[i] * wsr);
                      const unsigned uv = R.v[i >> 3][(i & 7) >> 1]; *(LAS bf16*)(L + O_VT + (16 * dc + i) * PT + ((w ^ dc) * 16) + rr * 2) = (bf16)((i & 1) ? (uv >> 16) : (uv & 0xffffu)); } }
            }
            if (c + 1 < SL / 64) load_chunk(R, c + 1, lane, w, b, head, dir, MQ, MK, MV, GATES);
            MLT(5, 1)
            MLBAR();
            MLT(1, 1) MLT(2, 0)
            const bool outp = c >= 4;
            const int nb = w & 3, mb0 = (w >> 2) * 4, nmb = 4 + (w >> 2);
            f32x4 nacc[5];
#pragma unroll
            for (int i = 0; i < 5; ++i) nacc[i] = (f32x4){0.f, 0.f, 0.f, 0.f};
            if (outp) {
                bf16x8 qf[4];
#pragma unroll
                for (int ks = 0; ks < 4; ++ks) qf[ks] = *(const LAS bf16x8*)(L + O_Q + (16 * nb + l15) * PQ + (32 * ks + 8 * l4) * 2);
                const float bmj = GT[16 * nb + l15];
#pragma unroll
                for (int mi = 0; mi < 2; ++mi) { const int mb = 2 * (w >> 2) + mi; f32x4 sacc = {0.f, 0.f, 0.f, 0.f};
#pragma unroll
                    for (int ks = 0; ks < 4; ++ks) { const bf16x8 kf = *(const LAS bf16x8*)(L + O_K + (16 * mb + l15) * PQ + (32 * ks + 8 * l4) * 2); sacc = __builtin_amdgcn_mfma_f32_16x16x32_bf16(kf, qf[ks], sacc, 0, 0, 0); }
                    const f32x4 uu = *(const LAS f32x4*)(GT + 64 + 16 * mb + 4 * l4); float pv[4];
#pragma unroll
                    for (int r = 0; r < 4; ++r) { const int s = 16 * mb + 4 * l4 + r, j = 16 * nb + l15; pv[r] = (s <= j) ? sacc[r] * __expf(bmj + uu[r]) : 0.f; }
                    u32x2 pk; pk.x = cvt_pk_bf16_s(pv[0], pv[1]); pk.y = cvt_pk_bf16_s(pv[2], pv[3]);
                    *(LAS u32x2*)(L + O_P + (16 * nb + l15) * PT + (16 * mb + 4 * l4) * 2) = pk; }
                const float wij = GT[128 + 16 * nb + l15];
#pragma unroll
                for (int i = 0; i < 5; ++i) if (i < nmb) { const int mb = mb0 + i;
#pragma unroll
                    for (int ks = 0; ks < 4; ++ks) { const bf16x8 cf = *(const LAS bf16x8*)(L + O_CB + (16 * mb + l15) * PQ + (32 * ks + 8 * l4) * 2); nacc[i] = __builtin_amdgcn_mfma_f32_16x16x32_bf16(cf, qf[ks], nacc[i], 0, 0, 0); }
                    nacc[i] = nacc[i] * wij; }
                MLBAR();
                bf16x8 pf[2];
#pragma unroll
                for (int ks = 0; ks < 2; ++ks) pf[ks] = *(const LAS bf16x8*)(L + O_P + (16 * nb + l15) * PT + (32 * ks + 8 * l4) * 2);
#pragma unroll
                for (int i = 0; i < 5; ++i) if (i < nmb) { const int mb = mb0 + i;
#pragma unroll
                    for (int ks = 0; ks < 2; ++ks) { const bf16x8 vf = *(const LAS bf16x8*)(L + O_VT + (16 * mb + l15) * PT + (((4 * ks + l4) ^ (mb & 7)) * 16)); nacc[i] = __builtin_amdgcn_mfma_f32_16x16x32_bf16(vf, pf[ks], nacc[i], 0, 0, 0); } }
                if (w >= 4 && l4 == 0) GT[256 + 16 * nb + l15] = nacc[4][0];
            }
            MLT(2, 1) MLT(3, 0)
            float cvv[CV_K]; const bool cv_on = cv_it < CVA_ITEMS;
            if (cv_on) { const CvItem cvi = cv_decode_gu(cv_it, lane, w_eg, w_eu, WGU); cv_load(cvv, cvi); }
            {
                bf16x8 kt[2];
#pragma unroll
                for (int ks = 0; ks < 2; ++ks) kt[ks] = *(const LAS bf16x8*)(L + O_KTW + (16 * w + l15) * PT + (((4 * ks + l4) ^ w) * 16));
#pragma unroll
                for (int n2 = 0; n2 < 9; ++n2) { accC[n2] = accC[n2] * w_old;
#pragma unroll
                    for (int ks = 0; ks < 2; ++ks) { const bf16x8 vf = *(const LAS bf16x8*)(L + O_VT + (16 * n2 + l15) * PT + (((4 * ks + l4) ^ (n2 & 7)) * 16)); accC[n2] = __builtin_amdgcn_mfma_f32_16x16x32_bf16(kt[ks], vf, accC[n2], 0, 0, 0); }
                    u32x2 pk; pk.x = cvt_pk_bf16_s(accC[n2][0], accC[n2][1]); pk.y = cvt_pk_bf16_s(accC[n2][2], accC[n2][3]);
                    *(LAS u32x2*)(L + O_CB + (16 * n2 + l15) * PQ + (16 * w + 4 * l4) * 2) = pk; }
            }
            MLBAR();
            MLT(3, 1) MLT(4, 0)
            if (outp) {
                const int j = 16 * nb + l15; const float den = GT[256 + j], emq = GT[192 + j]; const float inv = __builtin_amdgcn_rcpf(fmaxf(fabsf(den), emq));
                const int t = chunk_pos(c, j, dir) - CL;
                bf16* hp = H + ((size_t)dir * T + (size_t)b * S + t) * MW + head * MD + 4 * l4;
#pragma unroll
                for (int i = 0; i < 4; ++i) { const int mb = mb0 + i; const f32x4 hv = nacc[i] * inv;
                    u32x2 pk; pk.x = cvt_pk_bf16_s(hv[0], hv[1]); pk.y = cvt_pk_bf16_s(hv[2], hv[3]); *(u32x2*)(hp + 16 * mb) = pk; }
            }
            if (cv_on) { const CvItem cvi = cv_decode_gu(cv_it, lane, w_eg, w_eu, WGU); cv_store(cvv, cvi); cv_it += cv_stride; }
            MLT(4, 1)
            m = m_new;
        }
    }
    for (; cv_it < CVA_ITEMS; cv_it += cv_stride) { float cvv[CV_K]; const CvItem cvi = cv_decode_gu(cv_it, lane, w_eg, w_eu, WGU); cv_load(cvv, cvi); cv_store(cvv, cvi); }
    for (int it = F.vcu * NWAVES + w; it < CVB_ITEMS; it += 2 * cv_stride) {
        float va[CV_K], vb[CV_K]; const CvItem ca = cv_decode_dn(it, lane, w_ed, WD); cv_load(va, ca); const bool two = it + cv_stride < CVB_ITEMS;
        if (two) { const CvItem cb = cv_decode_dn(it + cv_stride, lane, w_ed, WD); cv_load(vb, cb); }
        cv_store(va, ca); if (two) { const CvItem cb = cv_decode_dn(it + cv_stride, lane, w_ed, WD); cv_store(vb, cb); } }
    __syncthreads();
}
__device__ __forceinline__ void mlstm_combine(Frame& F, const Args& a, int panel  ) {
    int tid = threadIdx.x; asm volatile("" : "+v"(tid));
    const int lane = tid & 63, wv = __builtin_amdgcn_readfirstlane(tid >> 6);
    const bf16* H = (const bf16*)(F.ws + WS_H); const bf16* MO = (const bf16*)(F.ws + WS_MO); bf16* AM = (bf16*)(F.ws + WS_RA); const float* g = a.in[17];
    const f32x4 g0 = *(const f32x4*)(g + 8 * lane), g1 = *(const f32x4*)(g + 8 * lane + 4);
    const int gw = F.vcu * NWAVES + wv, NGW = F.G * NWAVES;
    const int rbeg = panel >= 0 ? panel * 256 + wv * 32 : gw, rend = panel >= 0 ? rbeg + 32 : T, rstep = panel >= 0 ? 1 : NGW;
    for (int row = rbeg; row < rend; row += rstep) {
        const u32x4 hf = *(const u32x4*)(H + (size_t)row * MW + 8 * lane), hb = *(const u32x4*)(H + ((size_t)T + row) * MW + 8 * lane), mo = *(const u32x4*)(MO + (size_t)row * MW + 8 * lane);
        float v[8], s[8]; float ss = 0.f;
#pragma unroll
        for (int q = 0; q < 4; ++q) { v[2 * q] = bflo(hf[q]) + bflo(hb[q]); v[2 * q + 1] = bfhi(hf[q]) + bfhi(hb[q]); s[2 * q] = sigmoidf_(bflo(mo[q])); s[2 * q + 1] = sigmoidf_(bfhi(mo[q])); ss += v[2 * q] * v[2 * q] + v[2 * q + 1] * v[2 * q + 1]; }
        ss += __shfl_xor(ss, 1); ss += __shfl_xor(ss, 2); ss += __shfl_xor(ss, 4); ss += __shfl_xor(ss, 8);
        const float rs = rsqrtf(ss * (1.f / MD) + EPS);
        u32x4 o; o.x = cvt_pk_bf16(v[0] * rs * g0[0] * s[0], v[1] * rs * g0[1] * s[1]); o.y = cvt_pk_bf16(v[2] * rs * g0[2] * s[2], v[3] * rs * g0[3] * s[3]);
        o.z = cvt_pk_bf16(v[4] * rs * g1[0] * s[4], v[5] * rs * g1[1] * s[5]); o.w = cvt_pk_bf16(v[6] * rs * g1[2] * s[6], v[7] * rs * g1[3] * s[7]);
        *(u32x4*)(AM + (size_t)row * D + AW + 8 * lane) = o;
    }
}
}
__device__ __forceinline__ void tile_of(int L, int nN, int& pm, int& pn) {
    const int nwg = 256 * nN, q = nwg / 8; int wgid = (L % 8) * q + L / 8;
    const int nig = 8 * nN, gid = wgid / nig, fm = gid * 8; pm = fm + ((wgid % nig) % 8); pn = (wgid % nig) / 8;
}
struct ProgMerge {
    const char* AM; const char* WAT; const char* WMT; bf16* Y; const bf16* GA; int G, c, panel;
    __device__ __forceinline__ bool next(int i, eng::UnitD& u, LAS unsigned char*) const {
        int pm, pn; const int part = i & 1;
        if (panel >= 0) { if (i >= 8) return false; pm = panel; pn = i >> 1; }
        else { const long L = (long)(i >> 1) * G + c; if (L >= 1024) return false; tile_of((int)L, 4, pm, pn); }
        u.A = AM + (size_t)pm * (256 * 2048) + part * 1024; u.B = (part ? WMT : WAT) + (size_t)pn * (256 * 1024); u.lda = 2048; u.ldb = 1024; u.nt = 8; u.type = part; u.r0 = pm; u.r1 = pn; u.r2 = 0; u.r3 = 0; return true;
    }
    __device__ __forceinline__ void first(const eng::UnitD&, LAS unsigned char*) const {}
    __device__ __forceinline__ void prefetch(const eng::UnitD&, LAS unsigned char*) const {}
    __device__ __forceinline__ void offsets(const eng::UnitD& u, const int (&Rr)[2], const int (&Cc)[2], unsigned (&oA)[2][2], LAS unsigned char*) const {
#pragma unroll
        for (int h = 0; h < 2; ++h)
#pragma unroll
            for (int i = 0; i < 2; ++i) oA[h][i] = (unsigned)(128 * h + Rr[i]) * u.lda + (unsigned)Cc[i];
    }
    __device__ __forceinline__ void epilogue(eng::Acc& acc, const eng::UnitD& u, int wr, int wc, int fr, int fq, LAS unsigned char*) const {
        const size_t off0 = ((size_t)u.r0 * 256 + wr * 64 + fr) * D + u.r1 * 256 + wc * 32 + 8 * fq;
        if (u.type == 0) { eng::store_tile_bf16<0>(acc, Y + off0, D); return; }
        const bf16* GMp = GA + (size_t)T * D;
#pragma unroll
        for (int ai = 0; ai < 2; ++ai)
#pragma unroll
            for (int m = 0; m < 4; ++m) {
#pragma unroll
                for (int bj = 0; bj < 2; ++bj) { const size_t o = off0 + (size_t)(ai * 128 + m * 16) * D + bj * 128;
                    const u32x4 p1 = *(const u32x4*)(Y + o), ga = *(const u32x4*)(GA + o), gm = *(const u32x4*)(GMp + o);
                    u32x4 w;
#pragma unroll
                    for (int q = 0; q < 4; ++q) { const int n = q >> 1, e = (q & 1) * 2;
                        const float y0 = __uint_as_float(ga[q] << 16) * __uint_as_float(p1[q] << 16) + __uint_as_float(gm[q] << 16) * acc[ai][bj][m][n][e];
                        const float y1 = __uint_as_float(ga[q] & 0xffff0000u) * __uint_as_float(p1[q] & 0xffff0000u) + __uint_as_float(gm[q] & 0xffff0000u) * acc[ai][bj][m][n][e + 1];
                        w[q] = cvt_pk_bf16(y0, y1); }
                    *(u32x4*)(Y + o) = w; }
                asm volatile("" ::: "memory"); }
        __builtin_amdgcn_s_waitcnt(0x0F70);
    }
};
struct ProgOut {
    const char* Yb; const char* WOT; bf16* YO; float* RS1; int G, c, panel;
    __device__ __forceinline__ bool next(int i, eng::UnitD& u, LAS unsigned char*) const {
        int pm, pn;
        if (panel >= 0) { if (i >= 4) return false; pm = panel; pn = i; }
        else { const long L = (long)i * G + c; if (L >= 1024) return false; tile_of((int)L, 4, pm, pn); }
        u.A = Yb + (size_t)pm * (256 * 2048); u.B = WOT + (size_t)pn * (256 * 2048); u.lda = 2048; u.ldb = 2048; u.nt = 16; u.type = 0; u.r0 = pm; u.r1 = pn; u.r2 = 0; u.r3 = 0; return true;
    }
    __device__ __forceinline__ void first(const eng::UnitD&, LAS unsigned char*) const {}
    __device__ __forceinline__ void prefetch(const eng::UnitD&, LAS unsigned char*) const {}
    __device__ __forceinline__ void offsets(const eng::UnitD& u, const int (&Rr)[2], const int (&Cc)[2], unsigned (&oA)[2][2], LAS unsigned char*) const {
#pragma unroll
        for (int h = 0; h < 2; ++h)
#pragma unroll
            for (int i = 0; i < 2; ++i) oA[h][i] = (unsigned)(128 * h + Rr[i]) * u.lda + (unsigned)Cc[i];
    }
    __device__ __forceinline__ void epilogue(eng::Acc& acc, const eng::UnitD& u, int wr, int wc, int fr, int fq, LAS unsigned char*) const {
        const size_t row0 = (size_t)u.r0 * 256 + wr * 64 + fr;
        eng::store_tile_bf16<0>(acc, YO + row0 * D + u.r1 * 256 + wc * 32 + 8 * fq, D);
#pragma unroll
        for (int ai = 0; ai < 2; ++ai)
#pragma unroll
            for (int m = 0; m < 4; ++m) { float ss = 0.f;
#pragma unroll
                for (int bj = 0; bj < 2; ++bj)
#pragma unroll
                    for (int n = 0; n < 2; ++n) { const f32x4 v = acc[ai][bj][m][n]; ss += (v[0] * v[0] + v[1] * v[1]) + (v[2] * v[2] + v[3] * v[3]); }
                ss += __shfl_xor(ss, 16); ss += __shfl_xor(ss, 32);
                if (fq == 0) RS1[(row0 + ai * 128 + m * 16) * 16 + u.r1 * 4 + wc] = ss; }
    }
};
template <bool WRITE_X1>
__device__ __forceinline__ void p6_rowpass(Frame& F, const Args& a, int panel) {
    int tid_ = threadIdx.x; asm volatile("" : "+v"(tid_)); const int lane = tid_ & 63, wave_ = __builtin_amdgcn_readfirstlane(tid_ >> 6);
    const float* x = a.in[0]; const f32x4* gpost = (const f32x4*)a.in[7]; const f32x4* gpre = (const f32x4*)a.in[8];
    const float* mod = (const float*)(F.ws + WS_MOD); const bf16* YO = (const bf16*)(F.ws + WS_RA); const float* RS1 = (const float*)(F.ws + WS_RS1); bf16* FIN = (bf16*)(F.ws + WS_GA);
    const int NGW = F.G * NWAVES; constexpr int RPW = 32;
    for (int gw = (panel >= 0 ? panel : F.vcu) * NWAVES + wave_; gw * RPW < T; gw += (panel >= 0 ? T : NGW)) {
        const int row0 = gw * RPW; const f32x4* mr = (const f32x4*)(mod + (size_t)(row0 / S) * (NMOD * D));
        f32x4 cg[4], csc[4], csh[4];
#pragma unroll
        for (int j = 0; j < 4; ++j) { const int i4 = 64 * j + lane; cg[j] = mr[512 + i4] * gpost[i4]; csc[j] = gpre[i4] * (mr[1024 + i4] + 1.f); csh[j] = mr[768 + i4]; }
        for (int row = row0; row < row0 + RPW; ++row) {
            const f32x4* xr = (const f32x4*)(x + (size_t)row * D); const u32x2* yr = (const u32x2*)(YO + (size_t)row * D);
            float s1 = (lane < 16) ? RS1[(size_t)row * 16 + lane] : 0.f;
            s1 += __shfl_xor(s1, 1); s1 += __shfl_xor(s1, 2); s1 += __shfl_xor(s1, 4); s1 += __shfl_xor(s1, 8);
            const float rs1 = rsqrtf(__shfl(s1, 0) * (1.f / D) + EPS);
            f32x4 v[4]; float ss = 0.f;
#pragma unroll
            for (int j = 0; j < 4; ++j) { const int i4 = 64 * j + lane; const u32x2 yb = yr[i4]; const f32x4 xv = __builtin_nontemporal_load(xr + i4);
                f32x4 y; y[0] = __uint_as_float(yb.x << 16); y[1] = __uint_as_float(yb.x & 0xffff0000u); y[2] = __uint_as_float(yb.y << 16); y[3] = __uint_as_float(yb.y & 0xffff0000u);
                v[j] = xv + cg[j] * (y * rs1); ss += (v[j][0] * v[j][0] + v[j][1] * v[j][1]) + (v[j][2] * v[j][2] + v[j][3] * v[j][3]); }
            const float rs2 = rsqrtf(wave_sum(ss) * (1.f / D) + EPS);
            u32x2* o8 = (u32x2*)(FIN + (size_t)row * D);
#pragma unroll
            for (int j = 0; j < 4; ++j) { const int i4 = 64 * j + lane;
                if (WRITE_X1) ((f32x4*)(a.out + (size_t)row * D))[i4] = v[j];
                const f32x4 o = v[j] * rs2 * csc[j] + csh[j];
                u32x2 w; w.x = cvt_pk_bf16(o[0], o[1]); w.y = cvt_pk_bf16(o[2], o[3]); o8[i4] = w; }
        }
    }
}
constexpr int NCH = 1, TCH = T / NCH;
constexpr float EO_SCALE = 16.f;
constexpr size_t WS_SCORE = WS_GM;
constexpr size_t WS_WGU = WS_RW, WS_WD = WS_RW + 256 * MiB;
constexpr size_t WS_HIDS = WS_H, WS_HIDSH = WS_H + 64 * MiB;
constexpr size_t WS_EOHI = WS_GM;
constexpr int CW_CNT2 = 2048, CW_FILL2 = 2560;
constexpr int LIST_CAP = 589824;
constexpr int LDS_TOFF = RING_BYTES;
constexpr int LDS_IDX = RING_BYTES + 4096;
__device__ __forceinline__ unsigned char* eo_row(unsigned char* dout, unsigned char* ws, int k, size_t tok) { return k < 4 ? dout + tok * 4096 + (size_t)k * 1024 : ws + WS_EOHI + (size_t)(k & 3) * (64 * MiB) + tok * 1024; }

__device__ __forceinline__ void p0_expert_weights(Frame& F, const Args& a) {
    int tid_ = threadIdx.x; asm volatile("" : "+v"(tid_)); const int lane_ = tid_ & 63, wave_ = __builtin_amdgcn_readfirstlane(tid_ >> 6);
    LAS float* scr = (LAS float*)(F.lds + wave_ * 16384);
    const int gw = F.vcu * NWAVES + wave_, NGW = F.G * NWAVES, lane = lane_;
    const float* w_eg = a.in[23]; const float* w_eu = a.in[24]; const float* w_ed = a.in[25];
    bf16* WGU = (bf16*)(F.ws + WS_WGU); bf16* WD = (bf16*)(F.ws + WS_WD);
    for (int it = gw; it < NE * 384; it += NGW) {
        const int e = it / 384, r = it % 384;
        if (r < 256) { const int job = r >> 6, q = r & 63, kb = q >> 2, nb = q & 3, n = job >> 1, up = job & 1;
            transpose_item((up ? w_eu : w_eg) + (size_t)e * D * EFF, EFF, 64 * kb, 128 * n + 32 * nb + (lane & 31), WGU + (size_t)e * 512 * D, D, 256 * n + 128 * up + 32 * nb, scr, lane); }
        else { const int q = r - 256, kb = q >> 5, nb = q & 31;
            transpose_item(w_ed + (size_t)e * EFF * D, D, 64 * kb, 32 * nb + (lane & 31), WD + (size_t)e * D * EFF, EFF, 32 * nb, scr, lane); }
    }
}
struct ProgRouter {
    const char* FINb; const char* WRT; float* SCORE; int G, c, panel;
    __device__ __forceinline__ bool next(int i, eng::UnitD& u, LAS unsigned char*) const {
        const long L = panel >= 0 ? (i == 0 ? panel : 256) : (long)i * G + c; if (L >= 256) return false;
        u.A = FINb + (size_t)L * (256 * 2048); u.B = WRT; u.lda = 2048; u.ldb = 2048; u.nt = 16; u.type = 0; u.r0 = (int)L; u.r1 = 0; u.r2 = 0; u.r3 = 0; return true;
    }
    __device__ __forceinline__ void first(const eng::UnitD&, LAS unsigned char*) const {}
    __device__ __forceinline__ void prefetch(const eng::UnitD&, LAS unsigned char*) const {}
    __device__ __forceinline__ void offsets(const eng::UnitD& u, const int (&Rr)[2], const int (&Cc)[2], unsigned (&oA)[2][2], LAS unsigned char*) const {
#pragma unroll
        for (int h = 0; h < 2; ++h)
#pragma unroll
            for (int i = 0; i < 2; ++i) oA[h][i] = (unsigned)(128 * h + Rr[i]) * u.lda + (unsigned)Cc[i];
    }
    __device__ __forceinline__ void epilogue(eng::Acc& acc, const eng::UnitD& u, int wr, int wc, int fr, int fq, LAS unsigned char*) const {
        float* dst = SCORE + ((size_t)u.r0 * 256 + wr * 64 + fr) * NE + wc * 32 + 8 * fq;
#pragma unroll
        for (int ai = 0; ai < 2; ++ai)
#pragma unroll
            for (int m = 0; m < 4; ++m)
#pragma unroll
                for (int bj = 0; bj < 2; ++bj)
#pragma unroll
                    for (int n = 0; n < 2; ++n) *(f32x4*)(dst + (size_t)(ai * 128 + m * 16) * NE + bj * 128 + 4 * n) = acc[ai][bj][m][n];
    }
};
__device__ __forceinline__ unsigned okey(float f) { const unsigned b = __float_as_uint(f); return b ^ ((b >> 31) ? 0xFFFFFFFFu : 0x80000000u); }
template <int CTRL> __device__ __forceinline__ float dppf(float v) { return __uint_as_float((unsigned)__builtin_amdgcn_update_dpp(0, (int)__float_as_uint(v), CTRL, 0xF, 0xF, true)); }
__device__ __forceinline__ int below(unsigned long long m) { return (int)__builtin_amdgcn_mbcnt_hi((unsigned)(m >> 32), __builtin_amdgcn_mbcnt_lo((unsigned)m, 0u)); }
constexpr int TOK_BLOCKS = T / 256;
__device__ __forceinline__ void p_topk(Frame& F, const Args& a, int panel) {
    int tid_ = threadIdx.x; asm volatile("" : "+v"(tid_)); const int lane = tid_ & 63, wave_ = __builtin_amdgcn_readfirstlane(tid_ >> 6);
    const float* SCORE = (const float*)(F.ws + WS_SCORE);
    int* TOPI = (int*)(F.ws + WS_TOPI); float* TOPW = (float*)(F.ws + WS_TOPW); int* cnt = (int*)(F.ws + WS_CTL) + CW_CNT2;
    LAS int* hist = (LAS int*)F.lds; LAS float* wsel = (LAS float*)(F.lds + 2048) + wave_ * 8;
    const f32x4 bias = *(const f32x4*)(a.in[22] + 4 * lane);
    for (int blk = (panel >= 0 ? panel : F.vcu); blk < TOK_BLOCKS; blk += (panel >= 0 ? TOK_BLOCKS : F.G)) {
        __syncthreads();
        if (tid_ < NE) hist[tid_] = 0;
        __syncthreads();
        for (int it = 0; it < 32; ++it) {
            const int tok = blk * 256 + wave_ * 32 + it;
            const f32x4 x = *(const f32x4*)(SCORE + (size_t)tok * NE + 4 * lane);
            float sg[4], sv[4];
#pragma unroll
            for (int q = 0; q < 4; ++q) { sg[q] = sigmoidf_(x[q]); sv[q] = sg[q] + bias[q]; }
            float m1 = fmaxf(sv[0], sv[1]), m2 = fminf(sv[0], sv[1]);
            { const float t = sv[2]; const float n1 = fmaxf(m1, t); m2 = fmaxf(m2, fminf(m1, t)); m1 = n1; }
            { const float t = sv[3]; const float n1 = fmaxf(m1, t); m2 = fmaxf(m2, fminf(m1, t)); m1 = n1; }
            { const float o1 = dppf<0xB1>(m1), o2 = dppf<0xB1>(m2); const float n1 = fmaxf(m1, o1); m2 = fmaxf(fminf(m1, o1), fmaxf(m2, o2)); m1 = n1; }
            { const float o1 = dppf<0x4E>(m1), o2 = dppf<0x4E>(m2); const float n1 = fmaxf(m1, o1); m2 = fmaxf(fminf(m1, o1), fmaxf(m2, o2)); m1 = n1; }
            { const float o1 = dppf<0x141>(m1), o2 = dppf<0x141>(m2); const float n1 = fmaxf(m1, o1); m2 = fmaxf(fminf(m1, o1), fmaxf(m2, o2)); m1 = n1; }
            const float gs = m1 + m2;
            int rank = 0; const int myg = lane >> 3;
#pragma unroll
            for (int g = 0; g < NG; ++g) { const float og = __uint_as_float((unsigned)__builtin_amdgcn_readlane((int)__float_as_uint(gs), 8 * g)); rank += (og > gs || (og == gs && g < myg)) ? 1 : 0; }
            const bool gsel = rank < TKG;
            unsigned kq[4];
#pragma unroll
            for (int q = 0; q < 4; ++q) kq[q] = gsel ? okey(sv[q]) : 0u;
            unsigned thr = 0u;
            for (int b = 31; b >= 16; --b) { const unsigned cand = thr | (1u << b);
                const int n = __popcll(__ballot(kq[0] >= cand)) + __popcll(__ballot(kq[1] >= cand)) + __popcll(__ballot(kq[2] >= cand)) + __popcll(__ballot(kq[3] >= cand));
                thr = (n >= TOPK) ? cand : thr; }
            {
              const int n_ge = __popcll(__ballot(kq[0] >= thr)) + __popcll(__ballot(kq[1] >= thr)) + __popcll(__ballot(kq[2] >= thr)) + __popcll(__ballot(kq[3] >= thr));
              if (n_ge != TOPK) {
                for (int b = 15; b >= 0; --b) { const unsigned cand = thr | (1u << b);
                    const int n = __popcll(__ballot(kq[0] >= cand)) + __popcll(__ballot(kq[1] >= cand)) + __popcll(__ballot(kq[2] >= cand)) + __popcll(__ballot(kq[3] >= cand));
                    thr = (n >= TOPK) ? cand : thr; } } }
            int ngt = 0, eqb = 0, owneq = 0, selb = 0, ownsel = 0; bool sel[4];
            unsigned long long beq[4];
#pragma unroll
            for (int q = 0; q < 4; ++q) { ngt += __popcll(__ballot(kq[q] > thr)); beq[q] = __ballot(kq[q] == thr); eqb += below(beq[q]); }
            const int need = TOPK - ngt;
#pragma unroll
            for (int q = 0; q < 4; ++q) { const bool eq = kq[q] == thr; sel[q] = kq[q] > thr || (eq && (eqb + owneq) < need); owneq += eq ? 1 : 0; }
#pragma unroll
            for (int q = 0; q < 4; ++q) selb += below(__ballot(sel[q]));
#pragma unroll
            for (int q = 0; q < 4; ++q) if (sel[q]) { wsel[selb + ownsel] = sg[q]; ++ownsel; }
            asm volatile("s_waitcnt lgkmcnt(0)" ::: "memory");
            const f32x4 w0 = *(const LAS f32x4*)wsel, w1 = *(const LAS f32x4*)(wsel + 4);
            const float inv = RSCALE / (((w0[0] + w0[1]) + (w0[2] + w0[3])) + ((w1[0] + w1[1]) + (w1[2] + w1[3])));
            ownsel = 0;
#pragma unroll
            for (int q = 0; q < 4; ++q) if (sel[q]) { const int slot = selb + ownsel; ++ownsel; TOPI[tok * TOPK + slot] = 4 * lane + q; TOPW[tok * TOPK + slot] = sg[q] * inv; __hip_atomic_fetch_add(hist + 4 * lane + q, 1, __ATOMIC_RELAXED, __HIP_MEMORY_SCOPE_WORKGROUP); }
            asm volatile("s_waitcnt lgkmcnt(0)" ::: "memory");
        }
        __syncthreads();
        if (tid_ < NE) { const int n = hist[tid_]; if (n) __hip_atomic_fetch_add(cnt + ((blk * 256) / TCH) * NE + tid_, n, __ATOMIC_RELAXED, __HIP_MEMORY_SCOPE_AGENT); }
    }
    __syncthreads();
}
__device__ __forceinline__ void moe_tile_offsets(Frame& F) {
    int tid_ = threadIdx.x; asm volatile("" : "+v"(tid_)); const int lane_ = tid_ & 63, wave_ = __builtin_amdgcn_readfirstlane(tid_ >> 6);
    const int* cnt = (const int*)(F.ws + WS_CTL) + CW_CNT2; LAS int* toff = (LAS int*)(F.lds + LDS_TOFF); LAS int* wtot = toff + NCH * 257;
    const int c = tid_ >> 8, e = tid_ & 255;
    const int v = tid_ < NCH * NE ? (__hip_atomic_load(cnt + tid_, __ATOMIC_RELAXED, __HIP_MEMORY_SCOPE_AGENT) + 255) >> 8 : 0; int inc = v;
#pragma unroll
    for (int o = 1; o < 64; o <<= 1) { const int t = __shfl_up(inc, o); inc += (lane_ >= o) ? t : 0; }
    if (lane_ == 63) wtot[wave_] = inc;
    __syncthreads();
    int base = 0;
#pragma unroll
    for (int q = 0; q < 3; ++q) base += (q < (wave_ & 3)) ? wtot[(wave_ & ~3) + q] : 0;
    if (tid_ < NCH * NE) { toff[c * 257 + e] = base + inc - v; if (e == 255) toff[c * 257 + NE] = base + inc; }
    __syncthreads();
}
__device__ __forceinline__ void p_scatter(Frame& F) {
    moe_tile_offsets(F);
    int tid_ = threadIdx.x; asm volatile("" : "+v"(tid_));
    const LAS int* toff = (const LAS int*)(F.lds + LDS_TOFF); int* ctl = (int*)(F.ws + WS_CTL);
    LAS int* hist = (LAS int*)F.lds; LAS int* base = hist + NE;
    const int* TOPI = (const int*)(F.ws + WS_TOPI); const float* TOPW = (const float*)(F.ws + WS_TOPW); int* LIST = (int*)(F.ws + WS_LIST); float* LISTW = (float*)(F.ws + WS_LISTW);
    for (int ce = F.vcu; ce < NCH * NE; ce += F.G) { const int c = ce >> 8, e = ce & 255, n = ctl[CW_CNT2 + ce], b0 = toff[c * 257 + e] * 256, cap = ((n + 255) >> 8) << 8;
        for (int p = n + tid_; p < cap; p += 512) { LIST[c * LIST_CAP + b0 + p] = -1; LISTW[c * LIST_CAP + b0 + p] = 0.f; } }
    for (int blk = F.vcu; blk < TOK_BLOCKS; blk += F.G) {
        const int c = (blk * 256) / TCH;
        __syncthreads();
        if (tid_ < NE) hist[tid_] = 0;
        __syncthreads();
        int ex[4], loc[4];
#pragma unroll
        for (int i = 0; i < 4; ++i) { ex[i] = TOPI[blk * 2048 + tid_ + 512 * i]; loc[i] = __hip_atomic_fetch_add(hist + ex[i], 1, __ATOMIC_RELAXED, __HIP_MEMORY_SCOPE_WORKGROUP); }
        __syncthreads();
        if (tid_ < NE) { const int n = hist[tid_]; base[tid_] = n ? __hip_atomic_fetch_add(ctl + CW_FILL2 + c * NE + tid_, n, __ATOMIC_RELAXED, __HIP_MEMORY_SCOPE_AGENT) : 0; }
        __syncthreads();
#pragma unroll
        for (int i = 0; i < 4; ++i) { const int asg = blk * 2048 + tid_ + 512 * i; const int slot = c * LIST_CAP + toff[c * 257 + ex[i]] * 256 + base[ex[i]] + loc[i];
            LIST[slot] = asg; LISTW[slot] = TOPW[asg]; }
    }
    __syncthreads();
}
struct ProgMoE {
    unsigned char* dout; unsigned char* ws; const char* FINb; const char* WGU; const char* WD; char* HID;
    const int* LIST; const float* LISTW; int chunk, ntiles, vcu, G, ns, drain;
    __device__ __forceinline__ int expert_of(int j, LAS unsigned char* lds) const {
        const LAS int* toff = (const LAS int*)(lds + LDS_TOFF) + chunk * 257; int lo = 0, hi = NE;
#pragma unroll
        for (int it = 0; it < 8; ++it) { const int mid = (lo + hi) >> 1; const bool ge = j >= toff[mid]; lo = ge ? mid : lo; hi = ge ? hi : mid; }
        return __builtin_amdgcn_readfirstlane(lo);
    }
    __device__ __forceinline__ bool next(int i, eng::UnitD& u, LAS unsigned char* lds) const {
        int s, kind, n;
        if (drain) { if (i >= 4 || ns == 0) return false; s = ns - 1; kind = 1; n = i; }
        else { if (i < 2) { s = 0; kind = 0; n = i; } else { const int ii = i - 2; s = 1 + ii / 6; const int r = ii % 6; if (r < 2) { kind = 0; n = r; } else { kind = 1; n = r - 2; s -= 1; } }
               if (kind == 0 ? (s >= ns) : (s + 1 >= ns)) return false; }
        const int j = s * G + vcu;
        const int e = expert_of(j, lds);
        u.type = kind; u.r0 = s; u.r1 = n; u.r2 = j; u.r3 = e;
        if (kind == 0) { u.A = FINb; u.lda = 2048; u.B = WGU + (size_t)e * (512 * 2048) + (size_t)n * (256 * 2048); u.ldb = 2048; u.nt = 16; }
        else { u.A = HID + (size_t)(s & 1) * (256 * 512); u.lda = 512; u.B = WD + (size_t)e * (1024 * 512) + (size_t)n * (256 * 512); u.ldb = 512; u.nt = 4; }
        return true;
    }
    __device__ __forceinline__ void idx_dma(const eng::UnitD& u, LAS unsigned char* lds) const {
        if (threadIdx.x < 64) { const size_t base = (size_t)chunk * LIST_CAP + (size_t)u.r2 * 256 + threadIdx.x * 4; LAS unsigned char* dst = lds + LDS_IDX + (u.r0 % 3) * 2048;
            __builtin_amdgcn_global_load_lds((const unsigned*)(LIST + base), (LAS unsigned*)dst, 16, 0, 0);
            __builtin_amdgcn_global_load_lds((const unsigned*)(LISTW + base), (LAS unsigned*)(dst + 1024), 16, 0, 0); }
    }
    __device__ __forceinline__ void first(const eng::UnitD& u, LAS unsigned char* lds) const {
        if (!drain) { idx_dma(u, lds); asm volatile("s_waitcnt vmcnt(0)" ::: "memory"); __builtin_amdgcn_s_barrier(); asm volatile("" ::: "memory"); }
    }
    __device__ __forceinline__ void prefetch(const eng::UnitD& nxt, LAS unsigned char* lds) const { if (nxt.type == 0 && nxt.r1 == 0) idx_dma(nxt, lds); }
    __device__ __forceinline__ void offsets(const eng::UnitD& u, const int (&Rr)[2], const int (&Cc)[2], unsigned (&oA)[2][2], LAS unsigned char* lds) const {
        if (u.type == 0) { const LAS int* idx = (const LAS int*)(lds + LDS_IDX + (u.r0 % 3) * 2048);
#pragma unroll
            for (int h = 0; h < 2; ++h)
#pragma unroll
                for (int i = 0; i < 2; ++i) { const int v = idx[128 * h + Rr[i]]; oA[h][i] = (unsigned)((v < 0 ? 0 : v) >> 3) * 2048u + (unsigned)Cc[i]; } }
        else {
#pragma unroll
            for (int h = 0; h < 2; ++h)
#pragma unroll
                for (int i = 0; i < 2; ++i) oA[h][i] = (unsigned)(128 * h + Rr[i]) * 512u + (unsigned)Cc[i]; }
    }
    __device__ __forceinline__ void epilogue(eng::Acc& acc, const eng::UnitD& u, int wr, int wc, int fr, int fq, LAS unsigned char* lds) const {
        if (u.type == 0) {
            bf16* dst = (bf16*)(HID + (size_t)(u.r0 & 1) * (256 * 512)) + (size_t)(wr * 64 + fr) * 256 + u.r1 * 128 + wc * 32 + 8 * fq;
#pragma unroll
            for (int ai = 0; ai < 2; ++ai)
#pragma unroll
                for (int m = 0; m < 4; ++m) { f32x4 h0, h1;
#pragma unroll
                    for (int e = 0; e < 4; ++e) { h0[e] = siluf_(acc[ai][0][m][0][e]) * acc[ai][1][m][0][e]; h1[e] = siluf_(acc[ai][0][m][1][e]) * acc[ai][1][m][1][e]; }
                    u32x4 w; w.x = cvt_pk_bf16(h0[0], h0[1]); w.y = cvt_pk_bf16(h0[2], h0[3]); w.z = cvt_pk_bf16(h1[0], h1[1]); w.w = cvt_pk_bf16(h1[2], h1[3]);
                    *(u32x4*)(dst + (size_t)(ai * 128 + m * 16) * 256) = w; }
        } else {
            const LAS int* idx = (const LAS int*)(lds + LDS_IDX + (u.r0 % 3) * 2048); const LAS float* wgt = (const LAS float*)(idx + 256);
            const int col = u.r1 * 256 + wc * 64 + 16 * fq;
#pragma unroll
            for (int ai = 0; ai < 2; ++ai)
#pragma unroll
                for (int m = 0; m < 4; ++m) { const int r = ai * 128 + wr * 64 + m * 16 + fr; const int asg = idx[r]; const float w = wgt[r];
                    if (asg >= 0) { unsigned char* rowp = eo_row(dout, ws, asg & 7, (size_t)(asg >> 3)) + col; const float ws_ = w * EO_SCALE; u32x4 o;
#pragma unroll
                        for (int bj = 0; bj < 2; ++bj) { f32x4 v0 = acc[ai][bj][m][0] * ws_, v1 = acc[ai][bj][m][1] * ws_;
#pragma unroll
                            for (int e = 0; e < 4; ++e) { v0[e] = __builtin_amdgcn_fmed3f(v0[e], -448.f, 448.f); v1[e] = __builtin_amdgcn_fmed3f(v1[e], -448.f, 448.f); }
                            int lo = __builtin_amdgcn_cvt_pk_fp8_f32(v0[0], v0[1], 0, false); lo = __builtin_amdgcn_cvt_pk_fp8_f32(v0[2], v0[3], lo, true);
                            int hi = __builtin_amdgcn_cvt_pk_fp8_f32(v1[0], v1[1], 0, false); hi = __builtin_amdgcn_cvt_pk_fp8_f32(v1[2], v1[3], hi, true);
                            o[2 * bj] = (unsigned)lo; o[2 * bj + 1] = (unsigned)hi; }
                        *(u32x4*)rowp = o; } }
        }
    }
};
struct ProgSharedG1 {
    const char* FINb; const char* WSGU; bf16* HIDSH; int G, c, r;
    __device__ __forceinline__ bool next(int i, eng::UnitD& u, LAS unsigned char*) const {
        const int nshort = G - r, q = (c - r + G) % G, first = nshort * 4 < 512 ? nshort * 4 : 512;
        int L;
        if (q < nshort && 4 * q + i < first && i < 4) L = 4 * q + i;
        else { const int i2 = (q < nshort) ? i - ((4 * q < first) ? ((first - 4 * q) < 4 ? (first - 4 * q) : 4) : 0) : i; L = first + i2 * G + q; if (i2 < 0 || L >= 512) return false; }
        const int pm = L >> 1, n = L & 1;
        u.A = FINb + (size_t)pm * (256 * 2048); u.B = WSGU + (size_t)n * (256 * 2048); u.lda = 2048; u.ldb = 2048; u.nt = 16; u.type = 0; u.r0 = pm; u.r1 = n; u.r2 = 0; u.r3 = 0; return true;
    }
    __device__ __forceinline__ void first(const eng::UnitD&, LAS unsigned char*) const {}
    __device__ __forceinline__ void prefetch(const eng::UnitD&, LAS unsigned char*) const {}
    __device__ __forceinline__ void offsets(const eng::UnitD& u, const int (&Rr)[2], const int (&Cc)[2], unsigned (&oA)[2][2], LAS unsigned char*) const {
#pragma unroll
        for (int h = 0; h < 2; ++h)
#pragma unroll
            for (int i = 0; i < 2; ++i) oA[h][i] = (unsigned)(128 * h + Rr[i]) * u.lda + (unsigned)Cc[i];
    }
    __device__ __forceinline__ void epilogue(eng::Acc& acc, const eng::UnitD& u, int wr, int wc, int fr, int fq, LAS unsigned char*) const {
        bf16* dst = HIDSH + ((size_t)u.r0 * 256 + wr * 64 + fr) * 256 + u.r1 * 128 + wc * 32 + 8 * fq;
#pragma unroll
        for (int ai = 0; ai < 2; ++ai)
#pragma unroll
            for (int m = 0; m < 4; ++m) { f32x4 h0, h1;
#pragma unroll
                for (int e = 0; e < 4; ++e) { h0[e] = siluf_(acc[ai][0][m][0][e]) * acc[ai][1][m][0][e]; h1[e] = siluf_(acc[ai][0][m][1][e]) * acc[ai][1][m][1][e]; }
                u32x4 w; w.x = cvt_pk_bf16(h0[0], h0[1]); w.y = cvt_pk_bf16(h0[2], h0[3]); w.z = cvt_pk_bf16(h1[0], h1[1]); w.w = cvt_pk_bf16(h1[2], h1[3]);
                *(u32x4*)(dst + (size_t)(ai * 128 + m * 16) * 256) = w; }
    }
};
struct ProgSharedG2 {
    const char* HIDSHb; const char* WSD; bf16* SH; int G, c;
    __device__ __forceinline__ bool next(int i, eng::UnitD& u, LAS unsigned char*) const {
        const long L = (long)i * G + c; if (L >= 1024) return false;
        const int pm = (int)(L >> 2), n = (int)(L & 3);
        int nt4 = 4; asm volatile("" : "+s"(nt4));
        u.A = HIDSHb + (size_t)pm * (256 * 512); u.B = WSD + (size_t)n * (256 * 512); u.lda = 512; u.ldb = 512; u.nt = nt4; u.type = 0; u.r0 = pm; u.r1 = n; u.r2 = 0; u.r3 = 0; return true;
    }
    __device__ __forceinline__ void first(const eng::UnitD&, LAS unsigned char*) const {}
    __device__ __forceinline__ void prefetch(const eng::UnitD&, LAS unsigned char*) const {}
    __device__ __forceinline__ void offsets(const eng::UnitD& u, const int (&Rr)[2], const int (&Cc)[2], unsigned (&oA)[2][2], LAS unsigned char*) const {
#pragma unroll
        for (int h = 0; h < 2; ++h)
#pragma unroll
            for (int i = 0; i < 2; ++i) oA[h][i] = (unsigned)(128 * h + Rr[i]) * u.lda + (unsigned)Cc[i];
    }
    __device__ __forceinline__ void epilogue(eng::Acc& acc, const eng::UnitD& u, int wr, int wc, int fr, int fq, LAS unsigned char*) const {
        eng::store_tile_bf16<0>(acc, SH + ((size_t)u.r0 * 256 + wr * 64 + fr) * D + u.r1 * 256 + wc * 32 + 8 * fq, D);
    }
};
__device__ __forceinline__ void p_final(Frame& F, const Args& a) {
    int tid_ = threadIdx.x; asm volatile("" : "+v"(tid_)); const int lane = tid_ & 63, wave_ = __builtin_amdgcn_readfirstlane(tid_ >> 6);
    const float* x = a.in[0]; const f32x4* gpost = (const f32x4*)a.in[7] + 4 * lane; const f32x4* gpf = (const f32x4*)a.in[9] + 4 * lane;
    const float* mod = (const float*)(F.ws + WS_MOD); const bf16* YO = (const bf16*)(F.ws + WS_RA); const bf16* SH = (const bf16*)(F.ws + WS_GA);
    const float* RS1 = (const float*)(F.ws + WS_RS1);
    const int NGW = F.G * NWAVES; constexpr int RPW = 32;
    for (int gw = F.vcu * NWAVES + wave_; gw * RPW < T; gw += NGW) {
        const int row0 = gw * RPW; const f32x4* mr = (const f32x4*)(mod + (size_t)(row0 / S) * (NMOD * D)) + 4 * lane;
        f32x4 c1[4], c2[4];
#pragma unroll
        for (int q = 0; q < 4; ++q) { c1[q] = mr[512 + q] * gpost[q]; c2[q] = mr[1280 + q] * gpf[q]; }
        for (int row = row0; row < row0 + RPW; ++row) {
            u32x4 e[TOPK];
#pragma unroll
            for (int k = 0; k < TOPK; ++k) e[k] = __builtin_nontemporal_load((const u32x4*)(eo_row(F.dout, F.ws, k, (size_t)row) + 16 * lane));
            const u32x4 sh0 = *(const u32x4*)(SH + (size_t)row * D + 16 * lane), sh1 = *(const u32x4*)(SH + (size_t)row * D + 16 * lane + 8);
            const u32x4 y0 = *(const u32x4*)(YO + (size_t)row * D + 16 * lane), y1 = *(const u32x4*)(YO + (size_t)row * D + 16 * lane + 8);
            f32x4 xv[4];
#pragma unroll
            for (int q = 0; q < 4; ++q) xv[q] = __builtin_nontemporal_load((const f32x4*)(x + (size_t)row * D) + 4 * lane + q);
            float s1 = (lane < 16) ? RS1[(size_t)row * 16 + lane] : 0.f;
            s1 += __shfl_xor(s1, 1); s1 += __shfl_xor(s1, 2); s1 += __shfl_xor(s1, 4); s1 += __shfl_xor(s1, 8);
            const float rs1 = rsqrtf(__shfl(s1, 0) * (1.f / D) + EPS);
            float fx[16]; float ss = 0.f;
#pragma unroll
            for (int w = 0; w < 4; ++w) { f32x2 a0 = {0.f, 0.f}, a1 = {0.f, 0.f};
#pragma unroll
                for (int k = 0; k < TOPK; ++k) { a0 += __builtin_amdgcn_cvt_pk_f32_fp8((int)e[k][w], false); a1 += __builtin_amdgcn_cvt_pk_f32_fp8((int)e[k][w], true); }
                const unsigned s_lo = (w < 2) ? sh0[2 * w] : sh1[2 * w - 4], s_hi = (w < 2) ? sh0[2 * w + 1] : sh1[2 * w - 3];
                fx[4 * w + 0] = __uint_as_float(s_lo << 16) + a0[0] * (1.f / EO_SCALE); fx[4 * w + 1] = __uint_as_float(s_lo & 0xffff0000u) + a0[1] * (1.f / EO_SCALE);
                fx[4 * w + 2] = __uint_as_float(s_hi << 16) + a1[0] * (1.f / EO_SCALE); fx[4 * w + 3] = __uint_as_float(s_hi & 0xffff0000u) + a1[1] * (1.f / EO_SCALE); }
#pragma unroll
            for (int i = 0; i < 16; ++i) ss += fx[i] * fx[i];
            const float rs2 = rsqrtf(wave_sum(ss) * (1.f / D) + EPS);
            f32x4* orow = (f32x4*)(a.out + (size_t)row * D) + 4 * lane;
#pragma unroll
            for (int q = 0; q < 4; ++q) { const unsigned yw0 = (q < 2) ? y0[2 * q] : y1[2 * q - 4], yw1 = (q < 2) ? y0[2 * q + 1] : y1[2 * q - 3];
                f32x4 y; y[0] = __uint_as_float(yw0 << 16); y[1] = __uint_as_float(yw0 & 0xffff0000u); y[2] = __uint_as_float(yw1 << 16); y[3] = __uint_as_float(yw1 & 0xffff0000u);
                const f32x4 f = {fx[4 * q], fx[4 * q + 1], fx[4 * q + 2], fx[4 * q + 3]};
                orow[q] = xv[q] + c1[q] * (y * rs1) + c2[q] * (f * rs2); }
        }
    }
}
#ifndef MOE_AUX
#define MOE_AUX 0
#endif
#ifndef PROBE_ENG_PH
#define PROBE_ENG_PH 2
#endif
#ifndef PROBE_SPAN
#define PROBE_SPAN (-1)
#endif
#ifndef PROBE_PHASE
#define PROBE_PHASE (-1)
#endif
__device__ __forceinline__ void ph2_inproj(Frame& F, const Args& args) {
    ProgInProj P; P.A1 = (const char*)(F.ws + WS_RA); P.BT1 = (const char*)(F.ws + WS_BT1); P.G = F.G; P.c = (int)blockIdx.x;
    P.Q = (bf16*)(F.ws + WS_Q); P.K = (bf16*)(F.dout + DO_K); P.V = (bf16*)(F.dout + DO_V); P.MQ = (bf16*)(F.dout + DO_MQ);
    P.MO = (bf16*)(F.ws + WS_MO); P.GA = (bf16*)(F.ws + WS_GA); P.GATES = (float*)(F.ws + WS_GATES);
    { LAS float* tab = (LAS float*)(F.lds + RING_BYTES); const float* rp = (const float*)(F.ws + WS_ROPE);
      int tq = threadIdx.x; asm volatile("" : "+v"(tq));
      for (int i = tq; i < 2048; i += 512) tab[i] = rp[i];
      if (tq < 64) tab[2048 + tq] = args.in[11][tq]; else if (tq < 128) tab[2048 + tq] = args.in[12][tq - 64]; else if (tq < 136) tab[2048 + tq] = args.in[15][tq - 128]; else if (tq < 144) tab[2048 + tq] = args.in[16][tq - 136];
      __syncthreads(); P.tab = tab; }
    eng::gemm_stream<ProgInProj, 0>(F.lds, P, PROBE_ENG_PH == 2 ? F.egacc : nullptr);
}
__device__ __forceinline__ void ph3a_attn(Frame& F, const Args&) {
    const attn_body::AttnTensors AT{(const attn_body::bf16*)(F.ws + WS_Q), (const attn_body::bf16*)(F.dout + DO_K), (const attn_body::bf16*)(F.dout + DO_V), (attn_body::bf16*)(F.ws + WS_RA)};
    const attn_body::StaticOrder SO(F.G, F.vcu);
    attn_body::attn_phase<attn_body::StaticOrder>((char*)F.ldsg, AT, SO);
}
__device__ __forceinline__ void ph5_merge(Frame& F, const Args&, int panel) {
    ProgMerge P; P.panel = panel; P.AM = (const char*)(F.ws + WS_RA); P.WAT = (const char*)(F.ws + WS_WAT); P.WMT = (const char*)(F.ws + WS_WMT); P.Y = (bf16*)(F.dout); P.GA = (const bf16*)(F.ws + WS_GA); P.G = F.G; P.c = (int)blockIdx.x;
    eng::gemm_stream<ProgMerge, 0>(F.lds, P);
}
__device__ __forceinline__ void ph6_out(Frame& F, const Args&, int panel) {
    ProgOut P; P.panel = panel; P.Yb = (const char*)(F.dout); P.WOT = (const char*)(F.ws + WS_WOT); P.YO = (bf16*)(F.ws + WS_RA); P.RS1 = (float*)(F.ws + WS_RS1); P.G = F.G; P.c = (int)blockIdx.x;
    eng::gemm_stream<ProgOut, 0>(F.lds, P);
}
__device__ __forceinline__ void ph8_router(Frame& F, const Args&, int panel) {
    ProgRouter P; P.panel = panel; P.FINb = (const char*)(F.ws + WS_GA); P.WRT = (const char*)(F.ws + WS_WRT); P.SCORE = (float*)(F.ws + WS_SCORE); P.G = F.G; P.c = F.vcu;
    eng::gemm_stream<ProgRouter, 0>(F.lds, P);
}
template <int CH> __device__ __forceinline__ void ph_routed(Frame& F, const Args&) {
    moe_tile_offsets(F);
    ProgMoE P; P.dout = F.dout; P.ws = F.ws; P.FINb = (const char*)(F.ws + WS_GA); P.WGU = (const char*)(F.ws + WS_WGU); P.WD = (const char*)(F.ws + WS_WD); P.HID = (char*)(F.ws + WS_HIDS) + (size_t)F.vcu * (2 * 256 * 512);
    P.LIST = (const int*)(F.ws + WS_LIST); P.LISTW = (const float*)(F.ws + WS_LISTW); P.chunk = CH; P.vcu = F.vcu; P.G = F.G;
    P.ntiles = __builtin_amdgcn_readfirstlane(((const LAS int*)(F.lds + LDS_TOFF))[CH * 257 + NE]);
    P.ns = P.ntiles > F.vcu ? (P.ntiles - F.vcu + F.G - 1) / F.G : 0;
    P.drain = 0; eng::gemm_stream<ProgMoE, MOE_AUX>(F.lds, P, PROBE_ENG_PH == 11 ? F.egacc : nullptr);
    P.drain = 1; eng::gemm_stream<ProgMoE, MOE_AUX>(F.lds, P, PROBE_ENG_PH == 11 ? F.egacc : nullptr);
}
__device__ __forceinline__ void ph_sharedg1(Frame& F, const Args&) {
    ProgSharedG1 Q1; Q1.FINb = (const char*)(F.ws + WS_GA); Q1.WSGU = (const char*)(F.ws + WS_WSGU); Q1.HIDSH = (bf16*)(F.ws + WS_HIDSH); Q1.G = F.G; Q1.c = F.vcu;
    Q1.r = __builtin_amdgcn_readfirstlane(((const LAS int*)(F.lds + LDS_TOFF))[NE]) % F.G;
    eng::gemm_stream<ProgSharedG1, 0>(F.lds, Q1);
}
__device__ __forceinline__ void ph_sharedg2(Frame& F, const Args&) {
    ProgSharedG2 P; P.HIDSHb = (const char*)(F.ws + WS_HIDSH); P.WSD = (const char*)(F.ws + WS_WSD); P.SH = (bf16*)(F.ws + WS_GA); P.G = F.G; P.c = F.vcu;
    eng::gemm_stream<ProgSharedG2, 0>(F.lds, P);
}
__device__ __forceinline__ void ph7_rowpass(Frame& F, const Args& a, int panel) { p6_rowpass<false>(F, a, panel); }
__device__ __forceinline__ void ph10_scatter(Frame& F, const Args&) { p_scatter(F); }

__global__ void __launch_bounds__(NWAVES * 64, 2) mk_fwd(Args args) {
    extern __shared__ __attribute__((aligned(16))) unsigned char lds_raw[];
    Frame F;
    F.lds = (LAS unsigned char*)lds_raw; F.ldsg = lds_raw;
    F.G = gridDim.x; { const int bx = blockIdx.x; F.vcu = (F.G % 8 == 0) ? (bx % 8) * (F.G / 8) + bx / 8 : bx; }
    F.ws = args.ws; F.dout = (unsigned char*)args.out;
    volatile LAS unsigned* MISC = (volatile LAS unsigned*)(F.lds + LDSCTL_OFF);
    for (int u = threadIdx.x; u < (LDS_BYTES - LDSCTL_OFF) / 4; u += NWAVES * 64) ((LAS unsigned*)(F.lds + LDSCTL_OFF))[u] = 0u;
    __syncthreads();
    XcdBarrier bar = xcd_barrier_post((unsigned*)(F.ws + WS_CTL) + CW_BAR, MISC + 8);
    const int lo = args.ph_lo, hi = args.ph_hi;
    unsigned long long pt0 = 0, pt1 = 0, mlacc = 0, egaccv = 0; F.egacc = (PROBE_ENG > 0 && blockIdx.x == 0) ? &egaccv : nullptr;
#define IN(k) (lo <= (k) && (k) < hi)
#define BOTH(k) (IN(k) && IN((k) + 1))
#define STAMP0(k) if (PROBE_SPAN == (k)) { __syncthreads(); pt0 = wall_clock64(); }
#define STAMP1(k) if (PROBE_SPAN == (k)) { __syncthreads(); pt1 = wall_clock64(); }
#define RUNPH(k, CALL) if (IN(k)) { STAMP0(k) CALL; if (PROBE_PHASE == (k)) { xcd_barrier(bar); CALL; } if (BOTH(k)) xcd_barrier(bar); STAMP1(k) }
#define RUNPH2(k, kp, CALL) { CALL; if (PROBE_PHASE == (kp)) { xcd_barrier(bar); CALL; } }
    RUNPH(0, p0_prologue(F, args))
    RUNPH(1, p1_norm_gates(F, args))
    RUNPH(2, ph2_inproj(F, args))
    if (IN(3)) { STAMP0(3) RUNPH2(3, 30, ph3a_attn(F, args)) RUNPH2(3, 31, ml::mlstm_phase(F, args, mlacc)) if (BOTH(3)) xcd_barrier(bar); STAMP1(3) }
    if (IN(4)) { STAMP0(4) RUNPH2(4, 40, ml::mlstm_combine(F, args, -1)) if (BOTH(4)) xcd_barrier(bar); STAMP1(4) }
    RUNPH(5, ph5_merge(F, args, -1))
    RUNPH(6, ph6_out(F, args, -1))
    RUNPH(7, ph7_rowpass(F, args, -1))
    RUNPH(8, ph8_router(F, args, -1))
    RUNPH(9, p_topk(F, args, -1))
    RUNPH(10, ph10_scatter(F, args))
    if (IN(11)) { STAMP0(11) RUNPH2(11, 110, ph_routed<0>(F, args)) RUNPH2(11, 111, ph_sharedg1(F, args)) if (BOTH(11)) xcd_barrier(bar); STAMP1(11) }
    RUNPH(12, ph_sharedg2(F, args))
    RUNPH(13, p_final(F, args))
    if (PROBE_ENG > 0 && blockIdx.x == 0) { const unsigned long long te = wall_clock64(); while (wall_clock64() - te < 4ull * egaccv) __builtin_amdgcn_s_sleep(8); }
    if (PROBE_ML > 0 && blockIdx.x == 0) { const unsigned long long te = wall_clock64(); while (wall_clock64() - te < 4ull * mlacc) __builtin_amdgcn_s_sleep(8); }
    if (PROBE_SPAN >= 0 && blockIdx.x == 0) { const unsigned long long te = wall_clock64(); while (wall_clock64() - te < 4ull * (pt1 - pt0)) __builtin_amdgcn_s_sleep(8); }
#undef IN
#undef BOTH
}

static void launch_mk(hipStream_t st, const Args& a0, int grid, int lo, int hi) {
    Args a = a0; a.ph_lo = lo; a.ph_hi = hi;
    hipLaunchKernelGGL(mk_fwd, dim3(grid), dim3(NWAVES * 64), LDS_BYTES, st, a);
}
extern "C" void kernel_launch(void* const* d_in, const int* in_sizes, int n_in, void* d_out, int out_size, void* d_ws, size_t ws_size, hipStream_t st) {
    static int grid = 0;
    if (grid == 0) {
        if (n_in != 29 || ws_size < WS_NEED || out_size != T * D) { fprintf(stderr, "kernel_launch: unexpected n_in %d / ws_size %zu / out_size %d\n", n_in, ws_size, out_size); grid = -1; return; }
        int dev = 0, cus = 0;
        if (hipGetDevice(&dev) != hipSuccess || hipDeviceGetAttribute(&cus, hipDeviceAttributeMultiprocessorCount, dev) != hipSuccess) { grid = -1; return; }
        if (hipFuncSetAttribute((const void*)mk_fwd, hipFuncAttributeMaxDynamicSharedMemorySize, LDS_BYTES) != hipSuccess) { fprintf(stderr, "kernel_launch: hipFuncSetAttribute failed\n"); grid = -1; return; }
        int per_cu = 0;
        if (hipOccupancyMaxActiveBlocksPerMultiprocessor(&per_cu, (const void*)mk_fwd, NWAVES * 64, LDS_BYTES) != hipSuccess || per_cu < 1) fprintf(stderr, "kernel_launch: occupancy query says %d\n", per_cu);
        (void)hipGetLastError();
        grid = cus;
    }
    if (grid < 0) return;
    unsigned char* ws = (unsigned char*)d_ws;
    (void)hipMemsetAsync(ws + WS_CTL, 0, CTL_ZERO_BYTES, st);
    Args a; memset(&a, 0, sizeof(a));
    for (int i = 0; i < 29; ++i) a.in[i] = (const float*)d_in[i];
    a.out = (float*)d_out; a.ws = ws;
#if defined(EXP_PER_PHASE)
    for (int ph = 0; ph < 14; ++ph) launch_mk(st, a, grid, ph, ph + 1);
#else
    launch_mk(st, a, grid, 0, 14);
#endif
}
```

```cpp
#include <hip/hip_runtime.h>
#include <cstdio>
#include <cstdint>
#include <cstring>

constexpr int D = 1024, NB = 32, S = 2048, CL = 256, T = NB * S, TC = NB * CL, TA = T + TC, SL = S + CL;
constexpr int NMOD = 6, INW = 4880;
constexpr int AH = 8, AKV = 2, HD = 64, AW = 512, KVW = 128;
constexpr int MH = 4, MD = 128, MW = 512, MCH = 64;
constexpr int NE = 256, TOPK = 8, NG = 8, TKG = 4, EFF = 256;
constexpr float EPS = 1e-6f, RSCALE = 2.5f;
constexpr int C_Q = 0, C_K = 512, C_V = 640, C_MQ = 768, C_MK = 1280, C_MV = 1792, C_MO = 2304, C_MI = 2816, C_MF = 2824, C_GA = 2832, C_GM = 3856;
constexpr int N1 = 4864;

typedef unsigned short bf16;
typedef short bf16x8 __attribute__((ext_vector_type(8)));
typedef float f32x4 __attribute__((ext_vector_type(4)));
typedef float f32x2 __attribute__((ext_vector_type(2)));
typedef unsigned u32x4 __attribute__((ext_vector_type(4)));
typedef unsigned u32x2 __attribute__((ext_vector_type(2)));
#define LAS __attribute__((address_space(3)))
#define GAS __attribute__((address_space(1)))
__device__ __forceinline__ float bf2f(bf16 b) { return __uint_as_float(((unsigned)b) << 16); }
__device__ __forceinline__ bf16 f2bf(float f) { unsigned u = __float_as_uint(f); u += 0x7fffu + ((u >> 16) & 1u); return (bf16)(u >> 16); }
typedef __bf16 bf16x2_t __attribute__((ext_vector_type(2)));
__device__ __forceinline__ unsigned cvt_pk_bf16(float lo, float hi) { unsigned r; asm volatile("s_nop 0\n\tv_cvt_pk_bf16_f32 %0, %1, %2" : "=v"(r) : "v"(lo), "v"(hi)); return r; }
__device__ __forceinline__ unsigned cvt_pk_bf16_s(float lo, float hi) { const f32x2 v = {lo, hi}; return __builtin_bit_cast(unsigned, __builtin_convertvector(v, bf16x2_t)); }
__device__ __forceinline__ float ldf(const float* p) { return *p; }
__device__ __forceinline__ float ldf(const bf16* p) { return bf2f(*p); }
__device__ __forceinline__ float sigmoidf_(float x) { return __builtin_amdgcn_rcpf(1.f + __expf(-x)); }
__device__ __forceinline__ float siluf_(float x) { return x * __builtin_amdgcn_rcpf(1.f + __expf(-x)); }
__device__ __forceinline__ float wave_sum(float v) {
#pragma unroll
    for (int o = 1; o < 64; o <<= 1) v += __shfl_xor(v, o);
    return v;
}
__device__ __forceinline__ int seqrow_lat(int r) { const int b = r / S, t = r % S; return b * SL + CL + t; }
__device__ __forceinline__ int seqrow_ctx(int r) { const int b = r / CL, t = r % CL; return b * SL + t; }

constexpr size_t MiB = 1u << 20;
constexpr size_t WS_CTL = 0, CTL_ZERO_BYTES = 32 * 1024;
constexpr size_t WS_MOD = 1 * MiB;
constexpr size_t WS_GATES = 2 * MiB;
constexpr size_t WS_ROPE = 7 * MiB;
constexpr size_t WS_BT1 = 8 * MiB;
constexpr size_t WS_WAT = 18 * MiB;
constexpr size_t WS_WMT = 19 * MiB;
constexpr size_t WS_WOT = 20 * MiB;
constexpr size_t WS_WRT = 22 * MiB;
constexpr size_t WS_WSGU = 23 * MiB;
constexpr size_t WS_WSD = 24 * MiB;
constexpr size_t WS_RS1 = 25 * MiB;
constexpr size_t WS_RS2 = 29 * MiB;
constexpr size_t WS_TOPI = 33 * MiB;
constexpr size_t WS_TOPW = 35 * MiB;
constexpr size_t WS_LIST = 37 * MiB;
constexpr size_t WS_LISTW = 40 * MiB;
constexpr size_t WS_TILE = 43 * MiB;
constexpr size_t WS_RA = 44 * MiB;
constexpr size_t WS_RW = 188 * MiB;
constexpr size_t WS_GA = 572 * MiB;
constexpr size_t WS_GM = 700 * MiB;
constexpr size_t WS_Q = 828 * MiB;
constexpr size_t WS_MO = 892 * MiB;
constexpr size_t WS_H = 956 * MiB;
constexpr size_t WS_NEED = 1084 * MiB;
constexpr size_t DO_MQ = 0, DO_MK = 72 * MiB, DO_MV = 144 * MiB, DO_K = 216 * MiB, DO_V = 234 * MiB;
constexpr int CW_CNT = 0;
constexpr int CW_OFF = 256;
constexpr int CW_FILL = 1024;
constexpr int CW_BAR = 4096;
constexpr int RING_BYTES = 131072, LDSCTL_OFF = 143360  , LDS_BYTES = 147456;
constexpr int NWAVES = 8;
namespace eng {
constexpr int BM = 256, BK = 64, HALF = 128, HTB = HALF * BK * 2, STAGE_BYTES = 8 * HTB;
__host__ __device__ __forceinline__ int lds_byte(int r, int c) { const int st = (r >> 4) * 2 + (c >> 5), rr = r & 15, cc = c & 31, ob = rr * 64 + cc * 2; return st * 1024 + (ob ^ (((ob >> 9) & 1) << 5)); }
__host__ __device__ __forceinline__ void stage_rc(int b, int& R, int& C) { const int st = b / 1024, sb = b % 1024, swz = sb ^ (((sb >> 9) & 1) << 5); R = (st >> 1) * 16 + swz / 64; C = (st & 1) * 32 + (swz % 64) / 2; }
__host__ __device__ __forceinline__ int perm32(int rho) { const int n = rho >> 4, i = rho & 15; return 8 * (i >> 2) + 4 * n + (i & 3); }

struct UnitD { const char* A; const char* B; unsigned lda, ldb; int nt, type, r0, r1, r2, r3; };

typedef f32x4 Acc[2][2][4][2];

#ifndef PROBE_ENG
#define PROBE_ENG 0
#endif
#define EGT(k, WHICH) if (PROBE_ENG == (k) && egacc) { const unsigned long long _t = wall_clock64(); if (WHICH) *egacc += _t - egt0; else egt0 = _t; }
template <class Prog, int AUX_A, bool CARRY = false>
__device__ __forceinline__ void gemm_stream(LAS unsigned char* lds, const Prog& P, unsigned long long* egacc = nullptr) {
    unsigned long long egt0 = 0;
    int tid = threadIdx.x; asm volatile("" : "+v"(tid));
    const int wid = __builtin_amdgcn_readfirstlane(tid >> 6), lane = tid & 63, wr = wid >> 2, wc = wid & 3, fr = lane & 15, fq = lane >> 4;
    int Rr[2], Cc[2], Rb[2];
#pragma unroll
    for (int i = 0; i < 2; ++i) { int R, C; stage_rc(tid * 16 + i * 8192, R, C); Rr[i] = R; Cc[i] = C * 2; Rb[i] = (R & ~31) + perm32(R & 31); }
    const size_t kstep = (size_t)(BK * 2);
    const unsigned ldsw = (unsigned)wid * 1024u;
    const int aoff = lds_byte(wr * 64 + fr, fq * 8), boff = lds_byte(wc * 32 + fr, fq * 8);
#define EG_SA(b, h) (((b) * 2 + (h)) * HTB)
#define EG_SB(b, h) ((4 + (b) * 2 + (h)) * HTB)
#define EG_STAGE_B(bufoff, gbase) do { _Pragma("unroll") for (int _i = 0; _i < 2; ++_i) \
        __builtin_amdgcn_global_load_lds((const unsigned*)((const char*)(gbase) + oB[_i]), (LAS unsigned*)(lds + (bufoff) + ldsw + _i * 8192), 16, 0, 0); } while (0)
#define EG_STAGE_A(bufoff, gbase, h) do { _Pragma("unroll") for (int _i = 0; _i < 2; ++_i) \
        __builtin_amdgcn_global_load_lds((const unsigned*)((const char*)(gbase) + oA[h][_i]), (LAS unsigned*)(lds + (bufoff) + ldsw + _i * 8192), 16, 0, AUX_A); } while (0)
#define EG_LDA(dst, b, h) do { _Pragma("unroll") for (int m = 0; m < 4; ++m) _Pragma("unroll") for (int k = 0; k < 2; ++k) dst[m][k] = *(const LAS bf16x8*)(lds + EG_SA(b, h) + aoff + m * 2048 + k * 1024); } while (0)
#define EG_LDB(dst, b, h) do { _Pragma("unroll") for (int n = 0; n < 2; ++n) _Pragma("unroll") for (int k = 0; k < 2; ++k) dst[n][k] = *(const LAS bf16x8*)(lds + EG_SB(b, h) + boff + n * 2048 + k * 1024); } while (0)
#define EG_MMA(ai, bj, At, Bt) do { __builtin_amdgcn_s_setprio(1); _Pragma("unroll") for (int m = 0; m < 4; ++m) _Pragma("unroll") for (int n = 0; n < 2; ++n) _Pragma("unroll") for (int k = 0; k < 2; ++k) \
        acc[ai][bj][m][n] = __builtin_amdgcn_mfma_f32_16x16x32_bf16(Bt[n][k], At[m][k], acc[ai][bj][m][n], 0, 0, 0); __builtin_amdgcn_s_setprio(0); } while (0)
#define EG_WAIT_V(n) asm volatile("s_waitcnt vmcnt(" #n ")" ::: "memory")
#define EG_WAIT_L(n) asm volatile("s_waitcnt lgkmcnt(" #n ")" ::: "memory")
#define EG_BAR __builtin_amdgcn_s_barrier()
#define EG_SCHED __builtin_amdgcn_sched_barrier(0)
    UnitD cur, nxt; int ui = 0;
    if (!P.next(0, cur, lds)) return;
#ifdef ENG_STAGGER
    { const unsigned long long t0s = wall_clock64(), dl = (unsigned long long)(blockIdx.x & 3) * ENG_STAGGER; while (wall_clock64() - t0s < dl) __builtin_amdgcn_s_sleep(4); }
#endif
    Acc acc;
#pragma unroll
    for (int a = 0; a < 2; ++a)
#pragma unroll
        for (int b = 0; b < 2; ++b)
#pragma unroll
            for (int m = 0; m < 4; ++m)
#pragma unroll
                for (int n = 0; n < 2; ++n) acc[a][b][m][n] = (f32x4){0.f, 0.f, 0.f, 0.f};
    bf16x8 At[4][2], B0[2][2], B1[2][2];
    unsigned oA[2][2], oB[2];
    P.first(cur, lds);
    P.offsets(cur, Rr, Cc, oA, lds);
#pragma unroll
    for (int i = 0; i < 2; ++i) oB[i] = (unsigned)Rb[i] * cur.ldb + (unsigned)Cc[i];
    const char* cA = cur.A; const char* cB = cur.B; size_t hB = (size_t)HALF * cur.ldb;
    EG_STAGE_B(EG_SB(0, 0), cB); EG_STAGE_B(EG_SB(0, 1), cB + hB); EG_STAGE_A(EG_SA(0, 0), cA, 0); EG_STAGE_A(EG_SA(0, 1), cA, 1);
    if (wr == 1) EG_BAR;
    EG_WAIT_V(2); EG_BAR;
    EG_STAGE_B(EG_SB(1, 0), cB + kstep); EG_STAGE_A(EG_SA(1, 0), cA + kstep, 0); EG_STAGE_B(EG_SB(1, 1), cB + hB + kstep);
    EG_WAIT_V(6); EG_BAR;
    for (;;) {
        const bool has_next = P.next(ui + 1, nxt, lds);
        if (has_next) P.prefetch(nxt, lds);
        const int nt = cur.nt;
        EGT(1, 0)
        for (int t = 0; t < nt; t += 2) {
            const bool last = (t == nt - 2);
            EG_LDB(B0, 0, 0); EG_LDB(B1, 0, 1); EG_SCHED; EG_LDA(At, 0, 0); EG_STAGE_A(EG_SA(1, 1), cA + (size_t)(t + 1) * kstep, 1);
            EG_WAIT_V(8); EG_WAIT_L(0); EG_BAR; EG_MMA(0, 0, At, B0); EG_MMA(0, 1, At, B1); EG_BAR; EG_SCHED;
            const char *a2, *b2;
            if (last) {
                if (has_next) {
                    P.offsets(nxt, Rr, Cc, oA, lds);
#pragma unroll
                    for (int i = 0; i < 2; ++i) oB[i] = (unsigned)Rb[i] * nxt.ldb + (unsigned)Cc[i];
                    cA = nxt.A; cB = nxt.B; hB = (size_t)HALF * nxt.ldb;
                }
                a2 = cA; b2 = cB;
            } else { a2 = cA + (size_t)(t + 2) * kstep; b2 = cB + (size_t)(t + 2) * kstep; }
            const char* a3 = a2 + kstep; const char* b3 = b2 + kstep;
            EG_LDA(At, 0, 1); EG_STAGE_B(EG_SB(0, 0), b2); EG_STAGE_B(EG_SB(0, 1), b2 + hB); EG_STAGE_A(EG_SA(0, 0), a2, 0);
            EG_WAIT_V(8); EG_WAIT_L(0); EG_BAR; EG_MMA(1, 0, At, B0); EG_MMA(1, 1, At, B1); EG_BAR; EG_SCHED;
            EG_LDB(B0, 1, 0); EG_LDB(B1, 1, 1); EG_SCHED; EG_LDA(At, 1, 0); EG_STAGE_A(EG_SA(0, 1), a2, 1);
            EG_WAIT_V(8); EG_WAIT_L(0); EG_BAR; EG_MMA(0, 0, At, B0); EG_MMA(0, 1, At, B1); EG_BAR; EG_SCHED;
            EG_LDA(At, 1, 1); EG_STAGE_B(EG_SB(1, 0), b3); EG_STAGE_B(EG_SB(1, 1), b3 + hB); EG_STAGE_A(EG_SA(1, 0), a3, 0);
            EG_WAIT_V(8); EG_WAIT_L(0); EG_BAR; EG_MMA(1, 0, At, B0); EG_MMA(1, 1, At, B1); EG_BAR; EG_SCHED;
        }
        EGT(1, 1) EGT(2, 0)
#ifndef ENG_NOALIGN
        if (wr == 0) EG_BAR;
#endif
        P.epilogue(acc, cur, wr, wc, fr, fq, lds);
        EGT(2, 1)
        if (!has_next) break;
        if (!(CARRY && cur.type == 0))
#pragma unroll
        for (int a = 0; a < 2; ++a)
#pragma unroll
            for (int b = 0; b < 2; ++b)
#pragma unroll
                for (int m = 0; m < 4; ++m)
#pragma unroll
                    for (int n = 0; n < 2; ++n) acc[a][b][m][n] = (f32x4){0.f, 0.f, 0.f, 0.f};
        cur = nxt; ++ui;
#ifndef ENG_NOALIGN
        if (wr == 1) EG_BAR;
#endif
    }
    EG_WAIT_V(0);
#ifdef ENG_NOALIGN
    if (wr == 0) EG_BAR;
#endif
    EG_BAR;
#undef EG_SA
#undef EG_SB
#undef EG_STAGE_A
#undef EG_STAGE_B
#undef EG_LDA
#undef EG_LDB
#undef EG_MMA
#undef EG_WAIT_V
#undef EG_WAIT_L
#undef EG_BAR
#undef EG_SCHED
}
template <int ACT  >
__device__ __forceinline__ void store_tile_bf16(const Acc& acc, bf16* dst, size_t ld) {
#pragma unroll
    for (int ai = 0; ai < 2; ++ai)
#pragma unroll
        for (int m = 0; m < 4; ++m) { bf16* rowp = dst + (size_t)(ai * HALF + m * 16) * ld;
#pragma unroll
            for (int bj = 0; bj < 2; ++bj) { f32x4 v0 = acc[ai][bj][m][0], v1 = acc[ai][bj][m][1];
                if (ACT == 1) {
#pragma unroll
                    for (int e = 0; e < 4; ++e) { v0[e] = sigmoidf_(v0[e]); v1[e] = sigmoidf_(v1[e]); } }
                u32x4 w; w.x = cvt_pk_bf16(v0[0], v0[1]); w.y = cvt_pk_bf16(v0[2], v0[3]); w.z = cvt_pk_bf16(v1[0], v1[1]); w.w = cvt_pk_bf16(v1[2], v1[3]);
                *(u32x4*)(rowp + bj * HALF) = w; } }
}
}
#define RLX_AGENT __ATOMIC_RELAXED, __HIP_MEMORY_SCOPE_AGENT
#define LDS_WAIT() asm volatile("s_waitcnt lgkmcnt(0)" ::: "memory")
#define VM_WAIT() asm volatile("s_waitcnt vmcnt(0)" ::: "memory")
#define XB_TMO      128
#define XB_XCNT(j)  (256  + 64 * (j))
#define XB_XSUB(j)  (1280 + 64 * (j))
#define XB_XGEN(j)  (2304 + 64 * (j))
#define XB_TOP      3328
#define XB_TOPGEN   3392
#define XCD_BAR_WORDS 3456
#define XB_SPIN_CAP (1u << 18)

__device__ __forceinline__ unsigned xb_ld(unsigned* p)              { return __hip_atomic_load(p, __ATOMIC_RELAXED, __HIP_MEMORY_SCOPE_AGENT); }
__device__ __forceinline__ unsigned xb_add(unsigned* p, unsigned v) { return __hip_atomic_fetch_add(p, v, __ATOMIC_RELAXED, __HIP_MEMORY_SCOPE_AGENT); }
__device__ __forceinline__ unsigned xb_xcc_id() { return (unsigned)__builtin_amdgcn_s_getreg((3 << 11) | 20) & 0xFu; }
#define XB_SPIN(cond, bar) do { unsigned _sp = 0; while (cond) { __builtin_amdgcn_s_sleep(1); \
    if ((++_sp & 255u) == 0u) { if (xb_ld(&(bar)[XB_TMO])) break; if (_sp > XB_SPIN_CAP) { atomicAdd(&(bar)[XB_TMO], 1u); break; } } } } while (0)

struct XcdBarrier {
    unsigned* bar; unsigned x;
    volatile LAS unsigned* st;
};

__device__ __forceinline__ XcdBarrier xcd_barrier_post(unsigned* bar, volatile LAS unsigned* st) {
    XcdBarrier b; b.bar = bar; b.x = xb_xcc_id(); b.st = st;
    if (threadIdx.x == 0) (void)xb_add(&bar[XB_XCNT(b.x)], 1u);
    return b;
}
__device__ __forceinline__ void xcd_barrier_complete(unsigned* bar, unsigned x, unsigned& nloc, unsigned& nx) {
    const unsigned G = gridDim.x * gridDim.y * gridDim.z;
    unsigned sum, cnt, mine, sp = 0u;
    for (;;) {
        sum = 0u; cnt = 0u; mine = 0u;
#pragma unroll
        for (unsigned j = 0; j < 16; ++j) { const unsigned c = xb_ld(&bar[XB_XCNT(j)]); sum += c; cnt += (c > 0u) ? 1u : 0u; mine = (j == x) ? c : mine; }
        if (sum == G) break;
        __builtin_amdgcn_s_sleep(1);
        if ((++sp & 255u) == 0u) { if (xb_ld(&bar[XB_TMO])) break; if (sp > XB_SPIN_CAP) { atomicAdd(&bar[XB_TMO], 1u); break; } }
    }
    nloc = mine > 0u ? mine : 1u; nx = cnt > 0u ? cnt : 1u;
}

__device__ __forceinline__ void xcd_barrier(const XcdBarrier& b) {
    asm volatile("s_waitcnt vmcnt(0)" ::: "memory");
    __syncthreads();
    if (threadIdx.x == 0) {
        unsigned* bar = b.bar;
        __builtin_amdgcn_s_waitcnt(0);
        unsigned nloc = b.st[0], nx = b.st[1];
        if (nloc == 0u) { xcd_barrier_complete(bar, b.x, nloc, nx); b.st[0] = nloc; b.st[1] = nx; }
        const unsigned old = xb_add(&bar[XB_XSUB(b.x)], 1u);
        const unsigned gen = old / nloc;
        if (old + 1u == (gen + 1u) * nloc) {
            __builtin_amdgcn_fence(__ATOMIC_RELEASE, "agent");
            asm volatile("s_waitcnt vmcnt(0)" ::: "memory");
            const unsigned og = xb_add(&bar[XB_TOP], 1u);
            const unsigned tg = og / nx;
            if (og + 1u == (tg + 1u) * nx) xb_add(&bar[XB_TOPGEN], 1u);
            else XB_SPIN(xb_ld(&bar[XB_TOPGEN]) == tg, bar);
            __builtin_amdgcn_fence(__ATOMIC_ACQUIRE, "agent");
            xb_add(&bar[XB_XGEN(b.x)], 1u);
            asm volatile("s_waitcnt vmcnt(0)" ::: "memory");
        } else {
            XB_SPIN(xb_ld(&bar[XB_XGEN(b.x)]) == gen, bar);
            __builtin_amdgcn_fence(__ATOMIC_ACQUIRE, "agent");
            asm volatile("s_waitcnt vmcnt(0)" ::: "memory");
        }
    }
    __syncthreads();
}

struct Args { const float* in[29]; float* out; unsigned char* ws; int ph_lo, ph_hi; };
struct Frame {
    LAS unsigned char* lds; unsigned char* ldsg;
    int vcu, G;
    unsigned char* ws; unsigned char* dout; unsigned long long* egacc;
};
__device__ __forceinline__ int sigma_in(int np) {
    if (np < 768) { const int p = np & 255, bj = p >> 7, wc = (p >> 5) & 3, j = p & 31;
        if (np < 512) return C_Q + (4 * (np >> 8) + wc) * 64 + (j >> 4) * 32 + bj * 16 + (j & 15);
        if (wc < 2) return C_K + wc * 64 + (j >> 4) * 32 + bj * 16 + (j & 15);
        return C_V + (wc - 2) * 64 + bj * 32 + j; }
    if (np >= N1) return C_MI + ((np - N1) & 15);
    return np < 2816 ? np : np + 16;
}
__device__ __forceinline__ void transpose_item(const float* W, size_t ldw, int k0, int scol, bf16* WT, size_t ldt, int n0, LAS float* scr, int lane) {
#pragma unroll 8
    for (int i = 0; i < 32; ++i) { const int kk = 2 * i + (lane >> 5); scr[kk * 33 + (lane & 31)] = W[(size_t)(k0 + kk) * ldw + scol]; }
    LDS_WAIT(); asm volatile("" ::: "memory");
    const int c = lane & 7;
#pragma unroll
    for (int j = 0; j < 4; ++j) { const int n = (lane >> 3) + 8 * j; const LAS float* s = scr + (8 * c) * 33 + n;
        u32x4 o; o.x = cvt_pk_bf16(s[0 * 33], s[1 * 33]); o.y = cvt_pk_bf16(s[2 * 33], s[3 * 33]); o.z = cvt_pk_bf16(s[4 * 33], s[5 * 33]); o.w = cvt_pk_bf16(s[6 * 33], s[7 * 33]);
        *(u32x4*)(WT + (size_t)(n0 + n) * ldt + k0 + 8 * c) = o; }
    LDS_WAIT(); asm volatile("" ::: "memory");
}
__device__ __forceinline__ void transpose_job(const float* W, size_t ldw, int Kr, int Nd, int scol0, bf16* WT, size_t ldt, int drow0, LAS float* scr, int lane, int gw, int NGW, int& start) {
    const int nnb = Nd / 32, nit = (Kr / 64) * nnb;
    const int first = (gw - start % NGW + NGW) % NGW; start += nit;
    for (int it = first; it < nit; it += NGW) { const int kb = it / nnb, nb = it % nnb; transpose_item(W, ldw, 64 * kb, scol0 + 32 * nb + (lane & 31), WT, ldt, drow0 + 32 * nb, scr, lane); }
}
__device__ __forceinline__ void p0_prologue(Frame& F, const Args& a) {
    int tid_ = threadIdx.x; asm volatile("" : "+v"(tid_)); const int lane_ = tid_ & 63, wave_ = __builtin_amdgcn_readfirstlane(tid_ >> 6);
    LAS float* scr = (LAS float*)(F.lds + wave_ * 16384);
    const int gw = F.vcu * NWAVES + wave_, NGW = F.G * NWAVES, lane = lane_;
    { const float* w_in = a.in[10]; bf16* BT1 = (bf16*)(F.ws + WS_BT1);
      constexpr int NR = N1 + 32, NIT = (D / 64) * (NR / 32);
      for (int i = F.vcu * 512 + tid_; i < 224 * D / 8; i += F.G * 512) ((u32x4*)(BT1 + (size_t)NR * D))[i] = (u32x4){0u, 0u, 0u, 0u};
      for (int it = gw; it < NIT; it += NGW) { const int kb = it / (NR / 32), nb = it % (NR / 32); transpose_item(w_in, INW, 64 * kb, sigma_in(32 * nb + (lane & 31)), BT1, D, 32 * nb, scr, lane); } }
    int jstart = (D / 64) * ((N1 + 32) / 32);
    transpose_job(a.in[18], D, 512, D, 0, (bf16*)(F.ws + WS_WAT), 512, 0, scr, lane, gw, NGW, jstart);
    transpose_job(a.in[19], D, 512, D, 0, (bf16*)(F.ws + WS_WMT), 512, 0, scr, lane, gw, NGW, jstart);
    transpose_job(a.in[20], D, D, D, 0, (bf16*)(F.ws + WS_WOT), D, 0, scr, lane, gw, NGW, jstart);
    transpose_job(a.in[21], NE, D, NE, 0, (bf16*)(F.ws + WS_WRT), D, 0, scr, lane, gw, NGW, jstart);
    for (int n = 0; n < 2; ++n) {
        transpose_job(a.in[26], EFF, D, 128, 128 * n, (bf16*)(F.ws + WS_WSGU), D, 256 * n, scr, lane, gw, NGW, jstart);
        transpose_job(a.in[27], EFF, D, 128, 128 * n, (bf16*)(F.ws + WS_WSGU), D, 256 * n + 128, scr, lane, gw, NGW, jstart); }
    transpose_job(a.in[28], D, EFF, D, 0, (bf16*)(F.ws + WS_WSD), EFF, 0, scr, lane, gw, NGW, jstart);
    { float* rc = (float*)(F.ws + WS_ROPE); float* rsn = rc + 1024;
      for (int i = F.vcu * 512 + tid_; i < 1024; i += F.G * 512) { const int pos = i >> 4, f = i & 15; const float inv = exp2f(-(float)f * (13.287712379549449f / 16.f)); const float ang = (float)pos * inv; rc[i] = cosf(ang); rsn[i] = sinf(ang); } }
    __syncthreads();
    { const float* c = a.in[1]; const float* c_ctx = a.in[3]; const float* w_ada = a.in[4]; const float* b_ada = a.in[5]; float* mod = (float*)(F.ws + WS_MOD);
      LAS float* sC = (LAS float*)F.lds;
      for (int i = tid_; i < 33 * 1024; i += 512) { const int r = i >> 10, k = i & 1023; const float v = r < NB ? c[i] : c_ctx[k]; sC[r * 1028 + k] = siluf_(v); }
      __syncthreads();
      for (int cb = F.vcu; cb < (NMOD * D) / 32; cb += F.G) {
          const int col = cb * 32 + (tid_ & 31), ks = tid_ >> 5;
          float acc[33];
#pragma unroll
          for (int r = 0; r < 33; ++r) acc[r] = 0.f;
          for (int k4 = 0; k4 < 16; ++k4) { const int k = ks * 64 + 4 * k4; float w[4];
#pragma unroll
              for (int i = 0; i < 4; ++i) w[i] = w_ada[(size_t)(k + i) * (NMOD * D) + col];
#pragma unroll
              for (int r = 0; r < 33; ++r) { const f32x4 s4 = *(const LAS f32x4*)(sC + r * 1028 + k); acc[r] += (s4[0] * w[0] + s4[1] * w[1]) + (s4[2] * w[2] + s4[3] * w[3]); } }
          __syncthreads();
          LAS float* red = (LAS float*)F.lds;
#pragma unroll
          for (int r = 0; r < 33; ++r) red[(ks * 33 + r) * 32 + (tid_ & 31)] = acc[r];
          __syncthreads();
          for (int o = tid_; o < 33 * 32; o += 512) { const int r = o >> 5, cc = o & 31; float s = 0.f;
#pragma unroll
              for (int q = 0; q < 16; ++q) s += red[(q * 33 + r) * 32 + cc];
              mod[(size_t)r * (NMOD * D) + cb * 32 + cc] = s + b_ada[cb * 32 + cc]; }
          __syncthreads();
          if (cb + F.G < (NMOD * D) / 32) { for (int i = tid_; i < 33 * 1024; i += 512) { const int r = i >> 10, k = i & 1023; const float v = r < NB ? c[i] : c_ctx[k]; sC[r * 1028 + k] = siluf_(v); } __syncthreads(); }
      }
      __syncthreads(); }
}
__device__ __forceinline__ void p1_norm_gates(Frame& F, const Args& a) {
    int tid_ = threadIdx.x; asm volatile("" : "+v"(tid_)); const int lane = tid_ & 63, wave_ = __builtin_amdgcn_readfirstlane(tid_ >> 6);
    const float* x = a.in[0]; const float* ctx = a.in[2]; const f32x4* g4 = (const f32x4*)a.in[6];
    const float* mod = (const float*)(F.ws + WS_MOD); bf16* A1 = (bf16*)(F.ws + WS_RA);
    const int NGW = F.G * NWAVES;
#pragma unroll 1
    for (int part = 0; part < 2; ++part) {
        const int NR = part ? TC : T, SEG = part ? CL : S, RPW = part ? 4 : 32;
        for (int gw = F.vcu * NWAVES + wave_; gw * RPW < NR; gw += NGW) {
            const int row0 = gw * RPW; const f32x4* mr = (const f32x4*)(mod + (size_t)(part ? NB : row0 / SEG) * (NMOD * D));
            f32x4 cs[4], ch[4];
#pragma unroll
            for (int j = 0; j < 4; ++j) { const int i4 = 64 * j + lane; cs[j] = g4[i4] * (mr[256 + i4] + 1.f); ch[j] = mr[i4]; }
            for (int row = row0; row < row0 + RPW && row < NR; ++row) {
                const f32x4* xr = (const f32x4*)((part ? ctx : x) + (size_t)row * D);
                f32x4 v[4]; float ss = 0.f;
#pragma unroll
                for (int j = 0; j < 4; ++j) { v[j] = __builtin_nontemporal_load(xr + 64 * j + lane); ss += (v[j][0] * v[j][0] + v[j][1] * v[j][1]) + (v[j][2] * v[j][2] + v[j][3] * v[j][3]); }
                const float rs = rsqrtf(wave_sum(ss) * (1.f / D) + EPS);
                u32x2* o8 = (u32x2*)(A1 + (size_t)(part ? T + row : row) * D);
#pragma unroll
                for (int j = 0; j < 4; ++j) { const f32x4 o = v[j] * rs * cs[j] + ch[j]; u32x2 w; w.x = cvt_pk_bf16(o[0], o[1]); w.y = cvt_pk_bf16(o[2], o[3]); o8[64 * j + lane] = w; }
            }
        }
    }
    __syncthreads();
}
#ifndef WGM2
#define WGM2 4
#endif
constexpr float QSCALE = 0.125f * 1.4426950408889634f;
struct ProgInProj {
    const char* A1; const char* BT1; int G, c;
    bf16 *Q, *K, *V, *MQ, *MO, *GA; float* GATES; const LAS float* tab;
    __device__ __forceinline__ bool next(int i, eng::UnitD& u, LAS unsigned char*) const {
        const long L = (long)i * G + c; if (L >= 5376) return false;
        int pm, pn;
        if (L < 5120) { int wgid = (int)L; { const int q = 5120 / 8, xcd = wgid % 8, off = wgid / 8; wgid = xcd * q + off; }
            const int nig = WGM2 * 20, gid = wgid / nig, fm = gid * WGM2; pm = fm + ((wgid % nig) % WGM2); pn = (wgid % nig) / WGM2; }
        else { const int j = (int)L - 5120; pm = 256 + (j & 31); pn = 2 + (j >> 5); if (pn == 9) pn = 19; }
        u.A = A1 + (size_t)pm * (256 * 2048); u.B = BT1 + (size_t)pn * (256 * 2048); u.lda = 2048; u.ldb = 2048; u.nt = 16; u.type = 0; u.r0 = pm; u.r1 = pn; u.r2 = 0; u.r3 = 0; return true;
    }
    __device__ __forceinline__ void first(const eng::UnitD&, LAS unsigned char*) const {}
    __device__ __forceinline__ void prefetch(const eng::UnitD&, LAS unsigned char*) const {}
    __device__ __forceinline__ void offsets(const eng::UnitD& u, const int (&Rr)[2], const int (&Cc)[2], unsigned (&oA)[2][2], LAS unsigned char*) const {
#pragma unroll
        for (int h = 0; h < 2; ++h)
#pragma unroll
            for (int i = 0; i < 2; ++i) oA[h][i] = (unsigned)(128 * h + Rr[i]) * u.lda + (unsigned)Cc[i];
    }
    template <bool ROPE>
    __device__ __forceinline__ void qk_epi(const eng::Acc& acc, bf16* dst  , size_t ld, const LAS float* gain, float scale, int pm, int wr, int fr, int fq) const {
        const LAS float* rope = tab;
        f32x4 gv[2][2];
#pragma unroll
        for (int bj = 0; bj < 2; ++bj)
#pragma unroll
            for (int n = 0; n < 2; ++n) gv[bj][n] = *(const LAS f32x4*)(gain + (fq >> 1) * 32 + bj * 16 + 8 * (fq & 1) + 4 * n);
#pragma unroll
        for (int ai = 0; ai < 2; ++ai)
#pragma unroll
            for (int m = 0; m < 4; ++m) {
                float ss = 0.f;
#pragma unroll
                for (int bj = 0; bj < 2; ++bj)
#pragma unroll
                    for (int n = 0; n < 2; ++n) { const f32x4 v = acc[ai][bj][m][n]; ss += (v[0] * v[0] + v[1] * v[1]) + (v[2] * v[2] + v[3] * v[3]); }
                ss += __shfl_xor(ss, 16); ss += __shfl_xor(ss, 32);
                const float rs = rsqrtf(ss * (1.f / HD) + EPS) * scale;
                f32x4 o1[2], o2[2];
#pragma unroll
                for (int n = 0; n < 2; ++n) { const f32x4 x1 = acc[ai][0][m][n] * rs * gv[0][n], x2 = acc[ai][1][m][n] * rs * gv[1][n];
                    if (ROPE) { const int pos = (fq >> 1) ? (16 * m + fr) : ((4 * pm + 2 * ai + wr) & 31);
                        const f32x4 cs = *(const LAS f32x4*)(rope + pos * 16 + 8 * (fq & 1) + 4 * n), sn = *(const LAS f32x4*)(rope + 1024 + pos * 16 + 8 * (fq & 1) + 4 * n);
                        o1[n] = x1 * cs - x2 * sn; o2[n] = x2 * cs + x1 * sn; }
                    else { o1[n] = x1; o2[n] = x2; } }
                bf16* rowp = dst + (size_t)(ai * 128 + m * 16) * ld;
                u32x4 w; w.x = cvt_pk_bf16(o1[0][0], o1[0][1]); w.y = cvt_pk_bf16(o1[0][2], o1[0][3]); w.z = cvt_pk_bf16(o1[1][0], o1[1][1]); w.w = cvt_pk_bf16(o1[1][2], o1[1][3]);
                *(u32x4*)(rowp) = w;
                w.x = cvt_pk_bf16(o2[0][0], o2[0][1]); w.y = cvt_pk_bf16(o2[0][2], o2[0][3]); w.z = cvt_pk_bf16(o2[1][0], o2[1][1]); w.w = cvt_pk_bf16(o2[1][2], o2[1][3]);
                *(u32x4*)(rowp + 32) = w;
            }
    }
    __device__ __forceinline__ void v_epi(const eng::Acc& acc, bf16* dst, size_t ld) const {
#pragma unroll
        for (int ai = 0; ai < 2; ++ai)
#pragma unroll
            for (int m = 0; m < 4; ++m) { bf16* rowp = dst + (size_t)(ai * 128 + m * 16) * ld;
#pragma unroll
                for (int bj = 0; bj < 2; ++bj) { const f32x4 v0 = acc[ai][bj][m][0], v1 = acc[ai][bj][m][1];
                    u32x4 w; w.x = cvt_pk_bf16(v0[0], v0[1]); w.y = cvt_pk_bf16(v0[2], v0[3]); w.z = cvt_pk_bf16(v1[0], v1[1]); w.w = cvt_pk_bf16(v1[2], v1[3]);
                    *(u32x4*)(rowp + bj * 32) = w; } }
    }
    __device__ __forceinline__ void epilogue(eng::Acc& acc, const eng::UnitD& u, int wr, int wc, int fr, int fq, LAS unsigned char*) const {
        const int pm = u.r0, pn = u.r1; const bool lat = pm < 256;
        const int lrow = wr * 64 + fr;
        const size_t r0 = (size_t)pm * 256;
        const size_t sr0 = lat ? r0 + (size_t)(pm / 8 + 1) * CL : (size_t)(pm - 256) * SL;
        if (pn < 2) { qk_epi<true>(acc, Q + (r0 + lrow) * AW + (4 * pn + wc) * 64 + 8 * fq, AW, tab + 2048, QSCALE, pm, wr, fr, fq); }
        else if (pn == 2) { int lrow = wr * 64 + fr; asm volatile("" : "+v"(lrow), "+v"(fq));
            if (wc < 2) { bf16* d = K + (sr0 + lrow) * KVW + wc * 64 + 8 * fq; if (lat) qk_epi<true>(acc, d, KVW, tab + 2112, 1.f, pm, wr, fr, fq); else qk_epi<false>(acc, d, KVW, tab + 2112, 1.f, pm, wr, fr, fq); }
            else v_epi(acc, V + (sr0 + lrow) * KVW + (wc - 2) * 64 + 8 * fq, KVW);
        }
        else if (pn < 9) { bf16* base = MQ + (size_t)((pn - 3) >> 1) * ((size_t)TA * MW); const int ct = ((pn - 3) & 1) * 256;
            eng::store_tile_bf16<0>(acc, base + (sr0 + lrow) * MW + ct + wc * 32 + 8 * fq, MW); }
        else if (pn < 11) eng::store_tile_bf16<0>(acc, MO + (r0 + lrow) * MW + (pn - 9) * 256 + wc * 32 + 8 * fq, MW);
        else if (pn == 19) {
            if (wc == 0 && fq < 2) { const f32x4 b0 = *(const LAS f32x4*)(tab + 2176 + 8 * fq), b1 = *(const LAS f32x4*)(tab + 2176 + 8 * fq + 4);
#pragma unroll
                for (int ai = 0; ai < 2; ++ai)
#pragma unroll
                    for (int m = 0; m < 4; ++m) { f32x4 v0 = acc[ai][0][m][0] + b0, v1 = acc[ai][0][m][1] + b1;
                        if (fq == 1) {
#pragma unroll
                            for (int e = 0; e < 4; ++e) { v0[e] = fminf(v0[e], 0.f) - log1pf(__expf(-fabsf(v0[e]))); v1[e] = fminf(v1[e], 0.f) - log1pf(__expf(-fabsf(v1[e]))); } }
                        float* gp = GATES + (sr0 + lrow + ai * 128 + m * 16) * 16 + 8 * fq; *(f32x4*)gp = v0; *(f32x4*)(gp + 4) = v1; } } }
        else {
            unsigned char* lbase = (unsigned char*)GA + (size_t)((pn - 11) >> 2) * (128 * MiB) + (r0 + lrow) * D + ((pn - 11) & 3) * 256 + wc * 64 + 16 * fq;
#pragma unroll
            for (int ai = 0; ai < 2; ++ai)
#pragma unroll
                for (int m = 0; m < 4; ++m) { unsigned char* rp = lbase + (size_t)(ai * 128 + m * 16) * D; asm volatile("" : "+v"(rp));
                    u32x4 o;
#pragma unroll
                    for (int bj = 0; bj < 2; ++bj)
#pragma unroll
                        for (int n = 0; n < 2; ++n) { unsigned wv = 0u;
#pragma unroll
                            for (int e = 0; e < 4; ++e) wv |= (unsigned)(sigmoidf_(acc[ai][bj][m][n][e]) * 255.996f) << (8 * e);
                            o[2 * bj + n] = wv; }
                    *(u32x4*)rp = o; } }
    }
};
#include <hip/hip_bf16.h>
#include <cmath>
namespace attn_body {
using bf16=__hip_bfloat16;
using bf16x8=__attribute__((ext_vector_type(8)))short;
using s16x4=__attribute__((ext_vector_type(4)))short;
using f32x16=__attribute__((ext_vector_type(16)))float;
using u32x4=__attribute__((ext_vector_type(4)))unsigned;
constexpr int BATCH=32,NHEAD=8,SEQ=2048,SKV=2304,D=64,QP=512,KP=128,OP=1024;
constexpr int NW=8,QBLK=32,QB=QBLK*NW,KVBLK=64,NQB=SEQ/QB;
constexpr int ATTN_UNIT_ROWS=QB;
__device__ __forceinline__ int crow(int r,int hi){return (r&3)+8*(r>>2)+4*hi;}
#define SBAR() __builtin_amdgcn_sched_barrier(0)
__device__ __forceinline__ void cmask(f32x16&p0,f32x16&p1,int jb,int qrel,int hi){
  const float NEG=-INFINITY; int kb=64*jb+4*hi;
  #pragma unroll
  for(int r=0;r<16;++r){int kv=kb+(r&3)+8*(r>>2); if(kv>qrel)p0[r]=NEG; if(kv+32>qrel)p1[r]=NEG;}
}

constexpr int NSLOT=3, SLOTB=8192;
constexpr int LDS_K=0, LDS_V=NSLOT*SLOTB, LDS_WS=2*NSLOT*SLOTB, LDS_OST=LDS_WS+NW*64*4, LDS_BYTES=LDS_OST+NW*4096;
constexpr float C2=0.125f*1.4426950408889634f;
__device__ __forceinline__ void glds16(const void*gsrc,unsigned lds_dst){unsigned keep;
  asm volatile("s_mov_b32 %0, m0\n\ts_mov_b32 m0, %2\n\ts_nop 0\n\tglobal_load_lds_dwordx4 %1, off\n\ts_mov_b32 m0, %0":"=&s"(keep):"v"(gsrc),"s"(lds_dst):"memory");}
__device__ __forceinline__ float max3f(float a,float b,float c){float r;asm("v_max3_f32 %0, %1, %2, %3":"=v"(r):"v"(a),"v"(b),"v"(c));return r;}
__device__ __forceinline__ float max2f(float a,float b){float r;asm("v_max_f32_e32 %0, %1, %2":"=v"(r):"v"(a),"v"(b));return r;}
__device__ __forceinline__ float fadd_s(float a,float b){float r;asm("v_add_f32_e32 %0, %1, %2":"=v"(r):"v"(a),"v"(b));return r;}
__device__ __forceinline__ float fsub_s(float a,float b){float r;asm("v_sub_f32_e32 %0, %1, %2":"=v"(r):"v"(a),"v"(b));return r;}
typedef float f32x2_t __attribute__((ext_vector_type(2))); typedef __bf16 bf16x2_t __attribute__((ext_vector_type(2)));
__device__ __forceinline__ unsigned cvtpk_s(float lo,float hi){f32x2_t v={lo,hi};bf16x2_t b=__builtin_convertvector(v,bf16x2_t);return __builtin_bit_cast(unsigned,b);}
#define WAIT_BAR(N) asm volatile("s_waitcnt vmcnt(" #N ") lgkmcnt(0)\n\ts_barrier":::"memory")

__device__ __forceinline__ void qkt(f32x16&p0,f32x16&p1,const char*Kslot,const bf16x8*qr,const f32x16&negm,int r32,int hi){
  const char*kb=Kslot+hi*1024+r32*16;
  #pragma unroll
  for(int d0=0;d0<4;++d0){
    const bf16x8 b0=*reinterpret_cast<const bf16x8*>(kb+d0*2048);
    const bf16x8 b1=*reinterpret_cast<const bf16x8*>(kb+d0*2048+512);
    if(d0==0){p0=__builtin_amdgcn_mfma_f32_32x32x16_bf16(b0,qr[0],negm,0,0,0);p1=__builtin_amdgcn_mfma_f32_32x32x16_bf16(b1,qr[0],negm,0,0,0);}
    else{p0=__builtin_amdgcn_mfma_f32_32x32x16_bf16(b0,qr[d0],p0,0,0,0);p1=__builtin_amdgcn_mfma_f32_32x32x16_bf16(b1,qr[d0],p1,0,0,0);}}
}
typedef __attribute__((address_space(3))) const char* lds_cptr;
typedef short v4i16_t __attribute__((ext_vector_type(4)));
__device__ __forceinline__ void kload8(bf16x8*kf,lds_cptr kp){
  kf[0]=*(const __attribute__((address_space(3))) bf16x8*)(kp);      kf[1]=*(const __attribute__((address_space(3))) bf16x8*)(kp+512);
  kf[2]=*(const __attribute__((address_space(3))) bf16x8*)(kp+2048); kf[3]=*(const __attribute__((address_space(3))) bf16x8*)(kp+2560);
  kf[4]=*(const __attribute__((address_space(3))) bf16x8*)(kp+4096); kf[5]=*(const __attribute__((address_space(3))) bf16x8*)(kp+4608);
  kf[6]=*(const __attribute__((address_space(3))) bf16x8*)(kp+6144); kf[7]=*(const __attribute__((address_space(3))) bf16x8*)(kp+6656);
}
__device__ __forceinline__ void kload2(bf16x8*kf,lds_cptr kp,int j){ kf[2*j]=*(const __attribute__((address_space(3))) bf16x8*)(kp+j*2048); kf[2*j+1]=*(const __attribute__((address_space(3))) bf16x8*)(kp+j*2048+512); }
__device__ __forceinline__ s16x4 vtr(lds_cptr p){ return __builtin_bit_cast(s16x4,__builtin_amdgcn_ds_read_tr16_b64_v4i16((__attribute__((address_space(3))) v4i16_t*)p)); }
__device__ __forceinline__ float rowmax(const f32x16&p0,const f32x16&p1){
  float a=max3f(p0[0],p0[1],p1[0]),b=max3f(p0[2],p0[3],p1[1]);a=max3f(a,p1[2],p1[3]);
  #pragma unroll
  for(int r=4;r<16;r+=4){a=max3f(a,p0[r],p0[r+1]);b=max3f(b,p0[r+2],p0[r+3]);a=max3f(a,p1[r],p1[r+1]);b=max3f(b,p1[r+2],p1[r+3]);}
  const float m=max2f(a,b);
  auto rr=__builtin_amdgcn_permlane32_swap(__float_as_uint(m),__float_as_uint(m),false,false);
  return max2f(__uint_as_float(rr[0]),__uint_as_float(rr[1]));
}
__device__ __forceinline__ void pv(f32x16*o,int vb,bf16x8 pa0,bf16x8 pa1,bf16x8 pa2,bf16x8 pa3){
  #pragma unroll
  for(int d0=0;d0<2;++d0){s16x4 lo[4],hi[4];
    #pragma unroll
    for(int ks=0;ks<4;++ks){
      asm volatile("ds_read_b64_tr_b16 %0,%1 offset:%c2":"=&v"(lo[ks]):"v"(vb),"i"(d0*4096+ks*1024):"memory");
      asm volatile("ds_read_b64_tr_b16 %0,%1 offset:%c2":"=&v"(hi[ks]):"v"(vb),"i"(d0*4096+ks*1024+512):"memory");}
    asm volatile("s_waitcnt lgkmcnt(0)":::"memory");SBAR();
    #define PK(k) (bf16x8){lo[k][0],lo[k][1],lo[k][2],lo[k][3],hi[k][0],hi[k][1],hi[k][2],hi[k][3]}
    o[d0]=__builtin_amdgcn_mfma_f32_32x32x16_bf16(pa0,PK(0),o[d0],0,0,0);
    o[d0]=__builtin_amdgcn_mfma_f32_32x32x16_bf16(pa1,PK(1),o[d0],0,0,0);
    o[d0]=__builtin_amdgcn_mfma_f32_32x32x16_bf16(pa2,PK(2),o[d0],0,0,0);
    o[d0]=__builtin_amdgcn_mfma_f32_32x32x16_bf16(pa3,PK(3),o[d0],0,0,0);
    #undef PK
  }
}

#ifndef ATTN_STORE16
#define ATTN_STORE16(p,v) (*(u32x4*)(p)=(v))
#endif
template<int THRL> __device__ __forceinline__ void attn_unit(int b,int h,int qb,const bf16*Q,const bf16*__restrict__ K,const bf16*__restrict__ V,bf16*O,char*shm){
  const int tid=threadIdx.x,lane=tid&63,r32=lane&31,hi=lane>>5; const int wid=__builtin_amdgcn_readfirstlane(tid>>6);
  const long rowbase=(long)b*SEQ, kvbase=(long)b*SKV; const int q0=qb*QB;
  const bf16*Qw=Q+(rowbase+q0+wid*QBLK)*QP+h*D;
  const bf16*Kh=K+kvbase*KP+(h>>2)*D,*Vh=V+kvbase*KP+(h>>2)*D;
  const unsigned lds0=(unsigned)(uintptr_t)shm;
  float*wsf=(float*)(shm+LDS_WS)+wid*64;
  const bf16*ksrc=Kh+(long)lane*KP+wid*8;
  const bf16*vsrc=Vh+(long)(16*(wid&3)+(lane>>2))*KP+(wid>>2)*32+(lane&3)*8;
  const unsigned kdst=lds0+LDS_K+wid*1024, vdst=lds0+LDS_V+wid*1024;
  #define DMA_K(t,slot) glds16(ksrc+(long)(t)*KVBLK*KP,(unsigned)__builtin_amdgcn_readfirstlane(kdst+(slot)))
  #define DMA_V(t,slot) glds16(vsrc+(long)(t)*KVBLK*KP,(unsigned)__builtin_amdgcn_readfirstlane(vdst+(slot)))
  const int vb0=(int)(lds0+LDS_V)+((lane>>4)&1)*32+(lane&3)*8+(4*hi+((lane&15)>>2))*64;
  const char*Kbase=shm+LDS_K; bf16x8 kf[8];
  const lds_cptr shm3=(lds_cptr)shm; const lds_cptr kp0=shm3+LDS_K+hi*1024+r32*16; const lds_cptr vp0=shm3+LDS_V+((lane>>4)&1)*32+(lane&3)*8+(4*hi+((lane&15)>>2))*64;
  const int NT=SKV/KVBLK;
  DMA_K(0,0);DMA_V(0,0);DMA_K(1,SLOTB);
  bf16x8 qr[4];
  #pragma unroll
  for(int d0=0;d0<4;++d0)qr[d0]=*reinterpret_cast<const bf16x8*>(&Qw[(long)r32*QP+d0*16+hi*8]);
  float mhat=0.f,l_reg=0.f;f32x16 o[2];o[0]=f32x16{};o[1]=f32x16{};f32x16 negm=f32x16{};asm volatile("":"+v"(negm));
  const int qrel=wid*QBLK+r32;
  #define CMASK(P0,P1,t) do{}while(0)
  bool resc=false;
  #define START(P0,P1) do{ const float rm=rowmax(P0,P1); resc=false; \
    { const float dl=rm; mhat=fadd_s(mhat,dl); \
      _Pragma("unroll") for(int r=0;r<16;++r){P0[r]=fsub_s(P0[r],dl);P1[r]=fsub_s(P1[r],dl);} \
      _Pragma("unroll") for(int r=0;r<16;++r)negm[r]=-mhat; asm volatile("":"+v"(negm)); } \
    _Pragma("unroll") for(int r=0;r<16;++r)P0[r]=__builtin_amdgcn_exp2f(P0[r]); }while(0)
  #define RESC() do{ if(resc){ asm volatile("s_waitcnt lgkmcnt(0)":::"memory"); \
      _Pragma("unroll") for(int d_=0;d_<2;++d_) _Pragma("unroll") for(int r=0;r<16;++r)o[d_][r]*=wsf[crow(r,hi)]; } }while(0)
  f32x16 pA0,pA1,pB0,pB1;
  int sl_prev=0,sl_cur=0,sl_next=SLOTB;
  #define ROT() do{sl_prev=sl_cur;sl_cur=sl_next;sl_next=(sl_next==(NSLOT-1)*SLOTB)?0:sl_next+SLOTB;}while(0)
  DMA_K(2,2*SLOTB);
  WAIT_BAR(3);
  qkt(pA0,pA1,Kbase,qr,negm,r32,hi);asm volatile("s_nop 15\n\ts_nop 7":"+v"(pA0),"+v"(pA1));CMASK(pA0,pA1,0);
  START(pA0,pA1);
  _Pragma("unroll") for(int r=0;r<16;++r)pA1[r]=__builtin_amdgcn_exp2f(pA1[r]);
  WAIT_BAR(0);
  DMA_K(3,0);DMA_V(1,SLOTB);
  ROT();
  kload8(kf,kp0+sl_cur);
  WAIT_BAR(2);
  s16x4 vlo[8],vhi[8]; u32x4 pw0,pw1,pw2,pw3;
  #define PKW(P,B) cvtpk_s(P[B],P[B+1])
  #define PAF(k) __builtin_bit_cast(bf16x8,pw##k)
  #define VFR(i) (bf16x8){vlo[i][0],vlo[i][1],vlo[i][2],vlo[i][3],vhi[i][0],vhi[i][1],vhi[i][2],vhi[i][3]}
  #define PIN(x) asm volatile("":"+v"(x))
  #define MX3(a,b,c) __builtin_fmaxf(__builtin_fmaxf((a),(b)),(c))
  #define GAPA(MF,A0,A1,A2,A3,W0,W1,PW) do{ MF; sacc+=A0; sacc+=A1; sacc+=A2; sacc+=A3; PIN(sacc); W0; W1; PIN(PW); SBAR(); }while(0)
  #define EX(v) __builtin_amdgcn_exp2f(v)
  #define GAPB(MF,X,B) do{ MF; X[B]=EX(X[B]); X[B+1]=EX(X[B+1]); X[B+2]=EX(X[B+2]); X[B+3]=EX(X[B+3]); PIN(X); SBAR(); }while(0)
  #define VRD(i) do{ vlo[i]=vtr(vp_+(((i)>>2)*4096+((i)&3)*1024)); vhi[i]=vtr(vp_+(((i)>>2)*4096+((i)&3)*1024+512)); }while(0)
  #define KRD(G,j) do{ if(G){ kload2(kf,kp0+sl_next,j); SBAR(); } }while(0)
  #define STEP(C0,C1,P0,P1,t,GK,GV,GL) do{ SBAR(); \
    const lds_cptr vp_=vp0+sl_prev; \
    VRD(0); SBAR(); float sacc=(P0[0]+P0[1]); \
    GAPA(C0=__builtin_amdgcn_mfma_f32_32x32x16_bf16(kf[0],qr[0],negm,0,0,0), P0[2],P0[3],P0[4],P0[5],     pw0[0]=PKW(P0,0), pw0[1]=PKW(P0,2), pw0); \
    VRD(4); SBAR(); GAPA(C1=__builtin_amdgcn_mfma_f32_32x32x16_bf16(kf[1],qr[0],negm,0,0,0), P0[6],P0[7],P0[8],P0[9],     pw0[2]=PKW(P0,4), pw0[3]=PKW(P0,6), pw0); \
    VRD(1); SBAR(); GAPA(C0=__builtin_amdgcn_mfma_f32_32x32x16_bf16(kf[2],qr[1],C0,0,0,0),   P0[10],P0[11],P0[12],P0[13], pw1[0]=PKW(P0,8), pw1[1]=PKW(P0,10), pw1); \
    VRD(5); SBAR(); GAPA(C1=__builtin_amdgcn_mfma_f32_32x32x16_bf16(kf[3],qr[1],C1,0,0,0),   P0[14],P0[15],P1[0],P1[1],   pw1[2]=PKW(P0,12),pw1[3]=PKW(P0,14), pw1); \
    VRD(2); SBAR(); GAPA(C0=__builtin_amdgcn_mfma_f32_32x32x16_bf16(kf[4],qr[2],C0,0,0,0),   P1[2],P1[3],P1[4],P1[5],     pw2[0]=PKW(P1,0), pw2[1]=PKW(P1,2), pw2); \
    VRD(6); SBAR(); GAPA(C1=__builtin_amdgcn_mfma_f32_32x32x16_bf16(kf[5],qr[2],C1,0,0,0),   P1[6],P1[7],P1[8],P1[9],     pw2[2]=PKW(P1,4), pw2[3]=PKW(P1,6), pw2); \
    VRD(3); SBAR(); GAPA(C0=__builtin_amdgcn_mfma_f32_32x32x16_bf16(kf[6],qr[3],C0,0,0,0),   P1[10],P1[11],P1[12],P1[13], pw3[0]=PKW(P1,8), pw3[1]=PKW(P1,10), pw3); \
    VRD(7); SBAR(); GAPA(C1=__builtin_amdgcn_mfma_f32_32x32x16_bf16(kf[7],qr[3],C1,0,0,0),   P1[14],P1[15],0.f,0.f,       pw3[2]=PKW(P1,12),pw3[3]=PKW(P1,14), pw3); \
    l_reg+=sacc; \
    if(GK){DMA_K((t)+3,sl_cur);} if(GV){DMA_V((t)+1,sl_next);} \
    CMASK(C0,C1,t); \
    { float a=MX3(C0[0],C0[1],C1[0]),b=MX3(C0[2],C0[3],C1[1]); a=MX3(a,C1[2],C1[3]); \
      _Pragma("unroll") for(int r=4;r<16;r+=4){a=MX3(a,C0[r],C0[r+1]);b=MX3(b,C0[r+2],C0[r+3]);a=MX3(a,C1[r],C1[r+1]);b=MX3(b,C1[r+2],C1[r+3]);} \
      float rm=__builtin_fmaxf(a,b); { auto rr=__builtin_amdgcn_permlane32_swap(__float_as_uint(rm),__float_as_uint(rm),false,false); rm=__builtin_fmaxf(__uint_as_float(rr[0]),__uint_as_float(rr[1])); } \
      resc=false; \
      if(__builtin_expect(__any(rm>(float)THRL),0)){ const float dl=__builtin_fmaxf(rm,0.f); mhat+=dl; \
        _Pragma("unroll") for(int r=0;r<16;++r){C0[r]-=dl;C1[r]-=dl;} \
        _Pragma("unroll") for(int r=0;r<16;++r)negm[r]=-mhat; asm volatile("":"+v"(negm)); \
        const float f=__builtin_amdgcn_exp2f(-dl); l_reg*=f; if(hi==0)wsf[r32]=f; resc=true; } } \
    SBAR(); \
    GAPB(o[0]=__builtin_amdgcn_mfma_f32_32x32x16_bf16(PAF(0),VFR(0),o[0],0,0,0), C0,0); \
    GAPB(o[1]=__builtin_amdgcn_mfma_f32_32x32x16_bf16(PAF(0),VFR(4),o[1],0,0,0), C0,4); \
    KRD(GL,0); GAPB(o[0]=__builtin_amdgcn_mfma_f32_32x32x16_bf16(PAF(1),VFR(1),o[0],0,0,0), C0,8); \
    KRD(GL,1); GAPB(o[1]=__builtin_amdgcn_mfma_f32_32x32x16_bf16(PAF(1),VFR(5),o[1],0,0,0), C0,12); \
    KRD(GL,2); GAPB(o[0]=__builtin_amdgcn_mfma_f32_32x32x16_bf16(PAF(2),VFR(2),o[0],0,0,0), C1,0); \
    KRD(GL,3); GAPB(o[1]=__builtin_amdgcn_mfma_f32_32x32x16_bf16(PAF(2),VFR(6),o[1],0,0,0), C1,4); \
    GAPB(o[0]=__builtin_amdgcn_mfma_f32_32x32x16_bf16(PAF(3),VFR(3),o[0],0,0,0), C1,8); \
    GAPB(o[1]=__builtin_amdgcn_mfma_f32_32x32x16_bf16(PAF(3),VFR(7),o[1],0,0,0), C1,12); \
    }while(0)
  int t=1;
  #undef CMASK
  #define CMASK(P0,P1,t) do{}while(0)
  for(;t+5<NT;t+=2){
    STEP(pB0,pB1,pA0,pA1,t,true,true,true);     WAIT_BAR(2); RESC(); ROT();
    STEP(pA0,pA1,pB0,pB1,t+1,true,true,true);   WAIT_BAR(2); RESC(); ROT();
  }
  #undef CMASK
  #define CMASK(P0,P1,t) do{}while(0)
  #define ENDW(tt) do{ if((tt)+3<NT){WAIT_BAR(2);} else if((tt)+2<NT){WAIT_BAR(1);} else {WAIT_BAR(0);} }while(0)
  for(;t+1<NT;t+=2){
    STEP(pB0,pB1,pA0,pA1,t,(t+3<NT),(t+1<NT),(t+1<NT));       ENDW(t);   RESC(); ROT();
    STEP(pA0,pA1,pB0,pB1,t+1,(t+4<NT),(t+2<NT),(t+2<NT));     ENDW(t+1); RESC(); ROT();
  }
  STEP(pB0,pB1,pA0,pA1,NT-1,false,false,false); RESC();
  { float sacc=pB0[0]+pB0[1]; _Pragma("unroll") for(int r=2;r<16;++r)sacc+=pB0[r]; _Pragma("unroll") for(int r=0;r<16;++r)sacc+=pB1[r]; l_reg+=sacc;
    pw0=(u32x4){PKW(pB0,0),PKW(pB0,2),PKW(pB0,4),PKW(pB0,6)};pw1=(u32x4){PKW(pB0,8),PKW(pB0,10),PKW(pB0,12),PKW(pB0,14)};pw2=(u32x4){PKW(pB1,0),PKW(pB1,2),PKW(pB1,4),PKW(pB1,6)};pw3=(u32x4){PKW(pB1,8),PKW(pB1,10),PKW(pB1,12),PKW(pB1,14)};
    SBAR(); pv(o,vb0+sl_cur,PAF(0),PAF(1),PAF(2),PAF(3)); }
  #undef PKW
  #undef PAF
  #undef VFR
  #undef PIN
  #undef MX3
  #undef GAPA
  #undef GAPB
  #undef EX
  #undef VRD
  #undef KRD
  #undef STEP
  #undef ENDW
  {auto rr=__builtin_amdgcn_permlane32_swap(__float_as_uint(l_reg),__float_as_uint(l_reg),false,false);l_reg=__uint_as_float(rr[0])+__uint_as_float(rr[1]);}
  if(hi==0)wsf[32+r32]=l_reg;asm volatile("s_waitcnt lgkmcnt(0)":::"memory");
  float rli[16];
  #pragma unroll
  for(int r=0;r<16;++r)rli[r]=__builtin_amdgcn_rcpf(wsf[32+crow(r,hi)]);
  bf16*Ow=O+(rowbase+q0+wid*QBLK)*OP+h*D;
  { bf16*stg=(bf16*)(shm+LDS_OST)+wid*2048;
    #pragma unroll
    for(int r=0;r<16;++r){const int orow=crow(r,hi);
      #pragma unroll
      for(int d0=0;d0<2;++d0)stg[orow*64+d0*32+r32]=__float2bfloat16(o[d0][r]*rli[r]);}
    asm volatile("s_waitcnt lgkmcnt(0)":::"memory");
    #pragma unroll
    for(int i=0;i<4;++i){const int row=i*8+(lane>>3),ch=lane&7; const u32x4 v=*(const u32x4*)(stg+row*64+ch*8); ATTN_STORE16(Ow+(long)row*OP+ch*8,v);} }
  asm volatile("s_waitcnt lgkmcnt(0)\n\ts_barrier":::"memory");
  #undef DMA_K
  #undef DMA_V
  #undef CMASK
  #undef START
  #undef RESC
  #undef ROT
}
constexpr int ATTN_LDS_BYTES=LDS_BYTES;
struct AttnTensors { const bf16* Q; const bf16* K; const bf16* V; bf16* O; };
struct AttnUnit { int b; int h; int qb; };
struct StaticOrder {
  int vcu, G;
  __device__ __forceinline__ StaticOrder(int grid,int v):vcu(v),G(grid){}
  __device__ __forceinline__ bool next(int i,AttnUnit&u)const{ const int L=(i>>3)*G+vcu; if(L>=256)return false; u.b=L>>3; u.qb=L&7; u.h=i&7; return true; }
};
template<class Sched,int THRL=8> __device__ __forceinline__ void attn_phase(char*lds,const AttnTensors&T,const Sched&S){
  AttnUnit u;
  for(int i=0;S.next(i,u);++i){ attn_unit<THRL>(u.b,u.h,u.qb,T.Q,T.K,T.V,T.O,lds); }
}
#undef SBAR
#undef WAIT_BAR
}
#ifndef PROBE_ML
#define PROBE_ML 0
#endif
namespace ml {
#define MLT(k, WHICH) if (PROBE_ML == (k)) { const unsigned long long _t = wall_clock64(); if (WHICH) mlacc += _t - mlt0; else mlt0 = _t; }
#define MLBAR() asm volatile("s_waitcnt lgkmcnt(0)\n\ts_barrier" ::: "memory")
constexpr int PQ = 272, PT = 144;
constexpr int O_Q = 0, O_K = O_Q + 64 * PQ, O_KTW = O_K + 64 * PQ, O_VT = O_KTW + 128 * PT, O_P = O_VT + 144 * PT, O_CB = O_P + 64 * PT, O_GT = O_CB + 144 * PQ, O_CW = O_GT + 2 * 1280, O_END = O_CW + 4096;
static_assert(O_END <= LDSCTL_OFF, "mlstm LDS map");
struct Raw { u32x4 q[3][2], k[3][2], v[2]; float li, lf; };
template <int CTRL> __device__ __forceinline__ float dpp_or(float v, float ident) { return __uint_as_float((unsigned)__builtin_amdgcn_update_dpp((int)__float_as_uint(ident), (int)__float_as_uint(v), CTRL, 0xF, 0xF, false)); }
template <int CTRL, int ROWMASK> __device__ __forceinline__ float dpp_bc(float v, float ident) { return __uint_as_float((unsigned)__builtin_amdgcn_update_dpp((int)__float_as_uint(ident), (int)__float_as_uint(v), CTRL, ROWMASK, 0xF, false)); }
__device__ __forceinline__ float bflo(unsigned w) { return __uint_as_float(w << 16); }
__device__ __forceinline__ float bfhi(unsigned w) { return __uint_as_float(w & 0xffff0000u); }
__device__ __forceinline__ int chunk_pos(int c, int r, int dir) { return dir == 0 ? 64 * c + r : (c < 4 ? 255 - 64 * c - r : 2303 - 64 * (c - 4) - r); }
__device__ __forceinline__ void load_chunk(Raw& R, int c, int lane, int w, int b, int head, int dir, const bf16* MQ, const bf16* MK, const bf16* MV, const float* GATES) {
    const int pos = chunk_pos(c, 8 * w + (lane >> 3), dir); const int lo = pos < CL ? 0 : CL, hi = pos < CL ? CL : SL;
    const size_t sr = (size_t)b * SL + pos; const size_t co = (size_t)head * MD + 16 * (lane & 7);
    const u32x4 z = {0u, 0u, 0u, 0u};
#pragma unroll
    for (int j = 0; j < 3; ++j) { const int pp = pos + j - 1; const bool ok = pp >= lo && pp < hi; const size_t o = (sr + j - 1) * MW + co;
        R.q[j][0] = ok ? *(const u32x4*)(MQ + o) : z; R.q[j][1] = ok ? *(const u32x4*)(MQ + o + 8) : z;
        R.k[j][0] = ok ? *(const u32x4*)(MK + o) : z; R.k[j][1] = ok ? *(const u32x4*)(MK + o + 8) : z; }
    R.v[0] = *(const u32x4*)(MV + sr * MW + co); R.v[1] = *(const u32x4*)(MV + sr * MW + co + 8);
    const size_t srg = (size_t)b * SL + chunk_pos(c, lane, dir);
    R.li = GATES[srg * 16 + dir * 4 + head]; R.lf = GATES[srg * 16 + 8 + dir * 4 + head];
}
constexpr int CV_K = 32, CVA_PER_E = 8 * (D / CV_K), CVA_ITEMS = NE * CVA_PER_E, CVB_PER_E = 16 * (EFF / CV_K), CVB_ITEMS = NE * CVB_PER_E;
struct CvItem { const float* src; bf16* dst; unsigned sld; };
__device__ __forceinline__ CvItem cv_decode_gu(int it, int lane, const float* w_eg, const float* w_eu, bf16* WGU) {
    const int e = it / CVA_PER_E, r = it % CVA_PER_E; CvItem c;
    const int rb = r / (D / CV_K), kb = r % (D / CV_K), p0 = (64 * rb) & 255, up = p0 >> 7, col0 = 128 * (rb >> 2) + (p0 & 127);
    c.src = (up ? w_eu : w_eg) + (size_t)e * D * EFF + (size_t)(CV_K * kb) * EFF + col0 + lane; c.sld = EFF;
    c.dst = WGU + (size_t)e * 512 * D + (size_t)(64 * rb + lane) * D + CV_K * kb;
    return c;
}
__device__ __forceinline__ CvItem cv_decode_dn(int it, int lane, const float* w_ed, bf16* WD) {
    const int e = it / CVB_PER_E, q = it % CVB_PER_E, rb = q / (EFF / CV_K), kb = q % (EFF / CV_K); CvItem c;
    const int cs = 64 * rb + lane, drow = (cs & ~255) + 128 * ((cs >> 3) & 1) + 32 * ((cs >> 6) & 3) + 8 * ((cs >> 4) & 3) + (cs & 7);
    c.src = w_ed + (size_t)e * EFF * D + (size_t)(CV_K * kb) * D + cs; c.sld = D;
    c.dst = WD + (size_t)e * D * EFF + (size_t)drow * EFF + CV_K * kb;
    return c;
}
__device__ __forceinline__ void cv_load(float (&v)[CV_K], const CvItem& c) {
#pragma unroll
    for (int i = 0; i < CV_K; ++i) v[i] = __builtin_nontemporal_load(c.src + (size_t)i * c.sld);
}
__device__ __forceinline__ void cv_store(const float (&v)[CV_K], const CvItem& c) {
#pragma unroll
    for (int g = 0; g < CV_K / 8; ++g) { u32x4 o; o.x = cvt_pk_bf16_s(v[8 * g], v[8 * g + 1]); o.y = cvt_pk_bf16_s(v[8 * g + 2], v[8 * g + 3]); o.z = cvt_pk_bf16_s(v[8 * g + 4], v[8 * g + 5]); o.w = cvt_pk_bf16_s(v[8 * g + 6], v[8 * g + 7]);
        *(u32x4*)(c.dst + 8 * g) = o; }
}
__device__ __forceinline__ void mlstm_phase(Frame& F, const Args& a, unsigned long long& mlacc) {
    unsigned long long mlt0 = 0;
    int tid = threadIdx.x; asm volatile("" : "+v"(tid));
    const int lane = tid & 63, w = __builtin_amdgcn_readfirstlane(tid >> 6), l15 = lane & 15, l4 = lane >> 4;
    LAS unsigned char* L = F.lds;
    const bf16* MQ = (const bf16*)(F.dout + DO_MQ); const bf16* MK = (const bf16*)(F.dout + DO_MK); const bf16* MV = (const bf16*)(F.dout + DO_MV);
    const float* GATES = (const float*)(F.ws + WS_GATES); bf16* H = (bf16*)(F.ws + WS_H);
    const float* conv_w = a.in[13]; const float* conv_b = a.in[14];
    LAS float* CW = (LAS float*)(L + O_CW);
    const float* w_eg = a.in[23]; const float* w_eu = a.in[24]; const float* w_ed = a.in[25]; bf16* WGU = (bf16*)(F.ws + WS_RW); bf16* WD = (bf16*)(F.ws + WS_RW + 256 * MiB);
    int cv_it = F.vcu * NWAVES + w; const int cv_stride = F.G * NWAVES;
    for (int seq = F.vcu; seq < NB * MH * 2; seq += F.G) {
        const int b = seq >> 3, head = (seq >> 1) & 3, dir = seq & 1;
        __syncthreads();
        for (int i = tid; i < 1024; i += 512) { const int part = i >> 7, d = i & 127, kq = part >> 2, j = part & 3, ch = kq * 512 + head * MD + d; CW[i] = j < 3 ? conv_w[j * 1024 + ch] : conv_b[ch]; }
        for (int i = tid; i < 144 * PQ / 4; i += 512) ((LAS unsigned*)(L + O_CB))[i] = 0u;
        for (int i = tid; i < 16 * PT / 4; i += 512) ((LAS unsigned*)(L + O_VT + 128 * PT))[i] = (i < PT / 4) ? 0x3F803F80u : 0u;
        f32x4 accC[9];
#pragma unroll
        for (int i = 0; i < 9; ++i) accC[i] = (f32x4){0.f, 0.f, 0.f, 0.f};
        float m = 0.f;
        Raw R; load_chunk(R, 0, lane, w, b, head, dir, MQ, MK, MV, GATES);
        __syncthreads();
        for (int c = 0; c < SL / 64; ++c) {
            LAS float* GT = (LAS float*)(L + O_GT + (c & 1) * 1280);
            MLT(1, 0) MLT(5, 0)
            float bcs = R.lf;
            bcs += dpp_or<0x111>(bcs, 0.f); bcs += dpp_or<0x112>(bcs, 0.f); bcs += dpp_or<0x114>(bcs, 0.f); bcs += dpp_or<0x118>(bcs, 0.f);
            bcs += dpp_bc<0x142, 0xA>(bcs, 0.f); bcs += dpp_bc<0x143, 0xC>(bcs, 0.f);
            const float u = R.li - bcs; float pm = u;
            pm = fmaxf(pm, dpp_or<0x111>(pm, -INFINITY)); pm = fmaxf(pm, dpp_or<0x112>(pm, -INFINITY)); pm = fmaxf(pm, dpp_or<0x114>(pm, -INFINITY)); pm = fmaxf(pm, dpp_or<0x118>(pm, -INFINITY));
            pm = fmaxf(pm, dpp_bc<0x142, 0xA>(pm, -INFINITY)); pm = fmaxf(pm, dpp_bc<0x143, 0xC>(pm, -INFINITY));
            const float mq = fmaxf(bcs + m, bcs + pm);
            const float bL = __shfl(bcs, 63), umax = __shfl(pm, 63);
            const float m_new = fmaxf(bL + m, bL + umax), wsv = __expf(bL + u - m_new), w_old = __expf(bL + m - m_new);
            if (w == 0) { GT[lane] = bcs - mq; GT[64 + lane] = u; GT[128 + lane] = __expf(bcs + m - mq); GT[192 + lane] = __expf(-mq); }
            {
                const int rr = lane >> 3, dc = lane & 7, rowl = 8 * w + rr; const float wsr = __shfl(wsv, rowl);
                { float qv[16];
#pragma unroll
                  for (int g = 0; g < 4; ++g) { f32x4 wq[4];
#pragma unroll
                      for (int j = 0; j < 4; ++j) wq[j] = *(const LAS f32x4*)(CW + j * 128 + 16 * dc + 4 * g);
#pragma unroll
                      for (int e = 0; e < 4; ++e) { const int i = 4 * g + e, hv = i >> 3, wd = (i & 7) >> 1; float xq[3];
#pragma unroll
                          for (int j = 0; j < 3; ++j) { const unsigned uq = R.q[j][hv][wd]; xq[j] = (i & 1) ? bfhi(uq) : bflo(uq); }
                          qv[i] = siluf_(wq[0][e] * xq[0] + wq[1][e] * xq[1] + wq[2][e] * xq[2] + wq[3][e]) * 0.08838834764831845f; } }
                  u32x4 p0, p1;
                  p0.x = cvt_pk_bf16(qv[0], qv[1]); p0.y = cvt_pk_bf16(qv[2], qv[3]); p0.z = cvt_pk_bf16(qv[4], qv[5]); p0.w = cvt_pk_bf16(qv[6], qv[7]);
                  p1.x = cvt_pk_bf16(qv[8], qv[9]); p1.y = cvt_pk_bf16(qv[10], qv[11]); p1.z = cvt_pk_bf16(qv[12], qv[13]); p1.w = cvt_pk_bf16(qv[14], qv[15]);
                  *(LAS u32x4*)(L + O_Q + rowl * PQ + dc * 32) = p0; *(LAS u32x4*)(L + O_Q + rowl * PQ + dc * 32 + 16) = p1; }
                { float kv[16];
#pragma unroll
                  for (int g = 0; g < 4; ++g) { f32x4 wk[4];
#pragma unroll
                      for (int j = 0; j < 4; ++j) wk[j] = *(const LAS f32x4*)(CW + 512 + j * 128 + 16 * dc + 4 * g);
#pragma unroll
                      for (int e = 0; e < 4; ++e) { const int i = 4 * g + e, hv = i >> 3, wd = (i & 7) >> 1; float xk[3];
#pragma unroll
                          for (int j = 0; j < 3; ++j) { const unsigned uk = R.k[j][hv][wd]; xk[j] = (i & 1) ? bfhi(uk) : bflo(uk); }
                          kv[i] = siluf_(wk[0][e] * xk[0] + wk[1][e] * xk[1] + wk[2][e] * xk[2] + wk[3][e]); } }
                  u32x4 p0, p1;
                  p0.x = cvt_pk_bf16(kv[0], kv[1]); p0.y = cvt_pk_bf16(kv[2], kv[3]); p0.z = cvt_pk_bf16(kv[4], kv[5]); p0.w = cvt_pk_bf16(kv[6], kv[7]);
                  p1.x = cvt_pk_bf16(kv[8], kv[9]); p1.y = cvt_pk_bf16(kv[10], kv[11]); p1.z = cvt_pk_bf16(kv[12], kv[13]); p1.w = cvt_pk_bf16(kv[14], kv[15]);
                  *(LAS u32x4*)(L + O_K + rowl * PQ + dc * 32) = p0; *(LAS u32x4*)(L + O_K + rowl * PQ + dc * 32 + 16) = p1;
#pragma unroll
                  for (int i = 0; i < 16; ++i) {
                      *(LAS bf16*)(L + O_KTW + (16 * dc + i) * PT + ((w ^ dc) * 16) + rr * 2) = f2bf(kv[i] * wsr);
                      const unsigned uv = R.v[i >> 3][(i & 7) >> 1]; *(LAS bf16*)(L + O_VT + (16 * dc + i) * PT + ((w ^ dc) * 16) + rr * 2) = (bf16)((i & 1) ? (uv >> 16) : (uv & 0xffffu)); } }
            }
            if (c + 1 < SL / 64) load_chunk(R, c + 1, lane, w, b, head, dir, MQ, MK, MV, GATES);
            MLT(5, 1)
            MLBAR();
            MLT(1, 1) MLT(2, 0)
            const bool outp = c >= 4;
            const int nb = w & 3, mb0 = (w >> 2) * 4, nmb = 4 + (w >> 2);
            f32x4 nacc[5];
#pragma unroll
            for (int i = 0; i < 5; ++i) nacc[i] = (f32x4){0.f, 0.f, 0.f, 0.f};
            if (outp) {
                bf16x8 qf[4];
#pragma unroll
                for (int ks = 0; ks < 4; ++ks) qf[ks] = *(const LAS bf16x8*)(L + O_Q + (16 * nb + l15) * PQ + (32 * ks + 8 * l4) * 2);
                const float bmj = GT[16 * nb + l15];
#pragma unroll
                for (int mi = 0; mi < 2; ++mi) { const int mb = 2 * (w >> 2) + mi; f32x4 sacc = {0.f, 0.f, 0.f, 0.f};
#pragma unroll
                    for (int ks = 0; ks < 4; ++ks) { const bf16x8 kf = *(const LAS bf16x8*)(L + O_K + (16 * mb + l15) * PQ + (32 * ks + 8 * l4) * 2); sacc = __builtin_amdgcn_mfma_f32_16x16x32_bf16(kf, qf[ks], sacc, 0, 0, 0); }
                    const f32x4 uu = *(const LAS f32x4*)(GT + 64 + 16 * mb + 4 * l4); float pv[4];
#pragma unroll
                    for (int r = 0; r < 4; ++r) { const int s = 16 * mb + 4 * l4 + r, j = 16 * nb + l15; pv[r] = (s <= j) ? sacc[r] * __expf(bmj + uu[r]) : 0.f; }
                    u32x2 pk; pk.x = cvt_pk_bf16_s(pv[0], pv[1]); pk.y = cvt_pk_bf16_s(pv[2], pv[3]);
                    *(LAS u32x2*)(L + O_P + (16 * nb + l15) * PT + (16 * mb + 4 * l4) * 2) = pk; }
                const float wij = GT[128 + 16 * nb + l15];
#pragma unroll
                for (int i = 0; i < 5; ++i) if (i < nmb) { const int mb = mb0 + i;
#pragma unroll
                    for (int ks = 0; ks < 4; ++ks) { const bf16x8 cf = *(const LAS bf16x8*)(L + O_CB + (16 * mb + l15) * PQ + (32 * ks + 8 * l4) * 2); nacc[i] = __builtin_amdgcn_mfma_f32_16x16x32_bf16(cf, qf[ks], nacc[i], 0, 0, 0); }
                    nacc[i] = nacc[i] * wij; }
                MLBAR();
                bf16x8 pf[2];
#pragma unroll
                for (int ks = 0; ks < 2; ++ks) pf[ks] = *(const LAS bf16x8*)(L + O_P + (16 * nb + l15) * PT + (32 * ks + 8 * l4) * 2);
#pragma unroll
                for (int i = 0; i < 5; ++i) if (i < nmb) { const int mb = mb0 + i;
#pragma unroll
                    for (int ks = 0; ks < 2; ++ks) { const bf16x8 vf = *(const LAS bf16x8*)(L + O_VT + (16 * mb + l15) * PT + (((4 * ks + l4) ^ (mb & 7)) * 16)); nacc[i] = __builtin_amdgcn_mfma_f32_16x16x32_bf16(vf, pf[ks], nacc[i], 0, 0, 0); } }
                if (w >= 4 && l4 == 0) GT[256 + 16 * nb + l15] = nacc[4][0];
            }
            MLT(2, 1) MLT(3, 0)
            float cvv[CV_K]; const bool cv_on = cv_it < CVA_ITEMS;
            if (cv_on) { const CvItem cvi = cv_decode_gu(cv_it, lane, w_eg, w_eu, WGU); cv_load(cvv, cvi); }
            {
                bf16x8 kt[2];
#pragma unroll
                for (int ks = 0; ks < 2; ++ks) kt[ks] = *(const LAS bf16x8*)(L + O_KTW + (16 * w + l15) * PT + (((4 * ks + l4) ^ w) * 16));
#pragma unroll
                for (int n2 = 0; n2 < 9; ++n2) { accC[n2] = accC[n2] * w_old;
#pragma unroll
                    for (int ks = 0; ks < 2; ++ks) { const bf16x8 vf = *(const LAS bf16x8*)(L + O_VT + (16 * n2 + l15) * PT + (((4 * ks + l4) ^ (n2 & 7)) * 16)); accC[n2] = __builtin_amdgcn_mfma_f32_16x16x32_bf16(kt[ks], vf, accC[n2], 0, 0, 0); }
                    u32x2 pk; pk.x = cvt_pk_bf16_s(accC[n2][0], accC[n2][1]); pk.y = cvt_pk_bf16_s(accC[n2][2], accC[n2][3]);
                    *(LAS u32x2*)(L + O_CB + (16 * n2 + l15) * PQ + (16 * w + 4 * l4) * 2) = pk; }
            }
            MLBAR();
            MLT(3, 1) MLT(4, 0)
            if (outp) {
                const int j = 16 * nb + l15; const float den = GT[256 + j], emq = GT[192 + j]; const float inv = __builtin_amdgcn_rcpf(fmaxf(fabsf(den), emq));
                const int t = chunk_pos(c, j, dir) - CL;
                bf16* hp = H + ((size_t)dir * T + (size_t)b * S + t) * MW + head * MD + 4 * l4;
#pragma unroll
                for (int i = 0; i < 4; ++i) { const int mb = mb0 + i; const f32x4 hv = nacc[i] * inv;
                    u32x2 pk; pk.x = cvt_pk_bf16_s(hv[0], hv[1]); pk.y = cvt_pk_bf16_s(hv[2], hv[3]); *(u32x2*)(hp + 16 * mb) = pk; }
            }
            if (cv_on) { const CvItem cvi = cv_decode_gu(cv_it, lane, w_eg, w_eu, WGU); cv_store(cvv, cvi); cv_it += cv_stride; }
            MLT(4, 1)
            m = m_new;
        }
    }
    for (; cv_it < CVA_ITEMS; cv_it += cv_stride) { float cvv[CV_K]; const CvItem cvi = cv_decode_gu(cv_it, lane, w_eg, w_eu, WGU); cv_load(cvv, cvi); cv_store(cvv, cvi); }
    __syncthreads();
}
__device__ __forceinline__ void mlstm_combine(Frame& F, const Args& a, int panel  ) {
    int tid = threadIdx.x; asm volatile("" : "+v"(tid));
    const int lane = tid & 63, wv = __builtin_amdgcn_readfirstlane(tid >> 6);
    const bf16* H = (const bf16*)(F.ws + WS_H); const bf16* MO = (const bf16*)(F.ws + WS_MO); bf16* AM = (bf16*)(F.ws + WS_RA); const float* g = a.in[17];
    const f32x4 g0 = *(const f32x4*)(g + 8 * lane), g1 = *(const f32x4*)(g + 8 * lane + 4);
    const int gw = F.vcu * NWAVES + wv, NGW = F.G * NWAVES;
    const int rbeg = panel >= 0 ? panel * 256 + wv * 32 : gw, rend = panel >= 0 ? rbeg + 32 : T, rstep = panel >= 0 ? 1 : NGW;
    for (int row = rbeg; row < rend; row += rstep) {
        const u32x4 hf = *(const u32x4*)(H + (size_t)row * MW + 8 * lane), hb = *(const u32x4*)(H + ((size_t)T + row) * MW + 8 * lane), mo = *(const u32x4*)(MO + (size_t)row * MW + 8 * lane);
        float v[8], s[8]; float ss = 0.f;
#pragma unroll
        for (int q = 0; q < 4; ++q) { v[2 * q] = bflo(hf[q]) + bflo(hb[q]); v[2 * q + 1] = bfhi(hf[q]) + bfhi(hb[q]); s[2 * q] = sigmoidf_(bflo(mo[q])); s[2 * q + 1] = sigmoidf_(bfhi(mo[q])); ss += v[2 * q] * v[2 * q] + v[2 * q + 1] * v[2 * q + 1]; }
        ss += __shfl_xor(ss, 1); ss += __shfl_xor(ss, 2); ss += __shfl_xor(ss, 4); ss += __shfl_xor(ss, 8);
        const float rs = rsqrtf(ss * (1.f / MD) + EPS);
        u32x4 o; o.x = cvt_pk_bf16(v[0] * rs * g0[0] * s[0], v[1] * rs * g0[1] * s[1]); o.y = cvt_pk_bf16(v[2] * rs * g0[2] * s[2], v[3] * rs * g0[3] * s[3]);
        o.z = cvt_pk_bf16(v[4] * rs * g1[0] * s[4], v[5] * rs * g1[1] * s[5]); o.w = cvt_pk_bf16(v[6] * rs * g1[2] * s[6], v[7] * rs * g1[3] * s[7]);
        *(u32x4*)(AM + (size_t)row * D + AW + 8 * lane) = o;
    }
}
}
__device__ __forceinline__ void tile_of(int L, int nN, int& pm, int& pn) {
    const int nwg = 256 * nN, q = nwg / 8; int wgid = (L % 8) * q + L / 8;
    const int nig = 8 * nN, gid = wgid / nig, fm = gid * 8; pm = fm + ((wgid % nig) % 8); pn = (wgid % nig) / 8;
}
struct ProgMerge {
    const char* AM; const char* WAT; const char* WMT; bf16* Y; const bf16* GA; int G, c, panel;
    __device__ __forceinline__ bool next(int i, eng::UnitD& u, LAS unsigned char*) const {
        int pm, pn; const int part = i & 1;
        if (panel >= 0) { if (i >= 8) return false; pm = panel; pn = i >> 1; }
        else { const long L = (long)(i >> 1) * G + c; if (L >= 1024) return false; tile_of((int)L, 4, pm, pn); }
        u.A = AM + (size_t)pm * (256 * 2048) + part * 1024; u.B = (part ? WMT : WAT) + (size_t)pn * (256 * 1024); u.lda = 2048; u.ldb = 1024; u.nt = 8; u.type = part; u.r0 = pm; u.r1 = pn; u.r2 = 0; u.r3 = 0; return true;
    }
    __device__ __forceinline__ void first(const eng::UnitD&, LAS unsigned char*) const {}
    __device__ __forceinline__ void prefetch(const eng::UnitD&, LAS unsigned char*) const {}
    __device__ __forceinline__ void offsets(const eng::UnitD& u, const int (&Rr)[2], const int (&Cc)[2], unsigned (&oA)[2][2], LAS unsigned char*) const {
#pragma unroll
        for (int h = 0; h < 2; ++h)
#pragma unroll
            for (int i = 0; i < 2; ++i) oA[h][i] = (unsigned)(128 * h + Rr[i]) * u.lda + (unsigned)Cc[i];
    }
    __device__ __forceinline__ void epilogue(eng::Acc& acc, const eng::UnitD& u, int wr, int wc, int fr, int fq, LAS unsigned char*) const {
        const size_t off0 = ((size_t)u.r0 * 256 + wr * 64 + fr) * D + u.r1 * 256 + wc * 32 + 8 * fq;
        const unsigned char* GAb = (const unsigned char*)GA; const unsigned char* GMb = GAb + 128 * MiB;
        const size_t goff0 = ((size_t)u.r0 * 256 + wr * 64 + fr) * D + u.r1 * 256 + wc * 64 + 16 * fq;
        if (u.type == 0) {
            u32x4 ga[2][4], gm[2][4];
#pragma unroll
            for (int ai = 0; ai < 2; ++ai)
#pragma unroll
                for (int m = 0; m < 4; ++m) { const size_t o = goff0 + (size_t)(ai * 128 + m * 16) * D; ga[ai][m] = *(const u32x4*)(GAb + o); gm[ai][m] = *(const u32x4*)(GMb + o); }
#pragma unroll
            for (int ai = 0; ai < 2; ++ai)
#pragma unroll
                for (int m = 0; m < 4; ++m)
#pragma unroll
                    for (int bj = 0; bj < 2; ++bj)
#pragma unroll
                        for (int n = 0; n < 2; ++n)
#pragma unroll
                            for (int e = 0; e < 4; ++e) { const float av = (float)((ga[ai][m][2 * bj + n] >> (8 * e)) & 0xffu) + 0.5f, mv = (float)((gm[ai][m][2 * bj + n] >> (8 * e)) & 0xffu) + 0.5f;
                                acc[ai][bj][m][n][e] *= av * __builtin_amdgcn_rcpf(mv); }
            __builtin_amdgcn_s_waitcnt(0x0F70);
            return; }
        u32x4 gm[2][4];
#pragma unroll
        for (int ai = 0; ai < 2; ++ai)
#pragma unroll
            for (int m = 0; m < 4; ++m) gm[ai][m] = *(const u32x4*)(GMb + goff0 + (size_t)(ai * 128 + m * 16) * D);
#pragma unroll
        for (int ai = 0; ai < 2; ++ai)
#pragma unroll
            for (int m = 0; m < 4; ++m) {
#pragma unroll
                for (int bj = 0; bj < 2; ++bj) { const size_t o = off0 + (size_t)(ai * 128 + m * 16) * D + bj * 128;
                    u32x4 w;
#pragma unroll
                    for (int q = 0; q < 4; ++q) { const int n = q >> 1, e = (q & 1) * 2; const unsigned gw_ = gm[ai][m][2 * bj + n];
                        const float m0 = ((float)((gw_ >> (8 * e)) & 0xffu) + 0.5f) * (1.f / 256.f), m1 = ((float)((gw_ >> (8 * e + 8)) & 0xffu) + 0.5f) * (1.f / 256.f);
                        w[q] = cvt_pk_bf16(m0 * acc[ai][bj][m][n][e], m1 * acc[ai][bj][m][n][e + 1]); }
                    *(u32x4*)(Y + o) = w; } }
        __builtin_amdgcn_s_waitcnt(0x0F70);
    }
};
struct ProgOut {
    const char* Yb; const char* WOT; bf16* YO; float* RS1; int G, c, panel;
    __device__ __forceinline__ bool next(int i, eng::UnitD& u, LAS unsigned char*) const {
        int pm, pn;
        if (panel >= 0) { if (i >= 4) return false; pm = panel; pn = i; }
        else { const long L = (long)i * G + c; if (L >= 1024) return false; tile_of((int)L, 4, pm, pn); }
        u.A = Yb + (size_t)pm * (256 * 2048); u.B = WOT + (size_t)pn * (256 * 2048); u.lda = 2048; u.ldb = 2048; u.nt = 16; u.type = 0; u.r0 = pm; u.r1 = pn; u.r2 = 0; u.r3 = 0; return true;
    }
    __device__ __forceinline__ void first(const eng::UnitD&, LAS unsigned char*) const {}
    __device__ __forceinline__ void prefetch(const eng::UnitD&, LAS unsigned char*) const {}
    __device__ __forceinline__ void offsets(const eng::UnitD& u, const int (&Rr)[2], const int (&Cc)[2], unsigned (&oA)[2][2], LAS unsigned char*) const {
#pragma unroll
        for (int h = 0; h < 2; ++h)
#pragma unroll
            for (int i = 0; i < 2; ++i) oA[h][i] = (unsigned)(128 * h + Rr[i]) * u.lda + (unsigned)Cc[i];
    }
    __device__ __forceinline__ void epilogue(eng::Acc& acc, const eng::UnitD& u, int wr, int wc, int fr, int fq, LAS unsigned char*) const {
        const size_t row0 = (size_t)u.r0 * 256 + wr * 64 + fr;
        eng::store_tile_bf16<0>(acc, YO + row0 * D + u.r1 * 256 + wc * 32 + 8 * fq, D);
#pragma unroll
        for (int ai = 0; ai < 2; ++ai)
#pragma unroll
            for (int m = 0; m < 4; ++m) { float ss = 0.f;
#pragma unroll
                for (int bj = 0; bj < 2; ++bj)
#pragma unroll
                    for (int n = 0; n < 2; ++n) { const f32x4 v = acc[ai][bj][m][n]; ss += (v[0] * v[0] + v[1] * v[1]) + (v[2] * v[2] + v[3] * v[3]); }
                ss += __shfl_xor(ss, 16); ss += __shfl_xor(ss, 32);
                if (fq == 0) RS1[(row0 + ai * 128 + m * 16) * 16 + u.r1 * 4 + wc] = ss; }
    }
};
template <bool WRITE_X1>
__device__ __forceinline__ void p6_rowpass(Frame& F, const Args& a, int panel) {
    int tid_ = threadIdx.x; asm volatile("" : "+v"(tid_)); const int lane = tid_ & 63, wave_ = __builtin_amdgcn_readfirstlane(tid_ >> 6);
    const float* x = a.in[0]; const f32x4* gpost = (const f32x4*)a.in[7]; const f32x4* gpre = (const f32x4*)a.in[8];
    const float* mod = (const float*)(F.ws + WS_MOD); const bf16* YO = (const bf16*)(F.ws + WS_RA); const float* RS1 = (const float*)(F.ws + WS_RS1); bf16* FIN = (bf16*)(F.ws + WS_GA);
    const int NGW = F.G * NWAVES; constexpr int RPW = 32;
    for (int gw = (panel >= 0 ? panel : F.vcu) * NWAVES + wave_; gw * RPW < T; gw += (panel >= 0 ? T : NGW)) {
        const int row0 = gw * RPW; const f32x4* mr = (const f32x4*)(mod + (size_t)(row0 / S) * (NMOD * D));
        f32x4 cg[4], csc[4], csh[4];
#pragma unroll
        for (int j = 0; j < 4; ++j) { const int i4 = 64 * j + lane; cg[j] = mr[512 + i4] * gpost[i4]; csc[j] = gpre[i4] * (mr[1024 + i4] + 1.f); csh[j] = mr[768 + i4]; }
        for (int row = row0; row < row0 + RPW; ++row) {
            const f32x4* xr = (const f32x4*)(x + (size_t)row * D); const u32x2* yr = (const u32x2*)(YO + (size_t)row * D);
            float s1 = (lane < 16) ? RS1[(size_t)row * 16 + lane] : 0.f;
            s1 += __shfl_xor(s1, 1); s1 += __shfl_xor(s1, 2); s1 += __shfl_xor(s1, 4); s1 += __shfl_xor(s1, 8);
            const float rs1 = rsqrtf(__shfl(s1, 0) * (1.f / D) + EPS);
            f32x4 v[4]; float ss = 0.f;
#pragma unroll
            for (int j = 0; j < 4; ++j) { const int i4 = 64 * j + lane; const u32x2 yb = yr[i4]; const f32x4 xv = __builtin_nontemporal_load(xr + i4);
                f32x4 y; y[0] = __uint_as_float(yb.x << 16); y[1] = __uint_as_float(yb.x & 0xffff0000u); y[2] = __uint_as_float(yb.y << 16); y[3] = __uint_as_float(yb.y & 0xffff0000u);
                v[j] = xv + cg[j] * (y * rs1); ss += (v[j][0] * v[j][0] + v[j][1] * v[j][1]) + (v[j][2] * v[j][2] + v[j][3] * v[j][3]); }
            const float rs2 = rsqrtf(wave_sum(ss) * (1.f / D) + EPS);
            u32x2* o8 = (u32x2*)(FIN + (size_t)row * D);
#pragma unroll
            for (int j = 0; j < 4; ++j) { const int i4 = 64 * j + lane;
                if (WRITE_X1) ((f32x4*)(a.out + (size_t)row * D))[i4] = v[j];
                const f32x4 o = v[j] * rs2 * csc[j] + csh[j];
                u32x2 w; w.x = cvt_pk_bf16(o[0], o[1]); w.y = cvt_pk_bf16(o[2], o[3]); o8[i4] = w; }
        }
    }
}
constexpr int NCH = 1, TCH = T / NCH;
constexpr float EO_SCALE = 16.f;
constexpr size_t WS_SCORE = WS_GM;
constexpr size_t WS_WGU = WS_RW, WS_WD = WS_RW + 256 * MiB;
constexpr size_t WS_HIDS = WS_H + 1 * MiB, WS_HIDSH = WS_H + 65 * MiB;
constexpr size_t EO_SKEW = 8448, WS_SH8 = WS_GA + 32 * MiB + 5 * EO_SKEW;
constexpr size_t WS_EOHI = WS_GM + EO_SKEW;
constexpr int CW_CNT2 = 2048, CW_FILL2 = 2560;
constexpr int LIST_CAP = 589824;
constexpr int LDS_TOFF = RING_BYTES;
constexpr int LDS_IDX = RING_BYTES + 4096;
__device__ __forceinline__ unsigned char* eo_row(unsigned char* dout, unsigned char* ws, int k, size_t tok) { return k < 4 ? dout + tok * 4096 + (size_t)k * 1024 : ws + WS_EOHI + tok * 4096 + (size_t)(k & 3) * 1024; }

__device__ __forceinline__ void p0_expert_weights(Frame& F, const Args& a) {
    int tid_ = threadIdx.x; asm volatile("" : "+v"(tid_)); const int lane_ = tid_ & 63, wave_ = __builtin_amdgcn_readfirstlane(tid_ >> 6);
    LAS float* scr = (LAS float*)(F.lds + wave_ * 16384);
    const int gw = F.vcu * NWAVES + wave_, NGW = F.G * NWAVES, lane = lane_;
    const float* w_eg = a.in[23]; const float* w_eu = a.in[24]; const float* w_ed = a.in[25];
    bf16* WGU = (bf16*)(F.ws + WS_WGU); bf16* WD = (bf16*)(F.ws + WS_WD);
    for (int it = gw; it < NE * 384; it += NGW) {
        const int e = it / 384, r = it % 384;
        if (r < 256) { const int job = r >> 6, q = r & 63, kb = q >> 2, nb = q & 3, n = job >> 1, up = job & 1;
            transpose_item((up ? w_eu : w_eg) + (size_t)e * D * EFF, EFF, 64 * kb, 128 * n + 32 * nb + (lane & 31), WGU + (size_t)e * 512 * D, D, 256 * n + 128 * up + 32 * nb, scr, lane); }
        else { const int q = r - 256, kb = q >> 5, nb = q & 31;
            transpose_item(w_ed + (size_t)e * EFF * D, D, 64 * kb, 32 * nb + (lane & 31), WD + (size_t)e * D * EFF, EFF, 32 * nb, scr, lane); }
    }
}
struct ProgRouter {
    const char* FINb; const char* WRT; float* SCORE; int G, c, panel;
    __device__ __forceinline__ bool next(int i, eng::UnitD& u, LAS unsigned char*) const {
        const long L = panel >= 0 ? (i == 0 ? panel : 256) : (long)i * G + c; if (L >= 256) return false;
        u.A = FINb + (size_t)L * (256 * 2048); u.B = WRT; u.lda = 2048; u.ldb = 2048; u.nt = 16; u.type = 0; u.r0 = (int)L; u.r1 = 0; u.r2 = 0; u.r3 = 0; return true;
    }
    __device__ __forceinline__ void first(const eng::UnitD&, LAS unsigned char*) const {}
    __device__ __forceinline__ void prefetch(const eng::UnitD&, LAS unsigned char*) const {}
    __device__ __forceinline__ void offsets(const eng::UnitD& u, const int (&Rr)[2], const int (&Cc)[2], unsigned (&oA)[2][2], LAS unsigned char*) const {
#pragma unroll
        for (int h = 0; h < 2; ++h)
#pragma unroll
            for (int i = 0; i < 2; ++i) oA[h][i] = (unsigned)(128 * h + Rr[i]) * u.lda + (unsigned)Cc[i];
    }
    __device__ __forceinline__ void epilogue(eng::Acc& acc, const eng::UnitD& u, int wr, int wc, int fr, int fq, LAS unsigned char*) const {
        float* dst = SCORE + ((size_t)u.r0 * 256 + wr * 64 + fr) * NE + wc * 32 + 8 * fq;
#pragma unroll
        for (int ai = 0; ai < 2; ++ai)
#pragma unroll
            for (int m = 0; m < 4; ++m)
#pragma unroll
                for (int bj = 0; bj < 2; ++bj)
#pragma unroll
                    for (int n = 0; n < 2; ++n) *(f32x4*)(dst + (size_t)(ai * 128 + m * 16) * NE + bj * 128 + 4 * n) = acc[ai][bj][m][n];
    }
};
__device__ __forceinline__ unsigned okey(float f) { const unsigned b = __float_as_uint(f); return b ^ ((b >> 31) ? 0xFFFFFFFFu : 0x80000000u); }
template <int CTRL> __device__ __forceinline__ float dppf(float v) { return __uint_as_float((unsigned)__builtin_amdgcn_update_dpp(0, (int)__float_as_uint(v), CTRL, 0xF, 0xF, true)); }
__device__ __forceinline__ int below(unsigned long long m) { return (int)__builtin_amdgcn_mbcnt_hi((unsigned)(m >> 32), __builtin_amdgcn_mbcnt_lo((unsigned)m, 0u)); }
constexpr int TOK_BLOCKS = T / 256;
__device__ __forceinline__ void p_topk(Frame& F, const Args& a, int panel) {
    int tid_ = threadIdx.x; asm volatile("" : "+v"(tid_)); const int lane = tid_ & 63, wave_ = __builtin_amdgcn_readfirstlane(tid_ >> 6);
    const float* SCORE = (const float*)(F.ws + WS_SCORE);
    int* TOPI = (int*)(F.ws + WS_TOPI); float* TOPW = (float*)(F.ws + WS_TOPW); int* cnt = (int*)(F.ws + WS_CTL) + CW_CNT2;
    LAS int* hist = (LAS int*)F.lds; LAS float* wsel = (LAS float*)(F.lds + 2048) + wave_ * 8;
    const f32x4 bias = *(const f32x4*)(a.in[22] + 4 * lane);
    const float* w_ed = a.in[25]; bf16* WDc = (bf16*)(F.ws + WS_WD); int cvb_it = F.vcu * NWAVES + wave_; const int cvb_stride = F.G * NWAVES; float cvv[ml::CV_K];
    for (int blk = (panel >= 0 ? panel : F.vcu); blk < TOK_BLOCKS; blk += (panel >= 0 ? TOK_BLOCKS : F.G)) {
        __syncthreads();
        if (tid_ < NE) hist[tid_] = 0;
        __syncthreads();
        for (int it = 0; it < 32; ++it) {
            const int tok = blk * 256 + wave_ * 32 + it;
            const bool cv_on = cvb_it < ml::CVB_ITEMS;
            if (cv_on && !(it & 1)) { const ml::CvItem ci = ml::cv_decode_dn(cvb_it, lane, w_ed, WDc); ml::cv_load(cvv, ci); }
            const f32x4 x = *(const f32x4*)(SCORE + (size_t)tok * NE + 4 * lane);
            float sg[4], sv[4];
#pragma unroll
            for (int q = 0; q < 4; ++q) { sg[q] = sigmoidf_(x[q]); sv[q] = sg[q] + bias[q]; }
            float m1 = fmaxf(sv[0], sv[1]), m2 = fminf(sv[0], sv[1]);
            { const float t = sv[2]; const float n1 = fmaxf(m1, t); m2 = fmaxf(m2, fminf(m1, t)); m1 = n1; }
            { const float t = sv[3]; const float n1 = fmaxf(m1, t); m2 = fmaxf(m2, fminf(m1, t)); m1 = n1; }
            { const float o1 = dppf<0xB1>(m1), o2 = dppf<0xB1>(m2); const float n1 = fmaxf(m1, o1); m2 = fmaxf(fminf(m1, o1), fmaxf(m2, o2)); m1 = n1; }
            { const float o1 = dppf<0x4E>(m1), o2 = dppf<0x4E>(m2); const float n1 = fmaxf(m1, o1); m2 = fmaxf(fminf(m1, o1), fmaxf(m2, o2)); m1 = n1; }
            { const float o1 = dppf<0x141>(m1), o2 = dppf<0x141>(m2); const float n1 = fmaxf(m1, o1); m2 = fmaxf(fminf(m1, o1), fmaxf(m2, o2)); m1 = n1; }
            const float gs = m1 + m2;
            int rank = 0; const int myg = lane >> 3;
#pragma unroll
            for (int g = 0; g < NG; ++g) { const float og = __uint_as_float((unsigned)__builtin_amdgcn_readlane((int)__float_as_uint(gs), 8 * g)); rank += (og > gs || (og == gs && g < myg)) ? 1 : 0; }
            const bool gsel = rank < TKG;
            unsigned kq[4];
#pragma unroll
            for (int q = 0; q < 4; ++q) kq[q] = gsel ? okey(sv[q]) : 0u;
            unsigned thr = 0u;
            for (int b = 31; b >= 16; --b) { const unsigned cand = thr | (1u << b);
                const int n = __popcll(__ballot(kq[0] >= cand)) + __popcll(__ballot(kq[1] >= cand)) + __popcll(__ballot(kq[2] >= cand)) + __popcll(__ballot(kq[3] >= cand));
                thr = (n >= TOPK) ? cand : thr; }
            {
              const int n_ge = __popcll(__ballot(kq[0] >= thr)) + __popcll(__ballot(kq[1] >= thr)) + __popcll(__ballot(kq[2] >= thr)) + __popcll(__ballot(kq[3] >= thr));
              if (n_ge != TOPK) {
                for (int b = 15; b >= 0; --b) { const unsigned cand = thr | (1u << b);
                    const int n = __popcll(__ballot(kq[0] >= cand)) + __popcll(__ballot(kq[1] >= cand)) + __popcll(__ballot(kq[2] >= cand)) + __popcll(__ballot(kq[3] >= cand));
                    thr = (n >= TOPK) ? cand : thr; } } }
            int ngt = 0, eqb = 0, owneq = 0, selb = 0, ownsel = 0; bool sel[4];
            unsigned long long beq[4];
#pragma unroll
            for (int q = 0; q < 4; ++q) { ngt += __popcll(__ballot(kq[q] > thr)); beq[q] = __ballot(kq[q] == thr); eqb += below(beq[q]); }
            const int need = TOPK - ngt;
#pragma unroll
            for (int q = 0; q < 4; ++q) { const bool eq = kq[q] == thr; sel[q] = kq[q] > thr || (eq && (eqb + owneq) < need); owneq += eq ? 1 : 0; }
#pragma unroll
            for (int q = 0; q < 4; ++q) selb += below(__ballot(sel[q]));
#pragma unroll
            for (int q = 0; q < 4; ++q) if (sel[q]) { wsel[selb + ownsel] = sg[q]; ++ownsel; }
            asm volatile("s_waitcnt lgkmcnt(0)" ::: "memory");
            const f32x4 w0 = *(const LAS f32x4*)wsel, w1 = *(const LAS f32x4*)(wsel + 4);
            const float inv = RSCALE / (((w0[0] + w0[1]) + (w0[2] + w0[3])) + ((w1[0] + w1[1]) + (w1[2] + w1[3])));
            ownsel = 0;
#pragma unroll
            for (int q = 0; q < 4; ++q) if (sel[q]) { const int slot = selb + ownsel; ++ownsel; TOPI[tok * TOPK + slot] = 4 * lane + q; TOPW[tok * TOPK + slot] = sg[q] * inv; __hip_atomic_fetch_add(hist + 4 * lane + q, 1, __ATOMIC_RELAXED, __HIP_MEMORY_SCOPE_WORKGROUP); }
            asm volatile("s_waitcnt lgkmcnt(0)" ::: "memory");
            if (cv_on && (it & 1)) { const ml::CvItem ci = ml::cv_decode_dn(cvb_it, lane, w_ed, WDc); ml::cv_store(cvv, ci); cvb_it += cvb_stride; }
        }
        __syncthreads();
        if (tid_ < NE) { const int n = hist[tid_]; if (n) __hip_atomic_fetch_add(cnt + ((blk * 256) / TCH) * NE + tid_, n, __ATOMIC_RELAXED, __HIP_MEMORY_SCOPE_AGENT); }
    }
    for (; cvb_it < ml::CVB_ITEMS; cvb_it += cvb_stride) { const ml::CvItem ci = ml::cv_decode_dn(cvb_it, lane, w_ed, WDc); ml::cv_load(cvv, ci); ml::cv_store(cvv, ci); }
    __syncthreads();
}
__device__ __forceinline__ void moe_tile_offsets(Frame& F) {
    int tid_ = threadIdx.x; asm volatile("" : "+v"(tid_)); const int lane_ = tid_ & 63, wave_ = __builtin_amdgcn_readfirstlane(tid_ >> 6);
    const int* cnt = (const int*)(F.ws + WS_CTL) + CW_CNT2; LAS int* toff = (LAS int*)(F.lds + LDS_TOFF); LAS int* wtot = toff + NCH * 257;
    const int c = tid_ >> 8, e = tid_ & 255;
    const int v = tid_ < NCH * NE ? (__hip_atomic_load(cnt + tid_, __ATOMIC_RELAXED, __HIP_MEMORY_SCOPE_AGENT) + 255) >> 8 : 0; int inc = v;
#pragma unroll
    for (int o = 1; o < 64; o <<= 1) { const int t = __shfl_up(inc, o); inc += (lane_ >= o) ? t : 0; }
    if (lane_ == 63) wtot[wave_] = inc;
    __syncthreads();
    int base = 0;
#pragma unroll
    for (int q = 0; q < 3; ++q) base += (q < (wave_ & 3)) ? wtot[(wave_ & ~3) + q] : 0;
    if (tid_ < NCH * NE) { toff[c * 257 + e] = base + inc - v; if (e == 255) toff[c * 257 + NE] = base + inc; }
    __syncthreads();
}
__device__ __forceinline__ void p_scatter(Frame& F) {
    moe_tile_offsets(F);
    int tid_ = threadIdx.x; asm volatile("" : "+v"(tid_));
    const LAS int* toff = (const LAS int*)(F.lds + LDS_TOFF); int* ctl = (int*)(F.ws + WS_CTL);
    LAS int* hist = (LAS int*)F.lds; LAS int* base = hist + NE;
    const int* TOPI = (const int*)(F.ws + WS_TOPI); const float* TOPW = (const float*)(F.ws + WS_TOPW); int* LIST = (int*)(F.ws + WS_LIST); float* LISTW = (float*)(F.ws + WS_LISTW);
    for (int ce = F.vcu; ce < NCH * NE; ce += F.G) { const int c = ce >> 8, e = ce & 255, n = ctl[CW_CNT2 + ce], b0 = toff[c * 257 + e] * 256, cap = ((n + 255) >> 8) << 8;
        for (int p = n + tid_; p < cap; p += 512) { LIST[c * LIST_CAP + b0 + p] = -1; LISTW[c * LIST_CAP + b0 + p] = 0.f; } }
    for (int blk = F.vcu; blk < TOK_BLOCKS; blk += F.G) {
        const int c = (blk * 256) / TCH;
        __syncthreads();
        if (tid_ < NE) hist[tid_] = 0;
        __syncthreads();
        int ex[4], loc[4];
#pragma unroll
        for (int i = 0; i < 4; ++i) { ex[i] = TOPI[blk * 2048 + tid_ + 512 * i]; loc[i] = __hip_atomic_fetch_add(hist + ex[i], 1, __ATOMIC_RELAXED, __HIP_MEMORY_SCOPE_WORKGROUP); }
        __syncthreads();
        if (tid_ < NE) { const int n = hist[tid_]; base[tid_] = n ? __hip_atomic_fetch_add(ctl + CW_FILL2 + c * NE + tid_, n, __ATOMIC_RELAXED, __HIP_MEMORY_SCOPE_AGENT) : 0; }
        __syncthreads();
#pragma unroll
        for (int i = 0; i < 4; ++i) { const int asg = blk * 2048 + tid_ + 512 * i; const int slot = c * LIST_CAP + toff[c * 257 + ex[i]] * 256 + base[ex[i]] + loc[i];
            LIST[slot] = asg; LISTW[slot] = TOPW[asg]; }
    }
    __syncthreads();
}
struct ProgMoE {
    unsigned char* dout; unsigned char* ws; const char* FINb; const char* WGU; const char* WD; char* HID;
    const int* LIST; const float* LISTW; int chunk, ntiles, vcu, G, ns, drain;
    __device__ __forceinline__ int expert_of(int j, LAS unsigned char* lds) const {
        const LAS int* toff = (const LAS int*)(lds + LDS_TOFF) + chunk * 257; int lo = 0, hi = NE;
#pragma unroll
        for (int it = 0; it < 8; ++it) { const int mid = (lo + hi) >> 1; const bool ge = j >= toff[mid]; lo = ge ? mid : lo; hi = ge ? hi : mid; }
        return __builtin_amdgcn_readfirstlane(lo);
    }
    __device__ __forceinline__ bool next(int i, eng::UnitD& u, LAS unsigned char* lds) const {
        int s, kind, n;
        if (drain) { if (i >= 4 || ns == 0) return false; s = ns - 1; kind = 1; n = i; }
        else { if (i < 2) { s = 0; kind = 0; n = i; } else { const int ii = i - 2; s = 1 + ii / 6; const int r = ii % 6; if (r < 2) { kind = 0; n = r; } else { kind = 1; n = r - 2; s -= 1; } }
               if (kind == 0 ? (s >= ns) : (s + 1 >= ns)) return false; }
        const int j = s * G + vcu;
        const int e = expert_of(j, lds);
        u.type = kind; u.r0 = s; u.r1 = n; u.r2 = j; u.r3 = e;
        if (kind == 0) { u.A = FINb; u.lda = 2048; u.B = WGU + (size_t)e * (512 * 2048) + (size_t)n * (256 * 2048); u.ldb = 2048; u.nt = 16; }
        else { u.A = HID + (size_t)(s & 1) * (256 * 512); u.lda = 512; u.B = WD + (size_t)e * (1024 * 512) + (size_t)n * (256 * 512); u.ldb = 512; u.nt = 4; }
        return true;
    }
    __device__ __forceinline__ void idx_dma(const eng::UnitD& u, LAS unsigned char* lds) const {
        if (threadIdx.x < 64) { const size_t base = (size_t)chunk * LIST_CAP + (size_t)u.r2 * 256 + threadIdx.x * 4; LAS unsigned char* dst = lds + LDS_IDX + (u.r0 % 3) * 2048;
            __builtin_amdgcn_global_load_lds((const unsigned*)(LIST + base), (LAS unsigned*)dst, 16, 0, 0);
            __builtin_amdgcn_global_load_lds((const unsigned*)(LISTW + base), (LAS unsigned*)(dst + 1024), 16, 0, 0); }
    }
    __device__ __forceinline__ void first(const eng::UnitD& u, LAS unsigned char* lds) const {
        if (!drain) { idx_dma(u, lds); asm volatile("s_waitcnt vmcnt(0)" ::: "memory"); __builtin_amdgcn_s_barrier(); asm volatile("" ::: "memory"); }
    }
    __device__ __forceinline__ void prefetch(const eng::UnitD& nxt, LAS unsigned char* lds) const { if (nxt.type == 0 && nxt.r1 == 0) idx_dma(nxt, lds); }
    __device__ __forceinline__ void offsets(const eng::UnitD& u, const int (&Rr)[2], const int (&Cc)[2], unsigned (&oA)[2][2], LAS unsigned char* lds) const {
        if (u.type == 0) { const LAS int* idx = (const LAS int*)(lds + LDS_IDX + (u.r0 % 3) * 2048);
#pragma unroll
            for (int h = 0; h < 2; ++h)
#pragma unroll
                for (int i = 0; i < 2; ++i) { const int v = idx[128 * h + Rr[i]]; oA[h][i] = (unsigned)((v < 0 ? 0 : v) >> 3) * 2048u + (unsigned)Cc[i]; } }
        else {
#pragma unroll
            for (int h = 0; h < 2; ++h)
#pragma unroll
                for (int i = 0; i < 2; ++i) oA[h][i] = (unsigned)(128 * h + Rr[i]) * 512u + (unsigned)Cc[i]; }
    }
    __device__ __forceinline__ void epilogue(eng::Acc& acc, const eng::UnitD& u, int wr, int wc, int fr, int fq, LAS unsigned char* lds) const {
        if (u.type == 0) {
            bf16* dst = (bf16*)(HID + (size_t)(u.r0 & 1) * (256 * 512)) + (size_t)(wr * 64 + fr) * 256 + u.r1 * 128 + wc * 32 + 8 * fq;
#pragma unroll
            for (int ai = 0; ai < 2; ++ai)
#pragma unroll
                for (int m = 0; m < 4; ++m) { f32x4 h0, h1;
#pragma unroll
                    for (int e = 0; e < 4; ++e) { h0[e] = siluf_(acc[ai][0][m][0][e]) * acc[ai][1][m][0][e]; h1[e] = siluf_(acc[ai][0][m][1][e]) * acc[ai][1][m][1][e]; }
                    u32x4 w; w.x = cvt_pk_bf16(h0[0], h0[1]); w.y = cvt_pk_bf16(h0[2], h0[3]); w.z = cvt_pk_bf16(h1[0], h1[1]); w.w = cvt_pk_bf16(h1[2], h1[3]);
                    *(u32x4*)(dst + (size_t)(ai * 128 + m * 16) * 256) = w; }
        } else {
            const LAS int* idx = (const LAS int*)(lds + LDS_IDX + (u.r0 % 3) * 2048); const LAS float* wgt = (const LAS float*)(idx + 256);
            const int col = u.r1 * 256 + wc * 64 + 16 * fq;
#pragma unroll
            for (int ai = 0; ai < 2; ++ai)
#pragma unroll
                for (int m = 0; m < 4; ++m) { const int r = ai * 128 + wr * 64 + m * 16 + fr; const int asg = idx[r]; const float w = wgt[r];
                    if (asg >= 0) { unsigned char* rowp = eo_row(dout, ws, asg & 7, (size_t)(asg >> 3)) + col; const float ws_ = w * EO_SCALE; u32x4 o;
#pragma unroll
                        for (int bj = 0; bj < 2; ++bj) { f32x4 v0 = acc[ai][bj][m][0] * ws_, v1 = acc[ai][bj][m][1] * ws_;
#pragma unroll
                            for (int e = 0; e < 4; ++e) { v0[e] = __builtin_amdgcn_fmed3f(v0[e], -448.f, 448.f); v1[e] = __builtin_amdgcn_fmed3f(v1[e], -448.f, 448.f); }
                            int lo = __builtin_amdgcn_cvt_pk_fp8_f32(v0[0], v0[1], 0, false); lo = __builtin_amdgcn_cvt_pk_fp8_f32(v0[2], v0[3], lo, true);
                            int hi = __builtin_amdgcn_cvt_pk_fp8_f32(v1[0], v1[1], 0, false); hi = __builtin_amdgcn_cvt_pk_fp8_f32(v1[2], v1[3], hi, true);
                            o[2 * bj] = (unsigned)lo; o[2 * bj + 1] = (unsigned)hi; }
                        *(u32x4*)rowp = o; } }
        }
    }
};
struct ProgSharedG1 {
    const char* FINb; const char* WSGU; bf16* HIDSH; int G, c, r;
    __device__ __forceinline__ bool next(int i, eng::UnitD& u, LAS unsigned char*) const {
        const int nshort = G - r, q = (c - r + G) % G, first = nshort * 4 < 512 ? nshort * 4 : 512;
        int L;
        if (q < nshort && 4 * q + i < first && i < 4) L = 4 * q + i;
        else { const int i2 = (q < nshort) ? i - ((4 * q < first) ? ((first - 4 * q) < 4 ? (first - 4 * q) : 4) : 0) : i; L = first + i2 * G + q; if (i2 < 0 || L >= 512) return false; }
        const int pm = L >> 1, n = L & 1;
        u.A = FINb + (size_t)pm * (256 * 2048); u.B = WSGU + (size_t)n * (256 * 2048); u.lda = 2048; u.ldb = 2048; u.nt = 16; u.type = 0; u.r0 = pm; u.r1 = n; u.r2 = 0; u.r3 = 0; return true;
    }
    __device__ __forceinline__ void first(const eng::UnitD&, LAS unsigned char*) const {}
    __device__ __forceinline__ void prefetch(const eng::UnitD&, LAS unsigned char*) const {}
    __device__ __forceinline__ void offsets(const eng::UnitD& u, const int (&Rr)[2], const int (&Cc)[2], unsigned (&oA)[2][2], LAS unsigned char*) const {
#pragma unroll
        for (int h = 0; h < 2; ++h)
#pragma unroll
            for (int i = 0; i < 2; ++i) oA[h][i] = (unsigned)(128 * h + Rr[i]) * u.lda + (unsigned)Cc[i];
    }
    __device__ __forceinline__ void epilogue(eng::Acc& acc, const eng::UnitD& u, int wr, int wc, int fr, int fq, LAS unsigned char*) const {
        bf16* dst = HIDSH + ((size_t)u.r0 * 256 + wr * 64 + fr) * 256 + u.r1 * 128 + wc * 32 + 8 * fq;
#pragma unroll
        for (int ai = 0; ai < 2; ++ai)
#pragma unroll
            for (int m = 0; m < 4; ++m) { f32x4 h0, h1;
#pragma unroll
                for (int e = 0; e < 4; ++e) { h0[e] = siluf_(acc[ai][0][m][0][e]) * acc[ai][1][m][0][e]; h1[e] = siluf_(acc[ai][0][m][1][e]) * acc[ai][1][m][1][e]; }
                u32x4 w; w.x = cvt_pk_bf16(h0[0], h0[1]); w.y = cvt_pk_bf16(h0[2], h0[3]); w.z = cvt_pk_bf16(h1[0], h1[1]); w.w = cvt_pk_bf16(h1[2], h1[3]);
                *(u32x4*)(dst + (size_t)(ai * 128 + m * 16) * 256) = w; }
    }
};
struct ProgSharedG2 {
    const char* HIDSHb; const char* WSD; bf16* SH; int G, c;
    __device__ __forceinline__ bool next(int i, eng::UnitD& u, LAS unsigned char*) const {
        const long L = (long)i * G + c; if (L >= 1024) return false;
        const int pm = (int)(L >> 2), n = (int)(L & 3);
        int nt4 = 4; asm volatile("" : "+s"(nt4));
        u.A = HIDSHb + (size_t)pm * (256 * 512); u.B = WSD + (size_t)n * (256 * 512); u.lda = 512; u.ldb = 512; u.nt = nt4; u.type = 0; u.r0 = pm; u.r1 = n; u.r2 = 0; u.r3 = 0; return true;
    }
    __device__ __forceinline__ void first(const eng::UnitD&, LAS unsigned char*) const {}
    __device__ __forceinline__ void prefetch(const eng::UnitD&, LAS unsigned char*) const {}
    __device__ __forceinline__ void offsets(const eng::UnitD& u, const int (&Rr)[2], const int (&Cc)[2], unsigned (&oA)[2][2], LAS unsigned char*) const {
#pragma unroll
        for (int h = 0; h < 2; ++h)
#pragma unroll
            for (int i = 0; i < 2; ++i) oA[h][i] = (unsigned)(128 * h + Rr[i]) * u.lda + (unsigned)Cc[i];
    }
    __device__ __forceinline__ void epilogue(eng::Acc& acc, const eng::UnitD& u, int wr, int wc, int fr, int fq, LAS unsigned char*) const {
        unsigned char* base = (unsigned char*)SH + ((size_t)u.r0 * 256 + wr * 64 + fr) * D + u.r1 * 256 + wc * 32 + 8 * fq;
#pragma unroll
        for (int ai = 0; ai < 2; ++ai)
#pragma unroll
            for (int m = 0; m < 4; ++m) { unsigned char* rp = base + (size_t)(ai * 128 + m * 16) * D;
#pragma unroll
                for (int bj = 0; bj < 2; ++bj) { f32x4 v0 = acc[ai][bj][m][0] * EO_SCALE, v1 = acc[ai][bj][m][1] * EO_SCALE;
#pragma unroll
                    for (int e = 0; e < 4; ++e) { v0[e] = __builtin_amdgcn_fmed3f(v0[e], -448.f, 448.f); v1[e] = __builtin_amdgcn_fmed3f(v1[e], -448.f, 448.f); }
                    int lo = __builtin_amdgcn_cvt_pk_fp8_f32(v0[0], v0[1], 0, false); lo = __builtin_amdgcn_cvt_pk_fp8_f32(v0[2], v0[3], lo, true);
                    int hi = __builtin_amdgcn_cvt_pk_fp8_f32(v1[0], v1[1], 0, false); hi = __builtin_amdgcn_cvt_pk_fp8_f32(v1[2], v1[3], hi, true);
                    u32x2 o; o.x = (unsigned)lo; o.y = (unsigned)hi; *(u32x2*)(rp + bj * 128) = o; } }
    }
};
__device__ __forceinline__ void p_final(Frame& F, const Args& a) {
    int tid_ = threadIdx.x; asm volatile("" : "+v"(tid_)); const int lane = tid_ & 63, wave_ = __builtin_amdgcn_readfirstlane(tid_ >> 6);
    const float* x = a.in[0]; const f32x4* gpost = (const f32x4*)a.in[7]; const f32x4* gpf = (const f32x4*)a.in[9];
    const float* mod = (const float*)(F.ws + WS_MOD); const bf16* YO = (const bf16*)(F.ws + WS_RA); const unsigned char* SH = (const unsigned char*)(F.ws + WS_SH8);
    const float* RS1 = (const float*)(F.ws + WS_RS1);
    const int NGW = F.G * NWAVES; constexpr int RPW = 32;
    for (int gw = F.vcu * NWAVES + wave_; gw * RPW < T; gw += NGW) {
        const int row0 = gw * RPW; const f32x4* mr = (const f32x4*)(mod + (size_t)(row0 / S) * (NMOD * D));
        f32x4 c1[4], c2[4];
#pragma unroll
        for (int q = 0; q < 4; ++q) { const int i4 = 64 * q + lane; c1[q] = mr[512 + i4] * gpost[i4]; c2[q] = mr[1280 + i4] * gpf[i4]; }
        for (int row = row0; row < row0 + RPW; ++row) {
            unsigned e[TOPK][4], sh[4]; u32x2 yb[4]; f32x4 xv[4];
#pragma unroll
            for (int k = 0; k < TOPK; ++k) { const unsigned* ep = (const unsigned*)eo_row(F.dout, F.ws, k, (size_t)row) + lane;
#pragma unroll
                for (int q = 0; q < 4; ++q) e[k][q] = __builtin_nontemporal_load(ep + 64 * q); }
#pragma unroll
            for (int q = 0; q < 4; ++q) { const int i4 = 64 * q + lane; sh[q] = ((const unsigned*)(SH + (size_t)row * D))[i4]; yb[q] = __builtin_nontemporal_load((const u32x2*)(YO + (size_t)row * D) + i4);
                xv[q] = __builtin_nontemporal_load((const f32x4*)(x + (size_t)row * D) + i4); }
            float s1 = (lane < 16) ? RS1[(size_t)row * 16 + lane] : 0.f;
            s1 += __shfl_xor(s1, 1); s1 += __shfl_xor(s1, 2); s1 += __shfl_xor(s1, 4); s1 += __shfl_xor(s1, 8);
            const float rs1 = rsqrtf(__shfl(s1, 0) * (1.f / D) + EPS);
            f32x4 fx[4]; float ss = 0.f;
#pragma unroll
            for (int q = 0; q < 4; ++q) { f32x2 a0 = __builtin_amdgcn_cvt_pk_f32_fp8((int)sh[q], false), a1 = __builtin_amdgcn_cvt_pk_f32_fp8((int)sh[q], true);
#pragma unroll
                for (int k = 0; k < TOPK; ++k) { a0 += __builtin_amdgcn_cvt_pk_f32_fp8((int)e[k][q], false); a1 += __builtin_amdgcn_cvt_pk_f32_fp8((int)e[k][q], true); }
                fx[q][0] = a0[0] * (1.f / EO_SCALE); fx[q][1] = a0[1] * (1.f / EO_SCALE); fx[q][2] = a1[0] * (1.f / EO_SCALE); fx[q][3] = a1[1] * (1.f / EO_SCALE);
                ss += (fx[q][0] * fx[q][0] + fx[q][1] * fx[q][1]) + (fx[q][2] * fx[q][2] + fx[q][3] * fx[q][3]); }
            const float rs2 = rsqrtf(wave_sum(ss) * (1.f / D) + EPS);
            f32x4* orow = (f32x4*)(a.out + (size_t)row * D);
#pragma unroll
            for (int q = 0; q < 4; ++q) { f32x4 y; y[0] = __uint_as_float(yb[q].x << 16); y[1] = __uint_as_float(yb[q].x & 0xffff0000u); y[2] = __uint_as_float(yb[q].y << 16); y[3] = __uint_as_float(yb[q].y & 0xffff0000u);
                orow[64 * q + lane] = xv[q] + c1[q] * (y * rs1) + c2[q] * (fx[q] * rs2); }
        }
    }
}
#ifndef MOE_AUX
#define MOE_AUX 0
#endif
#ifndef PROBE_ENG_PH
#define PROBE_ENG_PH 2
#endif
#ifndef PROBE_SPAN
#define PROBE_SPAN (-1)
#endif
#ifndef PROBE_PHASE
#define PROBE_PHASE (-1)
#endif
__device__ __forceinline__ void ph2_inproj(Frame& F, const Args& args) {
    ProgInProj P; P.A1 = (const char*)(F.ws + WS_RA); P.BT1 = (const char*)(F.ws + WS_BT1); P.G = F.G; P.c = (int)blockIdx.x;
    P.Q = (bf16*)(F.ws + WS_Q); P.K = (bf16*)(F.dout + DO_K); P.V = (bf16*)(F.dout + DO_V); P.MQ = (bf16*)(F.dout + DO_MQ);
    P.MO = (bf16*)(F.ws + WS_MO); P.GA = (bf16*)(F.ws + WS_GA); P.GATES = (float*)(F.ws + WS_GATES);
    { LAS float* tab = (LAS float*)(F.lds + RING_BYTES); const float* rp = (const float*)(F.ws + WS_ROPE);
      int tq = threadIdx.x; asm volatile("" : "+v"(tq));
      for (int i = tq; i < 2048; i += 512) tab[i] = rp[i];
      if (tq < 64) tab[2048 + tq] = args.in[11][tq]; else if (tq < 128) tab[2048 + tq] = args.in[12][tq - 64]; else if (tq < 136) tab[2048 + tq] = args.in[15][tq - 128]; else if (tq < 144) tab[2048 + tq] = args.in[16][tq - 136];
      __syncthreads(); P.tab = tab; }
    eng::gemm_stream<ProgInProj, 0>(F.lds, P, PROBE_ENG_PH == 2 ? F.egacc : nullptr);
}
__device__ __forceinline__ void ph3a_attn(Frame& F, const Args&) {
    const attn_body::AttnTensors AT{(const attn_body::bf16*)(F.ws + WS_Q), (const attn_body::bf16*)(F.dout + DO_K), (const attn_body::bf16*)(F.dout + DO_V), (attn_body::bf16*)(F.ws + WS_RA)};
    const attn_body::StaticOrder SO(F.G, F.vcu);
    attn_body::attn_phase<attn_body::StaticOrder>((char*)F.ldsg, AT, SO);
}
__device__ __forceinline__ void ph5_merge(Frame& F, const Args&, int panel) {
    ProgMerge P; P.panel = panel; P.AM = (const char*)(F.ws + WS_RA); P.WAT = (const char*)(F.ws + WS_WAT); P.WMT = (const char*)(F.ws + WS_WMT); P.Y = (bf16*)(F.dout); P.GA = (const bf16*)(F.ws + WS_GA); P.G = F.G; P.c = (int)blockIdx.x;
    eng::gemm_stream<ProgMerge, 0, true>(F.lds, P);
}
__device__ __forceinline__ void ph6_out(Frame& F, const Args&, int panel) {
    ProgOut P; P.panel = panel; P.Yb = (const char*)(F.dout); P.WOT = (const char*)(F.ws + WS_WOT); P.YO = (bf16*)(F.ws + WS_RA); P.RS1 = (float*)(F.ws + WS_RS1); P.G = F.G; P.c = (int)blockIdx.x;
    eng::gemm_stream<ProgOut, 0>(F.lds, P);
}
__device__ __forceinline__ void ph8_router(Frame& F, const Args&, int panel) {
    ProgRouter P; P.panel = panel; P.FINb = (const char*)(F.ws + WS_GA); P.WRT = (const char*)(F.ws + WS_WRT); P.SCORE = (float*)(F.ws + WS_SCORE); P.G = F.G; P.c = F.vcu;
    eng::gemm_stream<ProgRouter, 0>(F.lds, P);
}
template <int CH> __device__ __forceinline__ void ph_routed(Frame& F, const Args&) {
    moe_tile_offsets(F);
    ProgMoE P; P.dout = F.dout; P.ws = F.ws; P.FINb = (const char*)(F.ws + WS_GA); P.WGU = (const char*)(F.ws + WS_WGU); P.WD = (const char*)(F.ws + WS_WD); P.HID = (char*)(F.ws + WS_HIDS) + (size_t)F.vcu * (2 * 256 * 512);
    P.LIST = (const int*)(F.ws + WS_LIST); P.LISTW = (const float*)(F.ws + WS_LISTW); P.chunk = CH; P.vcu = F.vcu; P.G = F.G;
    P.ntiles = __builtin_amdgcn_readfirstlane(((const LAS int*)(F.lds + LDS_TOFF))[CH * 257 + NE]);
    P.ns = P.ntiles > F.vcu ? (P.ntiles - F.vcu + F.G - 1) / F.G : 0;
    P.drain = 0; eng::gemm_stream<ProgMoE, MOE_AUX>(F.lds, P, PROBE_ENG_PH == 11 ? F.egacc : nullptr);
    P.drain = 1; eng::gemm_stream<ProgMoE, MOE_AUX>(F.lds, P, PROBE_ENG_PH == 11 ? F.egacc : nullptr);
}
__device__ __forceinline__ void ph_sharedg1(Frame& F, const Args&) {
    ProgSharedG1 Q1; Q1.FINb = (const char*)(F.ws + WS_GA); Q1.WSGU = (const char*)(F.ws + WS_WSGU); Q1.HIDSH = (bf16*)(F.ws + WS_HIDSH); Q1.G = F.G; Q1.c = F.vcu;
    Q1.r = __builtin_amdgcn_readfirstlane(((const LAS int*)(F.lds + LDS_TOFF))[NE]) % F.G;
    eng::gemm_stream<ProgSharedG1, 0>(F.lds, Q1);
}
__device__ __forceinline__ void ph_sharedg2(Frame& F, const Args&) {
    ProgSharedG2 P; P.HIDSHb = (const char*)(F.ws + WS_HIDSH); P.WSD = (const char*)(F.ws + WS_WSD); P.SH = (bf16*)(F.ws + WS_SH8); P.G = F.G; P.c = F.vcu;
    eng::gemm_stream<ProgSharedG2, 0>(F.lds, P);
}
__device__ __forceinline__ void ph7_rowpass(Frame& F, const Args& a, int panel) { p6_rowpass<false>(F, a, panel); }
__device__ __forceinline__ void ph10_scatter(Frame& F, const Args&) { p_scatter(F); }

__global__ void __launch_bounds__(NWAVES * 64, 2) mk_fwd(Args args) {
    extern __shared__ __attribute__((aligned(16))) unsigned char lds_raw[];
    Frame F;
    F.lds = (LAS unsigned char*)lds_raw; F.ldsg = lds_raw;
    F.G = gridDim.x; { const int bx = blockIdx.x; F.vcu = (F.G % 8 == 0) ? (bx % 8) * (F.G / 8) + bx / 8 : bx; }
    F.ws = args.ws; F.dout = (unsigned char*)args.out;
    volatile LAS unsigned* MISC = (volatile LAS unsigned*)(F.lds + LDSCTL_OFF);
    for (int u = threadIdx.x; u < (LDS_BYTES - LDSCTL_OFF) / 4; u += NWAVES * 64) ((LAS unsigned*)(F.lds + LDSCTL_OFF))[u] = 0u;
    __syncthreads();
    XcdBarrier bar = xcd_barrier_post((unsigned*)(F.ws + WS_CTL) + CW_BAR, MISC + 8);
    const int lo = args.ph_lo, hi = args.ph_hi;
    unsigned long long pt0 = 0, pt1 = 0, mlacc = 0, egaccv = 0; F.egacc = (PROBE_ENG > 0 && blockIdx.x == 0) ? &egaccv : nullptr;
#define IN(k) (lo <= (k) && (k) < hi)
#define BOTH(k) (IN(k) && IN((k) + 1))
#define STAMP0(k) if (PROBE_SPAN == (k)) { __syncthreads(); pt0 = wall_clock64(); }
#define STAMP1(k) if (PROBE_SPAN == (k)) { __syncthreads(); pt1 = wall_clock64(); }
#define RUNPH(k, CALL) if (IN(k)) { STAMP0(k) CALL; if (PROBE_PHASE == (k)) { xcd_barrier(bar); CALL; } if (BOTH(k)) xcd_barrier(bar); STAMP1(k) }
#define RUNPH2(k, kp, CALL) { CALL; if (PROBE_PHASE == (kp)) { xcd_barrier(bar); CALL; } }
    RUNPH(0, p0_prologue(F, args))
    RUNPH(1, p1_norm_gates(F, args))
    RUNPH(2, ph2_inproj(F, args))
    if (IN(3)) { STAMP0(3) RUNPH2(3, 30, ph3a_attn(F, args)) RUNPH2(3, 31, ml::mlstm_phase(F, args, mlacc)) if (BOTH(3)) xcd_barrier(bar); STAMP1(3) }
    if (IN(4)) { STAMP0(4) RUNPH2(4, 40, ml::mlstm_combine(F, args, -1)) if (BOTH(4)) xcd_barrier(bar); STAMP1(4) }
    RUNPH(5, ph5_merge(F, args, -1))
    RUNPH(6, ph6_out(F, args, -1))
    RUNPH(7, ph7_rowpass(F, args, -1))
    RUNPH(8, ph8_router(F, args, -1))
    RUNPH(9, p_topk(F, args, -1))
    RUNPH(10, ph10_scatter(F, args))
    if (IN(11)) { STAMP0(11) RUNPH2(11, 110, ph_routed<0>(F, args)) RUNPH2(11, 111, ph_sharedg1(F, args)) if (BOTH(11)) xcd_barrier(bar); STAMP1(11) }
    RUNPH(12, ph_sharedg2(F, args))
    RUNPH(13, p_final(F, args))
    if (PROBE_ENG > 0 && blockIdx.x == 0) { const unsigned long long te = wall_clock64(); while (wall_clock64() - te < 4ull * egaccv) __builtin_amdgcn_s_sleep(8); }
    if (PROBE_ML > 0 && blockIdx.x == 0) { const unsigned long long te = wall_clock64(); while (wall_clock64() - te < 4ull * mlacc) __builtin_amdgcn_s_sleep(8); }
    if (PROBE_SPAN >= 0 && blockIdx.x == 0) { const unsigned long long te = wall_clock64(); while (wall_clock64() - te < 4ull * (pt1 - pt0)) __builtin_amdgcn_s_sleep(8); }
#undef IN
#undef BOTH
}

static void launch_mk(hipStream_t st, const Args& a0, int grid, int lo, int hi) {
    Args a = a0; a.ph_lo = lo; a.ph_hi = hi;
    hipLaunchKernelGGL(mk_fwd, dim3(grid), dim3(NWAVES * 64), LDS_BYTES, st, a);
}
extern "C" void kernel_launch(void* const* d_in, const int* in_sizes, int n_in, void* d_out, int out_size, void* d_ws, size_t ws_size, hipStream_t st) {
    static int grid = 0;
    if (grid == 0) {
        if (n_in != 29 || ws_size < WS_NEED || out_size != T * D) { fprintf(stderr, "kernel_launch: unexpected n_in %d / ws_size %zu / out_size %d\n", n_in, ws_size, out_size); grid = -1; return; }
        int dev = 0, cus = 0;
        if (hipGetDevice(&dev) != hipSuccess || hipDeviceGetAttribute(&cus, hipDeviceAttributeMultiprocessorCount, dev) != hipSuccess) { grid = -1; return; }
        if (hipFuncSetAttribute((const void*)mk_fwd, hipFuncAttributeMaxDynamicSharedMemorySize, LDS_BYTES) != hipSuccess) { fprintf(stderr, "kernel_launch: hipFuncSetAttribute failed\n"); grid = -1; return; }
        int per_cu = 0;
        if (hipOccupancyMaxActiveBlocksPerMultiprocessor(&per_cu, (const void*)mk_fwd, NWAVES * 64, LDS_BYTES) != hipSuccess || per_cu < 1) fprintf(stderr, "kernel_launch: occupancy query says %d\n", per_cu);
        (void)hipGetLastError();
        grid = cus;
    }
    if (grid < 0) return;
    unsigned char* ws = (unsigned char*)d_ws;
    (void)hipMemsetAsync(ws + WS_CTL, 0, CTL_ZERO_BYTES, st);
    Args a; memset(&a, 0, sizeof(a));
    for (int i = 0; i < 29; ++i) a.in[i] = (const float*)d_in[i];
    a.out = (float*)d_out; a.ws = ws;
#if defined(EXP_PER_PHASE)
    for (int ph = 0; ph < 14; ++ph) launch_mk(st, a, grid, ph, ph + 1);
#else
    launch_mk(st, a, grid, 0, 14);
#endif
}
```
